# Optimizing an MI355X kernel written in HIP

```python
import jax, jax.numpy as jnp
from jax import lax
import numpy as np

D_MODEL = 2048
BATCH = 4
SEQ = 2048
DEPTH = 4

FOX_W = D_MODEL // 4
FOX_HD = 64
FOX_HEADS = FOX_W // FOX_HD
FOX_BLOCK = 128
GLA_HEADS = 4
GLA_W = D_MODEL // 4
GLA_DV = GLA_W // GLA_HEADS
GLA_DK = GLA_DV // 2
GLA_KW = GLA_HEADS * GLA_DK
GLA_RANK = 16
GLA_TAU = 16.0
GLA_CHUNK = 32
LRU_W = D_MODEL // 2
LRU_BLOCKS = 16
LRU_BW = LRU_W // LRU_BLOCKS
LRU_C = 8.0
CONV_WIDTH = 4
D_MIX = FOX_W + GLA_W + LRU_W
IN_W = 3 * FOX_W + FOX_HEADS + 2 * GLA_KW + 2 * GLA_W + GLA_RANK + 2 * LRU_W
FFN_HIDDEN = -(-8 * D_MODEL // 768) * 256
RMS_EPS = 1e-6

kernel_name = "hymba_fox_gla_rglru_hybrid"


def in_proj_sizes():
    return [FOX_W, FOX_W, FOX_W, FOX_HEADS,
            GLA_KW, GLA_KW, GLA_W, GLA_W, GLA_RANK,
            LRU_W, LRU_W]


def rmsnorm(x, g):
    xf = x.astype(jnp.float32)
    y = xf * lax.rsqrt(jnp.mean(xf * xf, axis=-1, keepdims=True) + RMS_EPS)
    return (y * g.astype(jnp.float32)).astype(x.dtype)


def fox_attention(q, k, v, f_logit, f_bias):
    B, S, H, Dh = q.shape
    c = jnp.cumsum(jax.nn.log_sigmoid((f_logit + f_bias).astype(jnp.float32)), axis=1)
    c = c.transpose(0, 2, 1)
    q, k, v = (t.transpose(0, 2, 1, 3) for t in (q, k, v))
    scale = Dh ** -0.5
    outs = []
    for i in range(S // FOX_BLOCK):
        q0 = i * FOX_BLOCK
        end = q0 + FOX_BLOCK
        s = jnp.einsum('bhqd,bhkd->bhqk', q[:, :, q0:end], k[:, :, :end]).astype(jnp.float32) * scale
        s = s + c[:, :, q0:end, None] - c[:, :, None, :end]
        mask = jnp.arange(end)[None, :] <= (q0 + jnp.arange(FOX_BLOCK))[:, None]
        p = jax.nn.softmax(jnp.where(mask, s, -jnp.inf), axis=-1)
        outs.append(jnp.einsum('bhqk,bhkd->bhqd', p.astype(v.dtype), v[:, :, :end]))
    o = jnp.concatenate(outs, axis=2)
    return o.transpose(0, 2, 1, 3).reshape(B, S, H * Dh)


def gla_chunked(q, k, v, log_alpha):
    B, S, H, Dk = q.shape
    Dv = v.shape[-1]
    C = GLA_CHUNK
    N = S // C

    def chunk(t):
        return t.astype(jnp.float32).reshape(B, N, C, H, t.shape[-1]).transpose(0, 3, 1, 2, 4)

    qc = chunk(q) * (Dk ** -0.5)
    kc = chunk(k)
    vc = chunk(v)
    b = jnp.cumsum(chunk(log_alpha), axis=3)
    causal = jnp.tril(jnp.ones((C, C), dtype=bool))
    diff = b[:, :, :, :, None, :] - b[:, :, :, None, :, :]
    decay = jnp.exp(jnp.where(causal[:, :, None], diff, -jnp.inf))
    A = jnp.einsum('bhntd,bhnsd,bhntsd->bhnts', qc, kc, decay)
    o_intra = jnp.einsum('bhnts,bhnsv->bhntv', A, vc)
    b_last = b[:, :, :, -1, :]
    q_in = qc * jnp.exp(b)
    k_st = kc * jnp.exp(b_last[:, :, :, None, :] - b)
    U = jnp.einsum('bhncd,bhncv->bhndv', k_st, vc)

    def step(state, inp):
        dec, u = inp
        return dec[..., None] * state + u, state

    s0 = jnp.zeros((B, H, Dk, Dv), jnp.float32)
    _, s_prev = lax.scan(step, s0, (jnp.moveaxis(jnp.exp(b_last), 2, 0), jnp.moveaxis(U, 2, 0)))
    s_prev = jnp.moveaxis(s_prev, 0, 2)
    o_inter = jnp.einsum('bhncd,bhndv->bhncv', q_in, s_prev)
    o = o_intra + o_inter
    return o.transpose(0, 2, 3, 1, 4).reshape(B, S, H, Dv)


def causal_depthwise_conv(x, w, b):
    K = w.shape[0]
    S = x.shape[1]
    xp = jnp.pad(x, ((0, 0), (K - 1, 0), (0, 0)))
    out = b
    for j in range(K):
        out = out + xp[:, j:j + S] * w[j]
    return out


def rg_lru(x, w_a, b_a, w_i, b_i, lam):
    B, S, W = x.shape
    xb = x.reshape(B, S, LRU_BLOCKS, LRU_BW)
    r = jax.nn.sigmoid(jnp.einsum('bsnd,nde->bsne', xb, w_a).reshape(B, S, W) + b_a)
    i = jax.nn.sigmoid(jnp.einsum('bsnd,nde->bsne', xb, w_i).reshape(B, S, W) + b_i)
    log_a = (LRU_C * r.astype(jnp.float32)) * jax.nn.log_sigmoid(lam.astype(jnp.float32))
    a = jnp.exp(log_a)
    u = jnp.sqrt(-jnp.expm1(2.0 * log_a)) * (i * x).astype(jnp.float32)

    def step(h, inp):
        a_t, u_t = inp
        h = a_t * h + u_t
        return h, h

    _, hs = lax.scan(step, jnp.zeros((B, W), jnp.float32), (a.swapaxes(0, 1), u.swapaxes(0, 1)))
    return hs.swapaxes(0, 1)


def setup_inputs(seed: int = 0) -> dict:
    key = jax.random.key(seed)
    ks = jax.random.split(key, 24)
    f32 = jnp.float32

    def nrm(k, shape, scale):
        return jax.random.normal(k, shape, f32) * scale

    def gain(k, shape):
        return 1.0 + 0.02 * jax.random.normal(k, shape, f32)

    u = jax.random.uniform(ks[15], (DEPTH, LRU_W), f32, minval=0.9, maxval=0.999)
    a_base = u ** (1.0 / LRU_C)
    lru_lambda = jnp.log(a_base) - jnp.log1p(-a_base)
    return {
        "x": nrm(ks[0], (BATCH, SEQ, D_MODEL), 1.0),
        "norm_mix": gain(ks[1], (DEPTH, D_MODEL)),
        "w_in": nrm(ks[2], (DEPTH, D_MODEL, IN_W), D_MODEL ** -0.5),
        "fox_f_bias": 2.0 + 0.1 * jax.random.normal(ks[3], (DEPTH, FOX_HEADS), f32),
        "fox_out_norm": gain(ks[4], (DEPTH, FOX_W)),
        "gla_gate_w2": nrm(ks[5], (DEPTH, GLA_RANK, GLA_KW), GLA_RANK ** -0.5),
        "gla_gate_bias": nrm(ks[6], (DEPTH, GLA_KW), 0.1),
        "gla_head_norm": gain(ks[7], (DEPTH, GLA_DV)),
        "conv_w": nrm(ks[8], (DEPTH, CONV_WIDTH, LRU_W), CONV_WIDTH ** -0.5),
        "conv_b": nrm(ks[9], (DEPTH, LRU_W), 0.02),
        "lru_w_a": nrm(ks[10], (DEPTH, LRU_BLOCKS, LRU_BW, LRU_BW), LRU_BW ** -0.5),
        "lru_b_a": nrm(ks[11], (DEPTH, LRU_W), 0.1),
        "lru_w_i": nrm(ks[12], (DEPTH, LRU_BLOCKS, LRU_BW, LRU_BW), LRU_BW ** -0.5),
        "lru_b_i": nrm(ks[13], (DEPTH, LRU_W), 0.1),
        "lru_lambda": lru_lambda,
        "lru_out_norm": gain(ks[14], (DEPTH, LRU_W)),
        "w_out": nrm(ks[16], (DEPTH, D_MIX, D_MODEL), D_MIX ** -0.5),
        "norm_ffn": gain(ks[17], (DEPTH, D_MODEL)),
        "w_gate": nrm(ks[18], (DEPTH, D_MODEL, FFN_HIDDEN), D_MODEL ** -0.5),
        "w_up": nrm(ks[19], (DEPTH, D_MODEL, FFN_HIDDEN), D_MODEL ** -0.5),
        "w_down": nrm(ks[20], (DEPTH, FFN_HIDDEN, D_MODEL), FFN_HIDDEN ** -0.5),
        "final_norm": gain(ks[21], (D_MODEL,)),
    }


def reference(x, norm_mix, w_in, fox_f_bias, fox_out_norm, gla_gate_w2, gla_gate_bias,
              gla_head_norm, conv_w, conv_b, lru_w_a, lru_b_a, lru_w_i, lru_b_i, lru_lambda,
              lru_out_norm, w_out, norm_ffn, w_gate, w_up, w_down, final_norm):
    B, S, _ = x.shape
    offsets = [int(o) for o in np.cumsum(in_proj_sizes())[:-1]]
    for l in range(DEPTH):
        h = rmsnorm(x, norm_mix[l])
        proj = h @ w_in[l]
        fq, fk, fv, ff, gq, gk, gv, gg, gr, lg, lx = jnp.split(proj, offsets, axis=-1)
        fox = fox_attention(fq.reshape(B, S, FOX_HEADS, FOX_HD), fk.reshape(B, S, FOX_HEADS, FOX_HD),
                            fv.reshape(B, S, FOX_HEADS, FOX_HD), ff, fox_f_bias[l])
        fox = rmsnorm(fox, fox_out_norm[l])
        log_alpha = jax.nn.log_sigmoid((gr @ gla_gate_w2[l] + gla_gate_bias[l]).astype(jnp.float32)) / GLA_TAU
        gla = gla_chunked(gq.reshape(B, S, GLA_HEADS, GLA_DK), gk.reshape(B, S, GLA_HEADS, GLA_DK),
                          gv.reshape(B, S, GLA_HEADS, GLA_DV), log_alpha.reshape(B, S, GLA_HEADS, GLA_DK))
        gla = rmsnorm(gla, gla_head_norm[l]) * jax.nn.silu(gg.reshape(B, S, GLA_HEADS, GLA_DV).astype(jnp.float32))
        gla = gla.reshape(B, S, GLA_W).astype(h.dtype)
        lru_in = causal_depthwise_conv(lx, conv_w[l], conv_b[l])
        lru = rg_lru(lru_in, lru_w_a[l], lru_b_a[l], lru_w_i[l], lru_b_i[l], lru_lambda[l])
        lru = rmsnorm((lru * jax.nn.gelu(lg.astype(jnp.float32))).astype(h.dtype), lru_out_norm[l])
        mix = jnp.concatenate([fox.astype(h.dtype), gla, lru], axis=-1) @ w_out[l]
        x = x + mix.astype(x.dtype)
        h = rmsnorm(x, norm_ffn[l])
        ffn = (jax.nn.silu(h @ w_gate[l]) * (h @ w_up[l])) @ w_down[l]
        x = x + ffn.astype(x.dtype)
    return rmsnorm(x, final_norm)
```

```cpp
#include <hip/hip_runtime.h>
#include <hip/hip_cooperative_groups.h>
#include <cstdio>
#include <cstdint>
namespace cg = cooperative_groups;
namespace pg8 {
#define PG8_LAS __attribute__((address_space(3)))
typedef unsigned short bf16_t;
typedef short bf16x8 __attribute__((ext_vector_type(8)));
typedef float f32x4 __attribute__((ext_vector_type(4)));
typedef unsigned u32x4 __attribute__((ext_vector_type(4)));
constexpr int BM = 256, BK = 64, HALF = 128, HTB = HALF * BK * 2  , STAGE_BYTES = 8 * HTB, NXCD = 8, WGM = 8;

__host__ __device__ __forceinline__ int lds_byte(int r, int c) { const int st = (r >> 4) * 2 + (c >> 5), rr = r & 15, cc = c & 31, ob = rr * 64 + cc * 2; return st * 1024 + (ob ^ (((ob >> 9) & 1) << 5)); }
__host__ __device__ __forceinline__ void stage_rc(int b, int& R, int& C) { const int st = b / 1024, sb = b % 1024, swz = sb ^ (((sb >> 9) & 1) << 5); R = (st >> 1) * 16 + swz / 64; C = (st & 1) * 32 + (swz % 64) / 2; }
__host__ __device__ __forceinline__ int perm32(int rho) { const int n = rho >> 4, i = rho & 15; return 8 * (i >> 2) + 4 * n + (i & 3); }

struct Unit { int pm, pn; };
struct Gemm { const bf16_t* A; const bf16_t* Bt; int M, N, K; };

struct StaticOrder {
    int nM, nN, nwg, G, c;
    __host__ __device__ void init(int M, int N, int G_, int c_) { nM = M / BM; nN = N / BM; nwg = nM * nN; G = G_; c = c_; }
    __host__ __device__ bool next(int i, Unit& u) const {
        const long L = (long)i * G + c; if (L >= nwg) return false;
        int wgid = (int)L; { const int q = nwg / NXCD, r = nwg % NXCD, xcd = wgid % NXCD, off = wgid / NXCD; wgid = (xcd < r ? xcd * (q + 1) : r * (q + 1) + (xcd - r) * q) + off; }
        const int nig = WGM * nN, gid = wgid / nig, fm = gid * WGM, gsz = (nM - fm) < WGM ? (nM - fm) : WGM;
        u.pm = fm + ((wgid % nig) % gsz); u.pn = (wgid % nig) / gsz; return true;
    }
    __device__ __forceinline__ void a_ready(const Unit&) const {}
    __device__ __forceinline__ void done(const Unit&) const {}
};

typedef unsigned u32x2 __attribute__((ext_vector_type(2)));
__device__ __forceinline__ unsigned cvt_pk_bf16(float lo, float hi) { unsigned r; asm("v_cvt_pk_bf16_f32 %0, %1, %2" : "=v"(r) : "v"(lo), "v"(hi)); return r; }
__device__ __forceinline__ float ssp_sum(const float* p, int row) {
    float s = 0.f;
#pragma unroll
    for (int i = 0; i < 8; ++i) { const f32x4 v = *(const f32x4*)(p + ((size_t)i * 8192 + row) * 4); s += (v[0] + v[1]) + (v[2] + v[3]); }
    return s;
}
template <class Sched> __device__ __forceinline__ void rstd_table(PG8_LAS float* rtab, const float* ss, const Sched& S, int tid) {
    float v[4]; bool ok[4];
#pragma unroll
    for (int k = 0; k < 4; ++k) { const int i = 2 * k + (tid >> 8); Unit u; ok[k] = S.next(i, u); v[k] = ok[k] ? ssp_sum(ss, u.pm * BM + (tid & 255)) : 0.f; }
#pragma unroll
    for (int k = 0; k < 4; ++k) if (ok[k]) rtab[(2 * k + (tid >> 8)) * 256 + (tid & 255)] = rsqrtf(v[k] * (1.0f / 2048.0f) + 1e-6f);
    __syncthreads();
}
#define PG8_ROW_RSTD(rs, ss, row0) float rs[2][4]; { const int lane_ = (int)(threadIdx.x & 63u); \
    const float v0_ = rsqrtf(ssp_sum((ss), (row0) + (lane_ >> 4) * 16) * (1.0f / 2048.0f) + 1e-6f), v1_ = rsqrtf(ssp_sum((ss), (row0) + HALF + (lane_ >> 4) * 16) * (1.0f / 2048.0f) + 1e-6f); \
    _Pragma("unroll") for (int m_ = 0; m_ < 4; ++m_) { rs[0][m_] = __shfl(v0_, (lane_ & 15) + 16 * m_); rs[1][m_] = __shfl(v1_, (lane_ & 15) + 16 * m_); } }
struct EpiStoreF32 {
    static constexpr bool PERM = false, AFTER_DRAIN = false;
    float* O; int ldc; const PG8_LAS float* rtab; mutable int ui;
    bf16_t* qkv;
    __device__ __forceinline__ void operator()(const f32x4 (&acc)[2][2][4][2], const Unit& u, int wr, int wc, int fr, int fq) const {
        const int row0 = u.pm * BM + wr * 64 + fr, col0 = u.pn * BM + wc * 32 + 4 * fq;
        const PG8_LAS float* rt = rtab + ui * 256 + wr * 64 + fr; ++ui;
#pragma unroll
        for (int ai = 0; ai < 2; ++ai)
#pragma unroll
            for (int m = 0; m < 4; ++m) { const int row = row0 + ai * HALF + m * 16; float* rowp = O + (size_t)row * ldc + col0;
                const float rs = rt[ai * HALF + m * 16];
                if (u.pn < 6 || (u.pn >> 1) == 4) {
                    const float sc = (u.pn < 2) ? 0.125f * 1.4426950408889634f : 1.0f;
                    bf16_t* bp = qkv + ((size_t)(u.pn < 6 ? (u.pn >> 1) : 3) * 8192 + row) * 512 + (u.pn & 1) * 256 + wc * 32 + 4 * fq;
#pragma unroll
                    for (int bj = 0; bj < 2; ++bj)
#pragma unroll
                        for (int n = 0; n < 2; ++n) { f32x4 v = acc[ai][bj][m][n] * rs; if (u.pn < 2) v = v * sc;
                            u32x2 w; w.x = cvt_pk_bf16(v[0], v[1]); w.y = cvt_pk_bf16(v[2], v[3]); *(u32x2*)(bp + bj * HALF + n * 16) = w; }
                } else {
#pragma unroll
                for (int bj = 0; bj < 2; ++bj)
#pragma unroll
                    for (int n = 0; n < 2; ++n) *(f32x4*)(rowp + bj * HALF + n * 16) = acc[ai][bj][m][n] * rs; } }
    }
};
struct EpiResid {
    static constexpr bool PERM = false, AFTER_DRAIN = false;
    const float* base; float* out; bf16_t* xb; float* ss; const float* gain; int ldc;
    __device__ __forceinline__ void operator()(const f32x4 (&acc)[2][2][4][2], const Unit& u, int wr, int wc, int fr, int fq) const {
        const int row0 = u.pm * BM + wr * 64 + fr, col0 = u.pn * BM + wc * 32 + 4 * fq;
        f32x4 gv[2][2];
#pragma unroll
        for (int bj = 0; bj < 2; ++bj)
#pragma unroll
            for (int n = 0; n < 2; ++n) gv[bj][n] = *(const f32x4*)(gain + col0 + bj * HALF + n * 16);
#pragma unroll
        for (int ai = 0; ai < 2; ++ai)
#pragma unroll
            for (int m = 0; m < 4; ++m) { const int row = row0 + ai * HALF + m * 16; const size_t off = (size_t)row * ldc + col0; float s = 0.f;
#pragma unroll
                for (int bj = 0; bj < 2; ++bj)
#pragma unroll
                    for (int n = 0; n < 2; ++n) { const f32x4 b = *(const f32x4*)(base + off + bj * HALF + n * 16); const f32x4 v = b + acc[ai][bj][m][n];
                        *(f32x4*)(out + off + bj * HALF + n * 16) = v; s += (v[0] * v[0] + v[1] * v[1]) + (v[2] * v[2] + v[3] * v[3]);
                        if (xb) { const f32x4 y = v * gv[bj][n]; u32x2 w; w.x = cvt_pk_bf16(y[0], y[1]); w.y = cvt_pk_bf16(y[2], y[3]); *(u32x2*)(xb + off + bj * HALF + n * 16) = w; } }
                s += __shfl_xor(s, 16); s += __shfl_xor(s, 32);
                if (fq == 0) ss[((size_t)u.pn * 8192 + row) * 4 + wc] = s; }
    }
};
struct EpiSwiglu {
    static constexpr bool PERM = true, AFTER_DRAIN = false;
    bf16_t* O; int ldc; const PG8_LAS float* rtab; mutable int ui;
    __device__ __forceinline__ void operator()(const f32x4 (&acc)[2][2][4][2], const Unit& u, int wr, int wc, int fr, int fq) const {
        const int row0 = u.pm * BM + wr * 64 + fr, col0 = u.pn * HALF + wc * 32 + 8 * fq;
        const PG8_LAS float* rt = rtab + ui * 256 + wr * 64 + fr; ++ui;
#pragma unroll
        for (int ai = 0; ai < 2; ++ai)
#pragma unroll
            for (int m = 0; m < 4; ++m) {
                const float rs = rt[ai * HALF + m * 16];
                float h[8];
#pragma unroll
                for (int n = 0; n < 2; ++n)
#pragma unroll
                    for (int e = 0; e < 4; ++e) { const float g = acc[ai][0][m][n][e] * rs, up = acc[ai][1][m][n][e] * rs; h[n * 4 + e] = g * __builtin_amdgcn_rcpf(1.0f + __builtin_amdgcn_exp2f(g * -1.4426950408889634f)) * up; }
                u32x4 w; w.x = cvt_pk_bf16(h[0], h[1]); w.y = cvt_pk_bf16(h[2], h[3]); w.z = cvt_pk_bf16(h[4], h[5]); w.w = cvt_pk_bf16(h[6], h[7]);
                *(u32x4*)(O + (size_t)(row0 + ai * HALF + m * 16) * ldc + col0) = w; }
    }
};
template <class Epi, class Sched, bool ALIGN_EPI = false, bool SP2 = false>
__device__ __forceinline__ void gemm_phase(PG8_LAS unsigned char* lds, const Gemm g, const Sched& S, const Epi& E, const int tid) {
    const int wid = __builtin_amdgcn_readfirstlane(tid >> 6), lane = tid & 63, wr = wid >> 2, wc = wid & 3, fr = lane & 15, fq = lane >> 4;
    const int K = g.K, nt = K / BK;
    unsigned voffA[2], voffB[2];
#pragma unroll
    for (int i = 0; i < 2; ++i) { int R, C; stage_rc(tid * 16 + i * 8192, R, C); const int Rb = Epi::PERM ? ((R & ~31) + perm32(R & 31)) : R;
        voffA[i] = (unsigned)(R * K + C) * 2u; voffB[i] = (unsigned)(Rb * K + C) * 2u; }
    const size_t kstep = (size_t)(BK * 2);
    const size_t hstep = (size_t)HALF * K * 2;
    const size_t tstep = 2 * hstep;
    const unsigned ldsw = (unsigned)wid * 1024u;
    const int aoff = lds_byte(wr * 64 + fr, fq * 8), boff = lds_byte(wc * 32 + fr, fq * 8);
#define PG8_SA(b, h) (((b) * 2 + (h)) * HTB)
#define PG8_SB(b, h) ((4 + (b) * 2 + (h)) * HTB)
#define PG8_STAGE(bufoff, gbase, voff) do { _Pragma("unroll") for (int _i = 0; _i < 2; ++_i) \
        __builtin_amdgcn_global_load_lds((const unsigned*)((const char*)(gbase) + (voff)[_i]), (PG8_LAS unsigned*)(lds + (bufoff) + ldsw + _i * 8192), 16, 0, 0); } while (0)
#define PG8_LDA(dst, b, h) do { _Pragma("unroll") for (int m = 0; m < 4; ++m) _Pragma("unroll") for (int k = 0; k < 2; ++k) dst[m][k] = *(const PG8_LAS bf16x8*)(lds + PG8_SA(b, h) + aoff + m * 2048 + k * 1024); } while (0)
#define PG8_LDB(dst, b, h) do { _Pragma("unroll") for (int n = 0; n < 2; ++n) _Pragma("unroll") for (int k = 0; k < 2; ++k) dst[n][k] = *(const PG8_LAS bf16x8*)(lds + PG8_SB(b, h) + boff + n * 2048 + k * 1024); } while (0)
#define PG8_MMA(ai, bj, At, Bt) do { __builtin_amdgcn_s_setprio(1); _Pragma("unroll") for (int m = 0; m < 4; ++m) _Pragma("unroll") for (int n = 0; n < 2; ++n) _Pragma("unroll") for (int k = 0; k < 2; ++k) \
        acc[ai][bj][m][n] = __builtin_amdgcn_mfma_f32_16x16x32_bf16(Bt[n][k], At[m][k], acc[ai][bj][m][n], 0, 0, 0); __builtin_amdgcn_s_setprio(0); } while (0)
#define PG8_WAIT_V(n) asm volatile("s_waitcnt vmcnt(" #n ")" ::: "memory")
#define PG8_WAIT_L(n) asm volatile("s_waitcnt lgkmcnt(" #n ")" ::: "memory")
#define PG8_BAR __builtin_amdgcn_s_barrier()
#define PG8_SCHED __builtin_amdgcn_sched_barrier(0)
    Unit cur, nxt; int ui = 0;
    if (!S.next(0, cur)) return;
    f32x4 acc[2][2][4][2];
#pragma unroll
    for (int a = 0; a < 2; ++a)
#pragma unroll
        for (int b = 0; b < 2; ++b)
#pragma unroll
            for (int m = 0; m < 4; ++m)
#pragma unroll
                for (int n = 0; n < 2; ++n) acc[a][b][m][n] = (f32x4){0.f, 0.f, 0.f, 0.f};
    bf16x8 At[4][2], B0[2][2], B1[2][2];
    const char* cA = (const char*)g.A + (size_t)cur.pm * tstep; const char* cB = (const char*)g.Bt + (size_t)cur.pn * tstep;
    S.a_ready(cur);
    if constexpr (SP2) {
        PG8_STAGE(PG8_SB(0, 0), cB, voffB); PG8_STAGE(PG8_SB(0, 1), cB + hstep, voffB); PG8_STAGE(PG8_SA(0, 0), cA, voffA); PG8_STAGE(PG8_SA(0, 1), cA + hstep, voffA);
        if (wr == 1) PG8_BAR;
        PG8_WAIT_V(2); PG8_BAR;
        PG8_STAGE(PG8_SB(1, 0), cB + kstep, voffB); PG8_STAGE(PG8_SA(1, 0), cA + kstep, voffA); PG8_STAGE(PG8_SB(1, 1), cB + hstep + kstep, voffB);
        PG8_WAIT_V(6); PG8_BAR;
    } else {
        PG8_STAGE(PG8_SB(0, 0), cB, voffB); PG8_STAGE(PG8_SA(0, 0), cA, voffA); PG8_STAGE(PG8_SB(0, 1), cB + hstep, voffB); PG8_STAGE(PG8_SA(0, 1), cA + hstep, voffA);
        if (wr == 1) PG8_BAR;
        PG8_WAIT_V(4); PG8_BAR;
        PG8_STAGE(PG8_SB(1, 0), cB + kstep, voffB); PG8_STAGE(PG8_SA(1, 0), cA + kstep, voffA); PG8_STAGE(PG8_SB(1, 1), cB + hstep + kstep, voffB);
        PG8_WAIT_V(6); PG8_BAR;
    }
    for (;;) {
        const bool has_next = S.next(ui + 1, nxt);
        const char* nA = has_next ? (const char*)g.A + (size_t)nxt.pm * tstep : cA; const char* nB = has_next ? (const char*)g.Bt + (size_t)nxt.pn * tstep : cB;
        for (int t = 0; t < nt; t += 2) {
            const bool last = (t == nt - 2);
            const char* a1 = cA + (size_t)(t + 1) * kstep;
            const char* a2 = last ? nA : cA + (size_t)(t + 2) * kstep; const char* b2 = last ? nB : cB + (size_t)(t + 2) * kstep;
            const char* a3 = a2 + kstep; const char* b3 = b2 + kstep;
            if (last && has_next) S.a_ready(nxt);
            if constexpr (SP2) {
            PG8_LDB(B0, 0, 0); PG8_LDB(B1, 0, 1); PG8_SCHED; PG8_LDA(At, 0, 0); PG8_STAGE(PG8_SA(1, 1), a1 + hstep, voffA);
            PG8_WAIT_V(8); PG8_WAIT_L(0); PG8_BAR; PG8_MMA(0, 0, At, B0); PG8_MMA(0, 1, At, B1); PG8_BAR; PG8_SCHED;
            PG8_LDA(At, 0, 1); PG8_STAGE(PG8_SB(0, 0), b2, voffB); PG8_STAGE(PG8_SB(0, 1), b2 + hstep, voffB); PG8_STAGE(PG8_SA(0, 0), a2, voffA);
            PG8_WAIT_V(8); PG8_WAIT_L(0); PG8_BAR; PG8_MMA(1, 0, At, B0); PG8_MMA(1, 1, At, B1); PG8_BAR; PG8_SCHED;
            PG8_LDB(B0, 1, 0); PG8_LDB(B1, 1, 1); PG8_SCHED; PG8_LDA(At, 1, 0); PG8_STAGE(PG8_SA(0, 1), a2 + hstep, voffA);
            PG8_WAIT_V(8); PG8_WAIT_L(0); PG8_BAR; PG8_MMA(0, 0, At, B0); PG8_MMA(0, 1, At, B1); PG8_BAR; PG8_SCHED;
            PG8_LDA(At, 1, 1); PG8_STAGE(PG8_SB(1, 0), b3, voffB); PG8_STAGE(PG8_SB(1, 1), b3 + hstep, voffB); PG8_STAGE(PG8_SA(1, 0), a3, voffA);
            PG8_WAIT_V(8); PG8_WAIT_L(0); PG8_BAR; PG8_MMA(1, 0, At, B0); PG8_MMA(1, 1, At, B1); PG8_BAR; PG8_SCHED;
            } else {
            PG8_LDB(B0, 0, 0); PG8_SCHED; PG8_LDA(At, 0, 0); PG8_STAGE(PG8_SA(1, 1), a1 + hstep, voffA);
            PG8_WAIT_L(8); PG8_BAR; PG8_WAIT_L(0); PG8_MMA(0, 0, At, B0); PG8_BAR; PG8_SCHED;
            PG8_LDB(B1, 0, 1); PG8_STAGE(PG8_SB(0, 0), b2, voffB);
            PG8_BAR; PG8_WAIT_L(0); PG8_MMA(0, 1, At, B1); PG8_BAR;
            PG8_LDA(At, 0, 1); PG8_STAGE(PG8_SA(0, 0), a2, voffA);
            PG8_BAR; PG8_WAIT_L(0); PG8_MMA(1, 0, At, B0); PG8_BAR; PG8_SCHED;
            PG8_STAGE(PG8_SB(0, 1), b2 + hstep, voffB);
            PG8_WAIT_V(6); PG8_BAR; PG8_MMA(1, 1, At, B1); PG8_BAR;
            PG8_LDB(B0, 1, 0); PG8_SCHED; PG8_LDA(At, 1, 0); PG8_STAGE(PG8_SA(0, 1), a2 + hstep, voffA);
            PG8_WAIT_L(8); PG8_BAR; PG8_WAIT_L(0); PG8_MMA(0, 0, At, B0); PG8_BAR; PG8_SCHED;
            PG8_LDB(B1, 1, 1); PG8_STAGE(PG8_SB(1, 0), b3, voffB);
            PG8_BAR; PG8_WAIT_L(0); PG8_MMA(0, 1, At, B1); PG8_BAR;
            PG8_LDA(At, 1, 1); PG8_STAGE(PG8_SA(1, 0), a3, voffA);
            PG8_BAR; PG8_WAIT_L(0); PG8_MMA(1, 0, At, B0); PG8_BAR; PG8_SCHED;
            PG8_STAGE(PG8_SB(1, 1), b3 + hstep, voffB);
            PG8_WAIT_V(6); PG8_BAR; PG8_MMA(1, 1, At, B1); PG8_BAR;
            }
        }
        if constexpr (ALIGN_EPI) { if (wr == 0) PG8_BAR; }
        if constexpr (!Epi::AFTER_DRAIN) { E(acc, cur, wr, wc, fr, fq); S.done(cur); }
        if (!has_next) break;
#pragma unroll
        for (int a = 0; a < 2; ++a)
#pragma unroll
            for (int b = 0; b < 2; ++b)
#pragma unroll
                for (int m = 0; m < 4; ++m)
#pragma unroll
                    for (int n = 0; n < 2; ++n) acc[a][b][m][n] = (f32x4){0.f, 0.f, 0.f, 0.f};
        cur = nxt; cA = nA; cB = nB; ++ui;
        if constexpr (ALIGN_EPI) { if (wr == 1) PG8_BAR; }
    }
    PG8_WAIT_V(0);
    if constexpr (!ALIGN_EPI) { if (wr == 0) PG8_BAR; }
    PG8_BAR;
    if constexpr (Epi::AFTER_DRAIN) { E.fused(acc, cur, wr, wc, fr, fq, lds, wid, lane); S.done(cur); }
#undef PG8_SA
#undef PG8_SB
#undef PG8_STAGE
#undef PG8_LDA
#undef PG8_LDB
#undef PG8_MMA
#undef PG8_WAIT_V
#undef PG8_WAIT_L
#undef PG8_BAR
#undef PG8_SCHED
}
}

#define LAS __attribute__((address_space(3)))
typedef unsigned short bf16_t;
typedef short bf16x8 __attribute__((ext_vector_type(8)));
typedef short s16x4 __attribute__((ext_vector_type(4)));
typedef float f32x4 __attribute__((ext_vector_type(4)));
typedef float f32x2 __attribute__((ext_vector_type(2)));
typedef unsigned u32x4 __attribute__((ext_vector_type(4)));
typedef unsigned u32x2 __attribute__((ext_vector_type(2)));
typedef LAS unsigned char* lds_t;

constexpr int NT = 8192, DM = 2048, SEQ = 2048, NB = 4, DEPTH = 4;
constexpr int INW = 5144, NPROJ = 5376, FFH = 5632;
constexpr int PC_FQ = 0, PC_FK = 512, PC_FV = 1024, PC_GQ = 1536, PC_GK = 1792, PC_GV = 2048, PC_GG = 2560, PC_LG = 3072, PC_LX = 4096, PC_FF = 5120, PC_GR = 5128;
constexpr float EPS = 1e-6f;
constexpr float LOG2E = 1.4426950408889634f;
constexpr int LDS_BYTES = 147456;

constexpr size_t MiB = 1u << 20;
constexpr size_t WS_WIN = 0, WS_WOUT = 21 * MiB, WS_WGU = 29 * MiB, WS_WDN = 73 * MiB;
constexpr size_t WS_XW = 96 * MiB;
constexpr size_t WS_HB = 160 * MiB;
constexpr size_t WS_PROJ = 192 * MiB;
constexpr size_t WS_MIX = 360 * MiB;
constexpr size_t WS_FOXO = 392 * MiB;
constexpr size_t WS_CBUF = 400 * MiB;
constexpr size_t WS_GQT = 401 * MiB;
constexpr size_t WS_GA = 405 * MiB;
constexpr size_t WS_GVT = 407 * MiB;
constexpr size_t WS_GU = 415 * MiB;
constexpr size_t WS_GS = 447 * MiB;
constexpr size_t WS_GDEC = 463 * MiB;
constexpr size_t WS_LA = 464 * MiB;
constexpr size_t WS_LU = 496 * MiB;
constexpr size_t WS_AGP = 528 * MiB, WS_AGH = 529 * MiB, WS_HIN = 530 * MiB;
constexpr size_t WS_SS1 = 532 * MiB, WS_SS2 = 537 * MiB;
constexpr size_t WS_CTL = 531 * MiB, CTL_BYTES = 16384;
constexpr size_t WS_GWT = 541 * MiB;
constexpr size_t WS_SMALL = 542 * MiB, SMALL_BYTES = 10 * MiB;
constexpr size_t SL_CBUF = 0, SL_GDEC = 256 * 1024, SL_GWT = 512 * 1024, SL_AGP = 1 * MiB, SL_AGH = 2 * MiB, SL_HIN = 3 * MiB, SL_GQT = 4 * MiB, SL_GA = 8 * MiB;
constexpr size_t WS_QKV = 582 * MiB;
constexpr size_t WS_END = 614 * MiB;

#define GAS __attribute__((address_space(1)))
struct Params { const float* in[22]; float* out; GAS unsigned char* ws; GAS unsigned char* wsl; };

__device__ __forceinline__ unsigned pk2(float lo, float hi) { unsigned r; asm("v_cvt_pk_bf16_f32 %0, %1, %2" : "=v"(r) : "v"(lo), "v"(hi)); return r; }
__device__ __forceinline__ bf16_t f2bf(float f) { return (bf16_t)(pk2(f, 0.f) & 0xffffu); }
__device__ __forceinline__ float bf2f(unsigned b) { return __uint_as_float(b << 16); }
__device__ __forceinline__ float logsig(float x) { return fminf(x, 0.f) - __logf(1.0f + __expf(-fabsf(x))); }
__device__ __forceinline__ float sigmoidf(float x) { return __builtin_amdgcn_rcpf(1.0f + __expf(-x)); }
__device__ __forceinline__ float neg_expm1_small(float y) {
    const float pl = y * (1.0f + y * (0.5f + y * (0.16666667f + y * (0.041666668f + y * (0.0083333338f + y * (0.0013888889f + y * 0.00019841270f))))));
    return (y > -0.25f) ? -pl : (1.0f - __expf(y));
}
__device__ __forceinline__ f32x4 mfma16(bf16x8 a, bf16x8 b, f32x4 c) { return __builtin_amdgcn_mfma_f32_16x16x32_bf16(a, b, c, 0, 0, 0); }
__device__ __forceinline__ float wave_sum(float v) {
#pragma unroll
    for (int o = 1; o < 64; o <<= 1) v += __shfl_xor(v, o);
    return v;
}
__device__ __forceinline__ bf16x8 pack8(f32x4 a, f32x4 b) {
    u32x4 w; w.x = pk2(a[0], a[1]); w.y = pk2(a[2], a[3]); w.z = pk2(b[0], b[1]); w.w = pk2(b[2], b[3]);
    return __builtin_bit_cast(bf16x8, w);
}

template <int MODE>
__device__ __forceinline__ void wconv_item(const float* W0, const float* W1, int Nsrc, int K, bf16_t* Bt, int NG, int item, int lane, const float* gain) {
    const int kb = item / NG, nb = item - kb * NG;
    const int kg = lane >> 4, ng = lane & 15;
    const int np = nb * 64 + ng * 4, k = kb * 32 + kg * 8;
    const float* src = W0; int c = np;
    if (MODE == 0) { c = np < 1536 ? np : np < 3072 ? np + 8 : np < 5120 ? np + 24 : np < 5128 ? np - 5120 + 1536 : np < 5144 ? np - 5128 + 3080 : -1; }
    if (MODE == 2) { const int pn = np >> 8, j = np & 255; src = j < 128 ? W0 : W1; c = pn * 128 + (j & 127); }
    f32x4 v[8];
#pragma unroll
    for (int i = 0; i < 8; ++i) v[i] = (c >= 0) ? *(const f32x4*)(src + (size_t)(k + i) * Nsrc + c) : (f32x4){0.f, 0.f, 0.f, 0.f};
    if (gain) { const f32x4 g0 = *(const f32x4*)(gain + k), g1 = *(const f32x4*)(gain + k + 4);
#pragma unroll
        for (int i = 0; i < 4; ++i) { v[i] = v[i] * g0[i]; v[4 + i] = v[4 + i] * g1[i]; } }
#pragma unroll
    for (int j = 0; j < 4; ++j) {
        u32x4 o; o.x = pk2(v[0][j], v[1][j]); o.y = pk2(v[2][j], v[3][j]); o.z = pk2(v[4][j], v[5][j]); o.w = pk2(v[6][j], v[7][j]);
        *(u32x4*)(Bt + (size_t)(np + j) * K + k) = o;
    }
}

__device__ __forceinline__ void prep_row(const float* xrow, bf16_t* orow, float* ss, int row, int lane, const float* g) {
    const f32x4* xr = (const f32x4*)xrow + lane; const f32x4* gr = (const f32x4*)g + lane;
    f32x4 v[8]; float s = 0.f;
#pragma unroll
    for (int j = 0; j < 8; ++j) { v[j] = xr[64 * j]; s += (v[j][0] * v[j][0] + v[j][1] * v[j][1]) + (v[j][2] * v[j][2] + v[j][3] * v[j][3]); }
    s = wave_sum(s);
    if (lane < 32) ss[((size_t)(lane >> 2) * 8192 + row) * 4 + (lane & 3)] = (lane == 0) ? s : 0.f;
#pragma unroll
    for (int j = 0; j < 8; ++j) { const f32x4 y = v[j] * gr[64 * j]; u32x2 w; w.x = pk2(y[0], y[1]); w.y = pk2(y[2], y[3]); ((u32x2*)orow)[lane + 64 * j] = w; }
}
__device__ __forceinline__ void final_row(const float* xrow, const float* g, float* orow, float ss, int lane) {
    const f32x4* xr = (const f32x4*)xrow + lane; const f32x4* gr = (const f32x4*)g + lane;
    const float rstd = rsqrtf(ss * (1.0f / 2048.0f) + EPS);
#pragma unroll
    for (int j = 0; j < 8; ++j) ((f32x4*)orow)[lane + 64 * j] = xr[64 * j] * rstd * gr[64 * j];
}

__device__ __forceinline__ void phase_wconv(const Params& p, int l, int mask, int w, int nw, int lane) {
    GAS unsigned char* ws = p.ws;
    constexpr int I_IN = 64 * 84, I_OUT = 64 * 32, I_GU = 64 * 176, I_DN = 176 * 32;
    const float* w_in = p.in[2] + (size_t)l * DM * INW;
    const float* w_out = p.in[16] + (size_t)l * DM * DM;
    const float* w_gate = p.in[18] + (size_t)l * DM * FFH;
    const float* w_up = p.in[19] + (size_t)l * DM * FFH;
    const float* w_down = p.in[20] + (size_t)l * FFH * DM;
    if (mask & 1) for (int it = w; it < I_IN; it += nw) wconv_item<0>(w_in, w_in, INW, DM, (bf16_t*)(ws + WS_WIN), 84, it, lane, nullptr);
    if (mask & 2) for (int it = w; it < I_OUT; it += nw) wconv_item<1>(w_out, w_out, DM, DM, (bf16_t*)(ws + WS_WOUT), 32, it, lane, nullptr);
    if (mask & 4) for (int it = w; it < I_GU; it += nw) wconv_item<2>(w_gate, w_up, FFH, DM, (bf16_t*)(ws + WS_WGU), 176, it, lane, nullptr);
    if (mask & 8) for (int it = w; it < I_DN; it += nw) wconv_item<1>(w_down, w_down, DM, FFH, (bf16_t*)(ws + WS_WDN), 32, it, lane, nullptr);
}

__device__ __forceinline__ void fox_cumsum(const Params& p, int l, int seq, int lane) {
    const float* proj = (const float*)(p.ws + WS_PROJ);
    float* cbuf = (float*)(p.wsl + SL_CBUF);
    const int b = seq >> 3, h = seq & 7;
    const float bias = p.in[3][l * 8 + h];
    const float* src = proj + (size_t)(b * SEQ + lane * 32) * NPROJ + PC_FF + h;
    float s = 0.f;
    for (int i = 0; i < 32; ++i) s += logsig(src[(size_t)i * NPROJ] + bias);
    float incl = s;
#pragma unroll
    for (int o = 1; o < 64; o <<= 1) { const float t = __shfl_up(incl, o); if (lane >= o) incl += t; }
    float run = incl - s;
    float* dst = cbuf + seq * SEQ + lane * 32;
    for (int i = 0; i < 32; ++i) { run += logsig(src[(size_t)i * NPROJ] + bias); dst[i] = run * LOG2E; }
}

__device__ __forceinline__ void gate_wt_prep(const Params& p, int l, int gid) {
    if (gid < 2 * 16 * 64 * 64) {
        const int d = gid & 63, e = (gid >> 6) & 63, n = (gid >> 12) & 15, g = gid >> 16;
        const float* w = (g == 0 ? p.in[10] : p.in[12]) + ((size_t)(l * 16 + n) * 64 + d) * 64 + e;
        ((bf16_t*)(p.wsl + SL_GWT))[gid] = f2bf(*w);
    }
}

__device__ __forceinline__ void gla_prep_witem(const Params& p, int l, int ch, lds_t wl_in, int lane_in) {
    int lane = lane_in; asm volatile("" : "+v"(lane));
    unsigned wlo_ = 0; asm volatile("" : "+s"(wlo_)); lds_t wl = wl_in + wlo_;
    const float* proj = (const float*)(p.ws + WS_PROJ);
    const int bh = ch >> 6, n = ch & 63, b = bh >> 2, h = bh & 3;
    const int t0 = b * SEQ + n * 32;
    LAS bf16_t* Qs = (LAS bf16_t*)(wl);
    LAS bf16_t* Ks = (LAS bf16_t*)(wl + 4608);
    LAS bf16_t* KstT = (LAS bf16_t*)(wl);
    LAS bf16_t* VT = (LAS bf16_t*)(wl + 5120);
    const int r = lane & 15, q = lane >> 4;
    float bcum[32];
    {
        const float* w2 = p.in[5] + (size_t)l * 16 * 256 + h * 64 + lane;
        const float gb = p.in[6][l * 256 + h * 64 + lane];
        float w2r[16];
#pragma unroll
        for (int i = 0; i < 16; ++i) w2r[i] = w2[i * 256];
        LAS float* grs = (LAS float*)(wl);
        { const float* gsrc = proj + (size_t)(t0 + (lane >> 1)) * NPROJ + PC_GR + (lane & 1) * 8;
          const f32x4 g0 = *(const f32x4*)gsrc, g1 = *(const f32x4*)(gsrc + 4);
          *(LAS f32x4*)(grs + lane * 8) = g0; *(LAS f32x4*)(grs + lane * 8 + 4) = g1; }
        float run = 0.f;
#pragma unroll
        for (int t = 0; t < 32; ++t) {
            f32x4 gr4[4];
#pragma unroll
            for (int i = 0; i < 4; ++i) gr4[i] = *(LAS f32x4*)(grs + t * 16 + 4 * i);
            float z = gb;
#pragma unroll
            for (int i = 0; i < 16; ++i) z += gr4[i >> 2][i & 3] * w2r[i];
            run += logsig(z) * (1.0f / 16.0f);
            bcum[t] = run;
        }
        asm volatile("" ::: "memory");
    }
    const float bl = bcum[31];
    unsigned kstp[16];
    {
        bf16_t* qtg = (bf16_t*)(p.wsl + SL_GQT) + (size_t)t0 * 256 + h * 64 + lane;
        float ksprev = 0.f;
#pragma unroll
        for (int t = 0; t < 32; ++t) {
            const float* prow = proj + (size_t)(t0 + t) * NPROJ;
            const float gq = prow[PC_GQ + h * 64 + lane], gk = prow[PC_GK + h * 64 + lane];
            const float bv = bcum[t];
            const float qt = gq * 0.125f * __expf(bv), kt = gk * __expf(-bv), ks = gk * __expf(bl - bv);
            const bf16_t qb16 = f2bf(qt);
            Qs[t * 72 + lane] = qb16; Ks[t * 72 + lane] = f2bf(kt);
            qtg[(size_t)t * 256] = qb16;
            if (t & 1) kstp[t >> 1] = pk2(ksprev, ks); else ksprev = ks;
            if ((t & 7) == 7) asm volatile("" ::: "memory");
        }
        ((float*)(p.wsl + SL_GDEC))[ch * 64 + lane] = __expf(bl);
    }
    {
        bf16_t* ab = (bf16_t*)(p.wsl + SL_GA) + (size_t)ch * 1024;
#pragma unroll
        for (int tt = 0; tt < 2; ++tt)
#pragma unroll
            for (int st = 0; st < 2; ++st) {
                f32x4 acc = {0.f, 0.f, 0.f, 0.f};
#pragma unroll
                for (int ks = 0; ks < 2; ++ks) {
                    const bf16x8 a = *(LAS bf16x8*)(Qs + (16 * tt + r) * 72 + 32 * ks + 8 * q);
                    const bf16x8 bb = *(LAS bf16x8*)(Ks + (16 * st + r) * 72 + 32 * ks + 8 * q);
                    acc = mfma16(a, bb, acc);
                }
#pragma unroll
                for (int j = 0; j < 4; ++j) { const int t = 16 * tt + 4 * q + j, s = 16 * st + r; ab[t * 32 + s] = f2bf(s <= t ? acc[j] : 0.f); }
            }
    }
#pragma unroll
    for (int i = 0; i < 4; ++i) { u32x4 w; w.x = kstp[4 * i]; w.y = kstp[4 * i + 1]; w.z = kstp[4 * i + 2]; w.w = kstp[4 * i + 3]; *(LAS u32x4*)(KstT + lane * 40 + 8 * i) = w; }
#pragma unroll
    for (int vv = 0; vv < 2; ++vv) {
        const int v = lane + 64 * vv;
        const bf16_t* vp = (const bf16_t*)(p.ws + WS_QKV) + ((size_t)3 * NT + t0) * 512 + h * 128 + v;
        unsigned vw[16];
#pragma unroll
        for (int t = 0; t < 32; t += 2) vw[t >> 1] = (unsigned)vp[(size_t)t * 512] | ((unsigned)vp[(size_t)(t + 1) * 512] << 16);
        bf16_t* vg = (bf16_t*)(p.ws + WS_GVT) + (size_t)ch * 4096 + v * 32;
#pragma unroll
        for (int i = 0; i < 4; ++i) { u32x4 w; w.x = vw[4 * i]; w.y = vw[4 * i + 1]; w.z = vw[4 * i + 2]; w.w = vw[4 * i + 3]; *(LAS u32x4*)(VT + v * 40 + 8 * i) = w; *(u32x4*)(vg + 8 * i) = w; }
    }
    {
        float* ub = (float*)(p.ws + WS_GU) + (size_t)ch * 8192;
        bf16x8 kb[4];
#pragma unroll
        for (int dt = 0; dt < 4; ++dt) kb[dt] = *(LAS bf16x8*)(KstT + (16 * dt + r) * 40 + 8 * q);
#pragma unroll
        for (int w = 0; w < 8; ++w) {
            const bf16x8 a = *(LAS bf16x8*)(VT + (16 * w + r) * 40 + 8 * q);
#pragma unroll
            for (int dt = 0; dt < 4; ++dt) {
                const f32x4 acc = mfma16(a, kb[dt], (f32x4){0.f, 0.f, 0.f, 0.f});
#pragma unroll
                for (int j = 0; j < 4; ++j) ub[(16 * w + 4 * q + j) * 64 + 16 * dt + r] = acc[j];
            }
        }
    }
}

__device__ __forceinline__ void lru_prep_witem(const Params& p, int l, int item, lds_t wl_in, int lane_in) {
    int lane = lane_in; asm volatile("" : "+v"(lane));
    unsigned wlo_ = 0; asm volatile("" : "+s"(wlo_)); lds_t wl = wl_in + wlo_;
    const float* proj = (const float*)(p.ws + WS_PROJ);
    const int gt = item >> 4, n = item & 15, tok0 = gt * 32, b = tok0 >> 11, p0 = tok0 & 2047, c0 = n * 64;
    LAS bf16_t* Xs = (LAS bf16_t*)(wl);
    LAS float* Xf = (LAS float*)(wl + 4608);
    const int r = lane & 15, q = lane >> 4;
    {
        const int c = c0 + lane;
        const float* cw = p.in[8] + (size_t)l * 4 * 1024 + c;
        const float w0 = cw[0], w1 = cw[1024], w2 = cw[2048], w3 = cw[3072], cb = p.in[9][l * 1024 + c];
        const float* lxp = proj + (size_t)(b * SEQ) * NPROJ + PC_LX + c;
        float x0 = p0 >= 3 ? lxp[(size_t)(p0 - 3) * NPROJ] : 0.f, x1 = p0 >= 2 ? lxp[(size_t)(p0 - 2) * NPROJ] : 0.f, x2 = p0 >= 1 ? lxp[(size_t)(p0 - 1) * NPROJ] : 0.f;
        float xv[32];
#pragma unroll
        for (int i = 0; i < 32; ++i) xv[i] = lxp[(size_t)(p0 + i) * NPROJ];
#pragma unroll
        for (int i = 0; i < 32; ++i) {
            const float x3 = xv[i];
            const float y = cb + w0 * x0 + w1 * x1 + w2 * x2 + w3 * x3;
            Xf[i * 68 + lane] = y; Xs[i * 72 + lane] = f2bf(y);
            x0 = x1; x1 = x2; x2 = x3;
        }
    }
    const bf16_t* gwt = (const bf16_t*)(p.wsl + SL_GWT);
    bf16x8 af[2][2];
#pragma unroll
    for (int tt = 0; tt < 2; ++tt)
#pragma unroll
        for (int ks = 0; ks < 2; ++ks) af[tt][ks] = *(LAS bf16x8*)(Xs + (16 * tt + r) * 72 + 32 * ks + 8 * q);
    float* la = (float*)(p.ws + WS_LA); float* lu = (float*)(p.ws + WS_LU);
#pragma unroll
    for (int et = 0; et < 4; ++et) {
        bf16x8 ba[2], bi[2];
#pragma unroll
        for (int ks = 0; ks < 2; ++ks) { ba[ks] = *(const bf16x8*)(gwt + ((size_t)(0 * 16 + n) * 64 + 16 * et + r) * 64 + 32 * ks + 8 * q); bi[ks] = *(const bf16x8*)(gwt + ((size_t)(1 * 16 + n) * 64 + 16 * et + r) * 64 + 32 * ks + 8 * q); }
        const int e = 16 * et + r, c = c0 + e;
        const float bba = p.in[11][l * 1024 + c], bbi = p.in[13][l * 1024 + c], lls = logsig(p.in[14][l * 1024 + c]);
        float av[2][4], uv[2][4];
#pragma unroll
        for (int tt = 0; tt < 2; ++tt) {
            f32x4 pa = {0.f, 0.f, 0.f, 0.f}, pi = {0.f, 0.f, 0.f, 0.f};
#pragma unroll
            for (int ks = 0; ks < 2; ++ks) { pa = mfma16(af[tt][ks], ba[ks], pa); pi = mfma16(af[tt][ks], bi[ks], pi); }
#pragma unroll
            for (int j = 0; j < 4; ++j) {
                const int t = 16 * tt + 4 * q + j;
                const float rg = sigmoidf(pa[j] + bba), ig = sigmoidf(pi[j] + bbi);
                const float loga = 8.0f * rg * lls;
                const float a = __expf(loga);
                const float u = __builtin_amdgcn_sqrtf(fmaxf(neg_expm1_small(2.0f * loga), 0.f)) * (ig * Xf[t * 68 + e]);
                la[(size_t)(tok0 + t) * 1024 + c] = a; lu[(size_t)(tok0 + t) * 1024 + c] = u;
                av[tt][j] = a; uv[tt][j] = u;
            }
            asm volatile("" ::: "memory");
        }
        float P = 1.f, H = 0.f;
#pragma unroll
        for (int tt = 0; tt < 2; ++tt)
#pragma unroll
            for (int qq = 0; qq < 4; ++qq) {
                if (q == qq) {
#pragma unroll
                    for (int j = 0; j < 4; ++j) { H = av[tt][j] * H + uv[tt][j]; P *= av[tt][j]; }
                }
                P = __shfl(P, r + 16 * qq); H = __shfl(H, r + 16 * qq);
            }
        if (q == 0) { ((float*)(p.wsl + SL_AGP))[gt * 1024 + c] = P; ((float*)(p.wsl + SL_AGH))[gt * 1024 + c] = H; }
    }
}

__device__ __forceinline__ void fox_attn_unit(const Params& p, int bh, int qb, lds_t lds, int tid, int wave, int lane) {
    const float* proj = (const float*)(p.ws + WS_PROJ);
    const float* cb = (const float*)(p.wsl + SL_CBUF) + bh * SEQ;
    const int b = bh >> 3, h = bh & 7;
    LAS bf16_t* Ks = (LAS bf16_t*)(lds);
    LAS bf16_t* Vt = (LAS bf16_t*)(lds + 9216);
    LAS float* cks = (LAS float*)(lds + 18432);
    const int r = lane & 15, q = lane >> 4;
    const int q0 = qb * 128, qw0 = q0 + 16 * wave, nkv = 2 * (qb + 1);
    const float C2 = 0.125f * LOG2E;
    bf16x8 qf[2];
    {
        const bf16_t* qp = (const bf16_t*)(p.ws + WS_QKV) + (size_t)(b * SEQ + qw0 + r) * 512 + h * 64 + 8 * q;
#pragma unroll
        for (int ks = 0; ks < 2; ++ks) qf[ks] = *(const bf16x8*)(qp + 32 * ks);
    }
    const float cq = cb[qw0 + r];
    float m = -1e30f, lsum = 0.f;
    f32x4 o[4];
#pragma unroll
    for (int i = 0; i < 4; ++i) o[i] = (f32x4){0.f, 0.f, 0.f, 0.f};
    const int lrow = tid >> 3, lch = (tid & 7) * 8;
    const bf16_t* kbase = (const bf16_t*)(p.ws + WS_QKV) + ((size_t)NT + b * SEQ + lrow) * 512 + h * 64 + lch;
    const int vrow = tid & 63, vch = (tid >> 6) * 8;
    const bf16_t* vbase = (const bf16_t*)(p.ws + WS_QKV) + ((size_t)2 * NT + b * SEQ + vrow) * 512 + h * 64 + vch;
    bf16x8 kA = *(const bf16x8*)kbase, vA = *(const bf16x8*)vbase;
    float ckA = tid < 64 ? cb[tid] : 0.f;
    bf16x8 kB = *(const bf16x8*)(kbase + (size_t)64 * 512), vB = *(const bf16x8*)(vbase + (size_t)64 * 512);
    float ckB = tid < 64 ? cb[64 + tid] : 0.f;
    constexpr int FOXBUF = 18432 + 256;
#define FOX_WRITE(KK, VV, CK, bufi, jn) { \
        LAS bf16_t* KsW = (LAS bf16_t*)(lds + (bufi) * FOXBUF); LAS bf16_t* VtW = (LAS bf16_t*)(lds + (bufi) * FOXBUF + 9216); LAS float* cksW = (LAS float*)(lds + (bufi) * FOXBUF + 18432); \
        *(LAS bf16x8*)(KsW + lrow * 72 + lch) = KK; \
        _Pragma("unroll") for (int i = 0; i < 8; ++i) VtW[(vch + i) * 72 + vrow] = (bf16_t)VV[i]; \
        if (tid < 64) cksW[tid] = CK; \
        if ((jn) < nkv) { const size_t off = (size_t)(jn) * 64 * 512; \
            KK = *(const bf16x8*)(kbase + off); VV = *(const bf16x8*)(vbase + off); \
            if (tid < 64) CK = cb[(jn) * 64 + tid]; } }
    __syncthreads();
    FOX_WRITE(kA, vA, ckA, 0, 2)
    asm volatile("s_waitcnt lgkmcnt(0)\n\ts_barrier" ::: "memory");
    for (int j0 = 0; j0 < nkv; j0 += 2) {
        { const int j = j0;
          FOX_WRITE(kB, vB, ckB, 1, j + 3)
          LAS bf16_t* KsX = (LAS bf16_t*)(lds); LAS bf16_t* VtX = (LAS bf16_t*)(lds + 9216); LAS float* cksX = (LAS float*)(lds + 18432);
        if (64 * j <= qw0 + 15) {
            f32x4 s[4]; float mx = -INFINITY;
            bf16x8 kfr[4][2]; f32x4 ckr[4]; s16x4 vlo[4][2], vhi[4][2];
#pragma unroll
            for (int st = 0; st < 4; ++st) {
#pragma unroll
                for (int ks = 0; ks < 2; ++ks) kfr[st][ks] = *(LAS bf16x8*)(KsX + (16 * st + r) * 72 + 32 * ks + 8 * q);
                ckr[st] = *(LAS f32x4*)(cksX + 16 * st + 4 * q);
            }
#pragma unroll
            for (int ds = 0; ds < 4; ++ds)
#pragma unroll
                for (int ks = 0; ks < 2; ++ks) { vlo[ds][ks] = *(LAS s16x4*)(VtX + (16 * ds + r) * 72 + 32 * ks + 4 * q); vhi[ds][ks] = *(LAS s16x4*)(VtX + (16 * ds + r) * 72 + 32 * ks + 16 + 4 * q); }
#pragma unroll
            for (int st = 0; st < 4; ++st) {
                f32x4 acc = {0.f, 0.f, 0.f, 0.f};
#pragma unroll
                for (int ks = 0; ks < 2; ++ks) acc = mfma16(kfr[st][ks], qf[ks], acc);
                const f32x4 ck = ckr[st];
#pragma unroll
                for (int jj = 0; jj < 4; ++jj) {
                    const int kv = 64 * j + 16 * st + 4 * q + jj;
                    float sv = acc[jj] + (cq - ck[jj]);
                    if (64 * j + 63 > qw0) sv = (kv <= qw0 + r) ? sv : -INFINITY;
                    s[st][jj] = sv; mx = fmaxf(mx, sv);
                }
            }
            { const unsigned mu = __float_as_uint(mx); const auto s16 = __builtin_amdgcn_permlane16_swap(mu, mu, false, false); mx = fmaxf(__uint_as_float(s16[0]), __uint_as_float(s16[1]));
              const unsigned mv = __float_as_uint(mx); const auto s32 = __builtin_amdgcn_permlane32_swap(mv, mv, false, false); mx = fmaxf(__uint_as_float(s32[0]), __uint_as_float(s32[1])); }
            const float mnew = fmaxf(m, mx);
            const float alpha = __builtin_amdgcn_exp2f(m - mnew);
            m = mnew;
            float ps = 0.f;
#pragma unroll
            for (int st = 0; st < 4; ++st)
#pragma unroll
                for (int jj = 0; jj < 4; ++jj) { const float e = __builtin_amdgcn_exp2f(s[st][jj] - mnew); s[st][jj] = e; ps += e; }
            lsum = lsum * alpha + ps;
#pragma unroll
            for (int i = 0; i < 4; ++i) o[i] = o[i] * alpha;
            bf16x8 pf[2];
            pf[0] = pack8(s[0], s[1]); pf[1] = pack8(s[2], s[3]);
#pragma unroll
            for (int ds = 0; ds < 4; ++ds)
#pragma unroll
                for (int ks = 0; ks < 2; ++ks) {
                    const s16x4 lo = vlo[ds][ks], hi = vhi[ds][ks];
                    const bf16x8 a = {lo[0], lo[1], lo[2], lo[3], hi[0], hi[1], hi[2], hi[3]};
                    o[ds] = mfma16(a, pf[ks], o[ds]);
                }
        }
          asm volatile("s_waitcnt lgkmcnt(0)\n\ts_barrier" ::: "memory");
        }
        { const int j = j0 + 1;
          if (j + 1 < nkv) FOX_WRITE(kA, vA, ckA, 0, j + 3)
          LAS bf16_t* KsX = (LAS bf16_t*)(lds + FOXBUF); LAS bf16_t* VtX = (LAS bf16_t*)(lds + FOXBUF + 9216); LAS float* cksX = (LAS float*)(lds + FOXBUF + 18432);
        if (64 * j <= qw0 + 15) {
            f32x4 s[4]; float mx = -INFINITY;
            bf16x8 kfr[4][2]; f32x4 ckr[4]; s16x4 vlo[4][2], vhi[4][2];
#pragma unroll
            for (int st = 0; st < 4; ++st) {
#pragma unroll
                for (int ks = 0; ks < 2; ++ks) kfr[st][ks] = *(LAS bf16x8*)(KsX + (16 * st + r) * 72 + 32 * ks + 8 * q);
                ckr[st] = *(LAS f32x4*)(cksX + 16 * st + 4 * q);
            }
#pragma unroll
            for (int ds = 0; ds < 4; ++ds)
#pragma unroll
                for (int ks = 0; ks < 2; ++ks) { vlo[ds][ks] = *(LAS s16x4*)(VtX + (16 * ds + r) * 72 + 32 * ks + 4 * q); vhi[ds][ks] = *(LAS s16x4*)(VtX + (16 * ds + r) * 72 + 32 * ks + 16 + 4 * q); }
#pragma unroll
            for (int st = 0; st < 4; ++st) {
                f32x4 acc = {0.f, 0.f, 0.f, 0.f};
#pragma unroll
                for (int ks = 0; ks < 2; ++ks) acc = mfma16(kfr[st][ks], qf[ks], acc);
                const f32x4 ck = ckr[st];
#pragma unroll
                for (int jj = 0; jj < 4; ++jj) {
                    const int kv = 64 * j + 16 * st + 4 * q + jj;
                    float sv = acc[jj] + (cq - ck[jj]);
                    if (64 * j + 63 > qw0) sv = (kv <= qw0 + r) ? sv : -INFINITY;
                    s[st][jj] = sv; mx = fmaxf(mx, sv);
                }
            }
            { const unsigned mu = __float_as_uint(mx); const auto s16 = __builtin_amdgcn_permlane16_swap(mu, mu, false, false); mx = fmaxf(__uint_as_float(s16[0]), __uint_as_float(s16[1]));
              const unsigned mv = __float_as_uint(mx); const auto s32 = __builtin_amdgcn_permlane32_swap(mv, mv, false, false); mx = fmaxf(__uint_as_float(s32[0]), __uint_as_float(s32[1])); }
            const float mnew = fmaxf(m, mx);
            const float alpha = __builtin_amdgcn_exp2f(m - mnew);
            m = mnew;
            float ps = 0.f;
#pragma unroll
            for (int st = 0; st < 4; ++st)
#pragma unroll
                for (int jj = 0; jj < 4; ++jj) { const float e = __builtin_amdgcn_exp2f(s[st][jj] - mnew); s[st][jj] = e; ps += e; }
            lsum = lsum * alpha + ps;
#pragma unroll
            for (int i = 0; i < 4; ++i) o[i] = o[i] * alpha;
            bf16x8 pf[2];
            pf[0] = pack8(s[0], s[1]); pf[1] = pack8(s[2], s[3]);
#pragma unroll
            for (int ds = 0; ds < 4; ++ds)
#pragma unroll
                for (int ks = 0; ks < 2; ++ks) {
                    const s16x4 lo = vlo[ds][ks], hi = vhi[ds][ks];
                    const bf16x8 a = {lo[0], lo[1], lo[2], lo[3], hi[0], hi[1], hi[2], hi[3]};
                    o[ds] = mfma16(a, pf[ks], o[ds]);
                }
        }
          asm volatile("s_waitcnt lgkmcnt(0)\n\ts_barrier" ::: "memory");
        }
    }
#undef FOX_WRITE
    lsum += __shfl_xor(lsum, 16); lsum += __shfl_xor(lsum, 32);
    const float inv = 1.0f / lsum;
    bf16_t* op = (bf16_t*)(p.ws + WS_FOXO) + (size_t)(b * SEQ + qw0 + r) * 512 + h * 64 + 4 * q;
#pragma unroll
    for (int ds = 0; ds < 4; ++ds) { u32x2 w; w.x = pk2(o[ds][0] * inv, o[ds][1] * inv); w.y = pk2(o[ds][2] * inv, o[ds][3] * inv); *(u32x2*)(op + 16 * ds) = w; }
}

__device__ __forceinline__ void gla_scan_item(const Params& p, int item, int tid) {
    const int bh = item >> 4, e = (item & 15) * 512 + tid, d = e & 63;
    const float* ub = (const float*)(p.ws + WS_GU) + (size_t)bh * 64 * 8192 + e;
    const float* dec = (const float*)(p.wsl + SL_GDEC) + (size_t)bh * 64 * 64 + d;
    bf16_t* sp = (bf16_t*)(p.ws + WS_GS) + (size_t)bh * 64 * 8192 + e;
    float st = 0.f;
#pragma unroll
    for (int n0 = 0; n0 < 64; n0 += 32) {
        float u[32], dc[32];
#pragma unroll
        for (int n = 0; n < 32; ++n) { u[n] = ub[(size_t)(n0 + n) * 8192]; dc[n] = dec[(n0 + n) * 64]; }
#pragma unroll
        for (int n = 0; n < 32; ++n) { sp[(size_t)(n0 + n) * 8192] = f2bf(st); st = dc[n] * st + u[n]; }
    }
}

__device__ __forceinline__ void lru_tilescan_item(const Params& p, int item, int tid) {
    const int gid = item * 512 + tid, b = gid >> 10, c = gid & 1023;
    const float* P = (const float*)(p.wsl + SL_AGP) + (size_t)b * 64 * 1024 + c;
    const float* H = (const float*)(p.wsl + SL_AGH) + (size_t)b * 64 * 1024 + c;
    float* hi = (float*)(p.wsl + SL_HIN) + (size_t)b * 64 * 1024 + c;
    float h = 0.f;
#pragma unroll
    for (int t0 = 0; t0 < 64; t0 += 32) {
        float a[32], u[32];
#pragma unroll
        for (int t = 0; t < 32; ++t) { a[t] = P[(t0 + t) * 1024]; u[t] = H[(t0 + t) * 1024]; }
#pragma unroll
        for (int t = 0; t < 32; ++t) { hi[(t0 + t) * 1024] = h; h = a[t] * h + u[t]; }
    }
}

__device__ __forceinline__ void fox_norm_rows4(const Params& p, int l, int tok0, int stride, int lane) {
    u32x4 w[4];
#pragma unroll
    for (int k = 0; k < 4; ++k) w[k] = *(const u32x4*)((const bf16_t*)(p.ws + WS_FOXO) + (size_t)(tok0 + k * stride) * 512 + lane * 8);
    const float* g = p.in[4] + l * 512 + lane * 8;
    const f32x4 g0 = *(const f32x4*)g, g1 = *(const f32x4*)(g + 4);
#pragma unroll
    for (int k = 0; k < 4; ++k) {
        float v[8];
#pragma unroll
        for (int i = 0; i < 4; ++i) { v[2 * i] = bf2f(w[k][i] & 0xffffu); v[2 * i + 1] = bf2f(w[k][i] >> 16); }
        float s = 0.f;
#pragma unroll
        for (int i = 0; i < 8; ++i) s += v[i] * v[i];
        const float rstd = rsqrtf(wave_sum(s) * (1.0f / 512.0f) + EPS);
        u32x4 ow; ow.x = pk2(v[0] * rstd * g0[0], v[1] * rstd * g0[1]); ow.y = pk2(v[2] * rstd * g0[2], v[3] * rstd * g0[3]);
        ow.z = pk2(v[4] * rstd * g1[0], v[5] * rstd * g1[1]); ow.w = pk2(v[6] * rstd * g1[2], v[7] * rstd * g1[3]);
        *(u32x4*)((bf16_t*)(p.ws + WS_MIX) + (size_t)(tok0 + k * stride) * 2048 + lane * 8) = ow;
    }
}

__device__ __forceinline__ void gla_out_witem(const Params& p, int l, int item, int lane) {
    const float* proj = (const float*)(p.ws + WS_PROJ);
    const int ch = item >> 1, tt = item & 1;
    const int bh = ch >> 6, n = ch & 63, b = bh >> 2, h = bh & 3;
    const int t0 = b * SEQ + n * 32;
    const int r = lane & 15, q = lane >> 4;
    const bf16_t* ab = (const bf16_t*)(p.wsl + SL_GA) + (size_t)ch * 1024;
    const bf16_t* vt = (const bf16_t*)(p.ws + WS_GVT) + (size_t)ch * 4096;
    const bf16_t* qt = (const bf16_t*)(p.wsl + SL_GQT) + (size_t)t0 * 256 + h * 64;
    const bf16_t* sp = (const bf16_t*)(p.ws + WS_GS) + (size_t)ch * 8192;
    const bf16x8 aa = *(const bf16x8*)(ab + (16 * tt + r) * 32 + 8 * q);
    const bf16x8 aq0 = *(const bf16x8*)(qt + (size_t)(16 * tt + r) * 256 + 8 * q), aq1 = *(const bf16x8*)(qt + (size_t)(16 * tt + r) * 256 + 32 + 8 * q);
    f32x4 acc[8];
#pragma unroll
    for (int w = 0; w < 8; ++w) {
        const int v = 16 * w + r;
        const bf16x8 bv = *(const bf16x8*)(vt + v * 32 + 8 * q);
        const bf16x8 bs0 = *(const bf16x8*)(sp + v * 64 + 8 * q), bs1 = *(const bf16x8*)(sp + v * 64 + 32 + 8 * q);
        f32x4 c = mfma16(aa, bv, (f32x4){0.f, 0.f, 0.f, 0.f});
        c = mfma16(aq0, bs0, c); c = mfma16(aq1, bs1, c);
        acc[w] = c;
    }
    float tot[4] = {0.f, 0.f, 0.f, 0.f};
#pragma unroll
    for (int w = 0; w < 8; ++w)
#pragma unroll
        for (int j = 0; j < 4; ++j) {
            float s = acc[w][j] * acc[w][j];
            s += __shfl_xor(s, 1); s += __shfl_xor(s, 2); s += __shfl_xor(s, 4); s += __shfl_xor(s, 8);
            tot[j] += s;
        }
#pragma unroll
    for (int j = 0; j < 4; ++j) {
        const int t = 16 * tt + 4 * q + j;
        const float rstd = rsqrtf(tot[j] * (1.0f / 128.0f) + EPS);
        const float* ggp = proj + (size_t)(t0 + t) * NPROJ + PC_GG + h * 128 + r;
        bf16_t* mp = (bf16_t*)(p.ws + WS_MIX) + (size_t)(t0 + t) * 2048 + 512 + h * 128 + r;
#pragma unroll
        for (int w = 0; w < 8; ++w) {
            const float gn = p.in[7][l * 128 + 16 * w + r];
            const float gg = ggp[16 * w];
            const float y = acc[w][j] * rstd * gn * (gg * sigmoidf(gg));
            mp[16 * w] = f2bf(y);
        }
    }
}

__device__ __forceinline__ float gelu_tanh(float x) {
    const float u = 0.7978845608028654f * (x + 0.044715f * x * x * x);
    const float t = 1.0f - 2.0f * __builtin_amdgcn_rcpf(1.0f + __expf(2.0f * u));
    return 0.5f * x * (1.0f + t);
}

__device__ __forceinline__ void lru_out_item(const Params& p, int l, int gt, lds_t lds, int tid, int wave, int lane) {
    const float* proj = (const float*)(p.ws + WS_PROJ);
    const int tok0 = gt * 32, c = 2 * tid;
    LAS float* part = (LAS float*)(lds);
    LAS float* rs = (LAS float*)(lds + 65536);
    const f32x2* la = (const f32x2*)((const float*)(p.ws + WS_LA) + (size_t)tok0 * 1024 + c);
    const f32x2* lu = (const f32x2*)((const float*)(p.ws + WS_LU) + (size_t)tok0 * 1024 + c);
    const float* lgp = proj + (size_t)tok0 * NPROJ + PC_LG + c;
    f32x2 h = *(const f32x2*)((const float*)(p.wsl + SL_HIN) + (size_t)gt * 1024 + c);
    f32x2 y[32];
    {
        f32x2 av[32], uv[32];
#pragma unroll
        for (int t = 0; t < 32; ++t) { av[t] = la[t * 512]; uv[t] = lu[t * 512]; }
#pragma unroll
        for (int t = 0; t < 32; ++t) { h = av[t] * h + uv[t]; y[t] = h; }
    }
    {
        f32x2 gv[32];
#pragma unroll
        for (int t = 0; t < 32; ++t) gv[t] = *(const f32x2*)(lgp + (size_t)t * NPROJ);
#pragma unroll
        for (int t = 0; t < 32; ++t) {
            y[t][0] = y[t][0] * gelu_tanh(gv[t][0]); y[t][1] = y[t][1] * gelu_tanh(gv[t][1]);
            part[t * 512 + tid] = y[t][0] * y[t][0] + y[t][1] * y[t][1];
        }
    }
    __syncthreads();
    {
        const int t = tid >> 4, k0 = tid & 15;
        float s = 0.f;
#pragma unroll 8
        for (int k = 0; k < 32; ++k) s += part[t * 512 + k0 + 16 * k];
        s += __shfl_xor(s, 1); s += __shfl_xor(s, 2); s += __shfl_xor(s, 4); s += __shfl_xor(s, 8);
        if (k0 == 0) rs[t] = rsqrtf(s * (1.0f / 1024.0f) + EPS);
    }
    __syncthreads();
    const f32x2 g = *(const f32x2*)(p.in[15] + l * 1024 + c);
    bf16_t* mix = (bf16_t*)(p.ws + WS_MIX) + (size_t)tok0 * 2048 + 1024 + c;
#pragma unroll
    for (int t = 0; t < 32; ++t) { const float rr = rs[t]; *(unsigned*)(mix + (size_t)t * 2048) = pk2(y[t][0] * rr * g[0], y[t][1] * rr * g[1]); }
    __syncthreads();
}

#define XB_TMO      128
#define XB_XCNT(j)  (256  + 64 * (j))
#define XB_XSUB(j)  (1280 + 64 * (j))
#define XB_XGEN(j)  (2304 + 64 * (j))
#define XB_TOP      3328
#define XB_TOPGEN   3392
#define XCD_BAR_WORDS 3456
#define XB_SPIN_CAP (1u << 18)

__device__ __forceinline__ unsigned xb_ld(unsigned* p)              { return __hip_atomic_load(p, __ATOMIC_RELAXED, __HIP_MEMORY_SCOPE_AGENT); }
__device__ __forceinline__ unsigned xb_add(unsigned* p, unsigned v) { return __hip_atomic_fetch_add(p, v, __ATOMIC_RELAXED, __HIP_MEMORY_SCOPE_AGENT); }
__device__ __forceinline__ unsigned xb_xcc_id() { return (unsigned)__builtin_amdgcn_s_getreg((3 << 11) | 20) & 0xFu; }
#define XB_SPIN(cond, bar) do { unsigned _sp = 0; while (cond) { __builtin_amdgcn_s_sleep(1); \
    if ((++_sp & 255u) == 0u) { if (xb_ld(&(bar)[XB_TMO])) break; if (_sp > XB_SPIN_CAP) { atomicAdd(&(bar)[XB_TMO], 1u); break; } } } } while (0)

struct XcdBarrier {
    unsigned* bar; unsigned x;
    volatile LAS unsigned* st;
};

__device__ __forceinline__ XcdBarrier xcd_barrier_post(unsigned* bar, volatile LAS unsigned* st) {
    XcdBarrier b; b.bar = bar; b.x = xb_xcc_id(); b.st = st;
    if (threadIdx.x == 0) (void)xb_add(&bar[XB_XCNT(b.x)], 1u);
    return b;
}
__device__ __forceinline__ void xcd_barrier_complete(unsigned* bar, unsigned x, unsigned& nloc, unsigned& nx) {
    const unsigned G = gridDim.x * gridDim.y * gridDim.z;
    unsigned sum, cnt, mine, sp = 0u;
    for (;;) {
        sum = 0u; cnt = 0u; mine = 0u;
#pragma unroll
        for (unsigned j = 0; j < 16; ++j) { const unsigned c = xb_ld(&bar[XB_XCNT(j)]); sum += c; cnt += (c > 0u) ? 1u : 0u; mine = (j == x) ? c : mine; }
        if (sum == G) break;
        __builtin_amdgcn_s_sleep(1);
        if ((++sp & 255u) == 0u) { if (xb_ld(&bar[XB_TMO])) break; if (sp > XB_SPIN_CAP) { atomicAdd(&bar[XB_TMO], 1u); break; } }
    }
    nloc = mine > 0u ? mine : 1u; nx = cnt > 0u ? cnt : 1u;
}

__device__ __forceinline__ void xcd_barrier(const XcdBarrier& b) {
    asm volatile("s_waitcnt vmcnt(0)" ::: "memory");
    __syncthreads();
    if (threadIdx.x == 0) {
        unsigned* bar = b.bar;
        __builtin_amdgcn_s_waitcnt(0);
        unsigned nloc = b.st[0], nx = b.st[1];
        if (nloc == 0u) { xcd_barrier_complete(bar, b.x, nloc, nx); b.st[0] = nloc; b.st[1] = nx; }
        const unsigned old = xb_add(&bar[XB_XSUB(b.x)], 1u);
        const unsigned gen = old / nloc;
        if (old + 1u == (gen + 1u) * nloc) {
            __builtin_amdgcn_fence(__ATOMIC_RELEASE, "agent");
            asm volatile("s_waitcnt vmcnt(0)" ::: "memory");
            const unsigned og = xb_add(&bar[XB_TOP], 1u);
            const unsigned tg = og / nx;
            if (og + 1u == (tg + 1u) * nx) xb_add(&bar[XB_TOPGEN], 1u);
            else XB_SPIN(xb_ld(&bar[XB_TOPGEN]) == tg, bar);
            __builtin_amdgcn_fence(__ATOMIC_ACQUIRE, "agent");
            xb_add(&bar[XB_XGEN(b.x)], 1u);
            asm volatile("s_waitcnt vmcnt(0)" ::: "memory");
        } else {
            XB_SPIN(xb_ld(&bar[XB_XGEN(b.x)]) == gen, bar);
            __builtin_amdgcn_fence(__ATOMIC_ACQUIRE, "agent");
            asm volatile("s_waitcnt vmcnt(0)" ::: "memory");
        }
    }
    __syncthreads();
}

__global__ void __launch_bounds__(512, 2) hymba_fwd(Params p0) {
    extern __shared__ __attribute__((aligned(16))) unsigned char lds_raw[];
    cg::grid_group grid = cg::this_grid();
    const int G = gridDim.x, bid = blockIdx.x, ngw = G * 8;
    volatile LAS unsigned* bst = (volatile LAS unsigned*)((lds_t)lds_raw + (LDS_BYTES - 64));
    if (threadIdx.x < 16) bst[threadIdx.x] = 0u;
    __syncthreads();
    const XcdBarrier bar = xcd_barrier_post((unsigned*)(p0.ws + WS_CTL), bst);
#define PHASE_BEGIN \
    int tid = threadIdx.x; asm volatile("" : "+v"(tid)); \
    const int lane = tid & 63, wave = __builtin_amdgcn_readfirstlane(tid >> 6); \
    unsigned lo_ = 0; asm volatile("" : "+s"(lo_)); lds_t lds = (lds_t)lds_raw + lo_; \
    Params p = p0; asm volatile("" : "+s"(p.ws)); p.wsl = p.ws + WS_SMALL + (size_t)lcur * SMALL_BYTES; \
    GAS unsigned char* ws = p.ws; const int gw = bid * 8 + wave; (void)gw; (void)lane; (void)lds; (void)ws;

#pragma clang loop unroll(disable)
    for (int l = 0; l < DEPTH; ++l) {
        const int lcur = l;
        if (l == 0) {
            {
                PHASE_BEGIN
                phase_wconv(p, 0, 1, gw, ngw, lane);
                for (int m = gw; m < NT; m += ngw) prep_row(p.in[0] + (size_t)m * DM, (bf16_t*)(ws + WS_HB) + (size_t)m * DM, (float*)(ws + WS_SS1), m, lane, p.in[1]);
            }
            if (p0.ws == nullptr) grid.sync();
            xcd_barrier(bar);
        }
        {
            PHASE_BEGIN
            pg8::Gemm g{(const bf16_t*)(ws + WS_HB), (const bf16_t*)(ws + WS_WIN), NT, NPROJ, DM}; pg8::StaticOrder S; S.init(NT, NPROJ, G, bid);
            gate_wt_prep(p, l, bid * 512 + tid);
            pg8::rstd_table((LAS float*)(lds + 131072), (const float*)(ws + WS_SS1 + (size_t)l * MiB), S, tid);
            pg8::EpiStoreF32 E{(float*)(ws + WS_PROJ), NPROJ, (const LAS float*)(lds + 131072), 0, (bf16_t*)(ws + WS_QKV)};
            pg8::gemm_phase<pg8::EpiStoreF32, pg8::StaticOrder, true, true>(lds, g, S, E, tid);
            { const int nfull = (NT / 256) * (NPROJ / 256) % G; if (nfull > 0 && bid >= nfull) phase_wconv(p, l, 2 | 4, (bid - nfull) * 8 + wave, (G - nfull) * 8, lane); else if (nfull == 0) phase_wconv(p, l, 2 | 4, gw, ngw, lane); }
        }
        xcd_barrier(bar);
        {
            PHASE_BEGIN
            if (gw < 32) fox_cumsum(p, l, gw, lane);
            {
                lds_t wl = lds + wave * 18432;
                if (G == 256) {
                    if (wave < 4) { gla_prep_witem(p, l, bid * 4 + wave, wl, lane); lru_prep_witem(p, l, bid * 16 + wave, wl, lane); }
                    else for (int k = 0; k < 3; ++k) lru_prep_witem(p, l, bid * 16 + 4 + (wave - 4) * 3 + k, wl, lane);
                } else
                for (int it = gw; it < 1024 + 4096; it += ngw) {
                    if (it < 1024) gla_prep_witem(p, l, it, wl, lane);
                    else lru_prep_witem(p, l, it - 1024, wl, lane);
                }
            }
        }
        xcd_barrier(bar);
        {
            PHASE_BEGIN
            for (int it = bid; it < 256; it += G) {
                const int bh = it >> 3, s = it & 7;
                fox_attn_unit(p, bh, 15 - s, lds, tid, wave, lane);
                fox_attn_unit(p, bh, s, lds, tid, wave, lane);
            }
            for (int it = bid; it < 256; it += G) gla_scan_item(p, it, tid);
            for (int it = G - 1 - bid; it < 8; it += G) lru_tilescan_item(p, it, tid);
        }
        xcd_barrier(bar);
        {
            PHASE_BEGIN
            for (int it = bid; it < 256; it += G) lru_out_item(p, l, it, lds, tid, wave, lane);
            for (int it = gw; it < 2048; it += ngw) gla_out_witem(p, l, it, lane);
            if (NT % (4 * ngw) == 0) { for (int tok = gw; tok < NT; tok += 4 * ngw) fox_norm_rows4(p, l, tok, ngw, lane); }
            else for (int tok = gw; tok < NT; tok += ngw) fox_norm_rows4(p, l, tok, 0, lane);
        }
        xcd_barrier(bar);
        {
            PHASE_BEGIN
            const float* xin = (l == 0) ? p.in[0] : (const float*)(ws + WS_XW);
            pg8::Gemm g{(const bf16_t*)(ws + WS_MIX), (const bf16_t*)(ws + WS_WOUT), NT, DM, DM}; pg8::StaticOrder S; S.init(NT, DM, G, bid);
            pg8::EpiResid E{xin, (float*)(ws + WS_XW), (bf16_t*)(ws + WS_HB), (float*)(ws + WS_SS2 + (size_t)l * MiB), p.in[17] + l * DM, DM};
            pg8::gemm_phase<pg8::EpiResid, pg8::StaticOrder, true, true>(lds, g, S, E, tid);
        }
        xcd_barrier(bar);
        {
            PHASE_BEGIN
            pg8::Gemm g{(const bf16_t*)(ws + WS_HB), (const bf16_t*)(ws + WS_WGU), NT, 2 * FFH, DM}; pg8::StaticOrder S; S.init(NT, 2 * FFH, G, bid);
            pg8::rstd_table((LAS float*)(lds + 131072), (const float*)(ws + WS_SS2 + (size_t)l * MiB), S, tid);
            pg8::EpiSwiglu E{(bf16_t*)(ws + WS_PROJ), FFH, (const LAS float*)(lds + 131072), 0};
            pg8::gemm_phase<pg8::EpiSwiglu, pg8::StaticOrder, true, true>(lds, g, S, E, tid);
            { const int nfull = (NT / 256) * (2 * FFH / 256) % G; const int msk = 8 | (l + 1 < DEPTH ? 1 : 0); const int ln = (l + 1 < DEPTH) ? l + 1 : l;
              if (nfull > 0 && bid >= nfull) { phase_wconv(p, l, 8, (bid - nfull) * 8 + wave, (G - nfull) * 8, lane); if (msk & 1) phase_wconv(p, ln, 1, (bid - nfull) * 8 + wave, (G - nfull) * 8, lane); }
              else if (nfull == 0) { phase_wconv(p, l, 8, gw, ngw, lane); if (msk & 1) phase_wconv(p, ln, 1, gw, ngw, lane); } }
        }
        xcd_barrier(bar);
        {
            PHASE_BEGIN
            pg8::Gemm g{(const bf16_t*)(ws + WS_PROJ), (const bf16_t*)(ws + WS_WDN), NT, DM, FFH}; pg8::StaticOrder S; S.init(NT, DM, G, bid);
            pg8::EpiResid E{(const float*)(ws + WS_XW), (float*)(ws + WS_XW), (l < DEPTH - 1) ? (bf16_t*)(ws + WS_HB) : (bf16_t*)nullptr, (float*)(ws + WS_SS1 + (size_t)(l + 1) * MiB), p.in[1] + (l < DEPTH - 1 ? l + 1 : 0) * DM, DM};
            pg8::gemm_phase<pg8::EpiResid, pg8::StaticOrder, true, true>(lds, g, S, E, tid);
        }
        xcd_barrier(bar);
    }
    {
        const int lcur = 0;
        PHASE_BEGIN
        for (int m = gw; m < NT; m += ngw) { const float sv = wave_sum(lane < 32 ? ((const float*)(ws + WS_SS1 + (size_t)DEPTH * MiB))[((size_t)(lane >> 2) * 8192 + m) * 4 + (lane & 3)] : 0.f);
            final_row((const float*)(ws + WS_XW) + (size_t)m * DM, p.in[21], p.out + (size_t)m * DM, sv, lane); }
    }
}

extern "C" void kernel_launch(void* const* d_in, const int* in_sizes, int n_in, void* d_out, int out_size, void* d_ws, size_t ws_size, hipStream_t stream) {
    static int grid_blocks = 0;
    if (grid_blocks == 0) {
        if (n_in != 22 || ws_size < WS_END) { fprintf(stderr, "kernel_launch: unexpected n_in %d / ws_size %zu\n", n_in, ws_size); grid_blocks = -1; return; }
        int dev = 0, cus = 0, per_cu = 0;
        hipGetDevice(&dev);
        hipDeviceGetAttribute(&cus, hipDeviceAttributeMultiprocessorCount, dev);
        hipFuncSetAttribute((const void*)hymba_fwd, hipFuncAttributeMaxDynamicSharedMemorySize, LDS_BYTES);
        hipOccupancyMaxActiveBlocksPerMultiprocessor(&per_cu, (const void*)hymba_fwd, 512, LDS_BYTES);
        if (per_cu < 1) { fprintf(stderr, "kernel_launch: occupancy query says %d blocks per CU\n", per_cu); per_cu = 1; }
        (void)hipGetLastError();
        grid_blocks = cus * 1;
    }
    if (grid_blocks < 0) return;
    Params p{};
    for (int i = 0; i < 22; ++i) p.in[i] = (const float*)d_in[i];
    p.out = (float*)d_out; p.ws = (GAS unsigned char*)d_ws;
    if (hipMemsetAsync((unsigned char*)d_ws + WS_CTL, 0, CTL_BYTES, stream) != hipSuccess) { fprintf(stderr, "kernel_launch: memset failed\n"); return; }
    void* args[] = {&p};
    hipError_t e = hipLaunchCooperativeKernel((const void*)hymba_fwd, dim3(grid_blocks), dim3(512), args, LDS_BYTES, stream);
    if (e != hipSuccess) fprintf(stderr, "cooperative launch failed: %s (grid %d)\n", hipGetErrorString(e), grid_blocks);
}
```

```cpp
#include <hip/hip_runtime.h>
#include <hip/hip_cooperative_groups.h>
#include <cstdio>
#include <cstdint>
namespace cg = cooperative_groups;
namespace pg8 {
#define PG8_LAS __attribute__((address_space(3)))
typedef unsigned short bf16_t;
typedef short bf16x8 __attribute__((ext_vector_type(8)));
typedef float f32x4 __attribute__((ext_vector_type(4)));
typedef unsigned u32x4 __attribute__((ext_vector_type(4)));
constexpr int BM = 256, BK = 64, HALF = 128, HTB = HALF * BK * 2  , STAGE_BYTES = 8 * HTB, NXCD = 8, WGM = 8;

__host__ __device__ __forceinline__ int lds_byte(int r, int c) { const int st = (r >> 4) * 2 + (c >> 5), rr = r & 15, cc = c & 31, ob = rr * 64 + cc * 2; return st * 1024 + (ob ^ (((ob >> 9) & 1) << 5)); }
__host__ __device__ __forceinline__ void stage_rc(int b, int& R, int& C) { const int st = b / 1024, sb = b % 1024, swz = sb ^ (((sb >> 9) & 1) << 5); R = (st >> 1) * 16 + swz / 64; C = (st & 1) * 32 + (swz % 64) / 2; }
__host__ __device__ __forceinline__ int perm32(int rho) { const int n = rho >> 4, i = rho & 15; return 8 * (i >> 2) + 4 * n + (i & 3); }

struct Unit { int pm, pn; };
struct Gemm { const bf16_t* A; const bf16_t* Bt; int M, N, K; };

struct StaticOrder {
    int nM, nN, nwg, G, c;
    __host__ __device__ void init(int M, int N, int G_, int c_) { nM = M / BM; nN = N / BM; nwg = nM * nN; G = G_; c = c_; }
    __host__ __device__ bool next(int i, Unit& u) const {
        const long L = (long)i * G + c; if (L >= nwg) return false;
        int wgid = (int)L; { const int q = nwg / NXCD, r = nwg % NXCD, xcd = wgid % NXCD, off = wgid / NXCD; wgid = (xcd < r ? xcd * (q + 1) : r * (q + 1) + (xcd - r) * q) + off; }
        const int nig = WGM * nN, gid = wgid / nig, fm = gid * WGM, gsz = (nM - fm) < WGM ? (nM - fm) : WGM;
        u.pm = fm + ((wgid % nig) % gsz); u.pn = (wgid % nig) / gsz; return true;
    }
    __device__ __forceinline__ void a_ready(const Unit&) const {}
    __device__ __forceinline__ void done(const Unit&) const {}
};

typedef unsigned u32x2 __attribute__((ext_vector_type(2)));
__device__ __forceinline__ unsigned cvt_pk_bf16(float lo, float hi) { unsigned r; asm("v_cvt_pk_bf16_f32 %0, %1, %2" : "=v"(r) : "v"(lo), "v"(hi)); return r; }
__device__ __forceinline__ float ssp_sum(const float* p, int row) {
    float s = 0.f;
#pragma unroll
    for (int i = 0; i < 8; ++i) { const f32x4 v = *(const f32x4*)(p + ((size_t)i * 8192 + row) * 4); s += (v[0] + v[1]) + (v[2] + v[3]); }
    return s;
}
template <class Sched> __device__ __forceinline__ void rstd_table(PG8_LAS float* rtab, const float* ss, const Sched& S, int tid) {
    float v[4]; bool ok[4];
#pragma unroll
    for (int k = 0; k < 4; ++k) { const int i = 2 * k + (tid >> 8); Unit u; ok[k] = S.next(i, u); v[k] = ok[k] ? ssp_sum(ss, u.pm * BM + (tid & 255)) : 0.f; }
#pragma unroll
    for (int k = 0; k < 4; ++k) if (ok[k]) rtab[(2 * k + (tid >> 8)) * 256 + (tid & 255)] = rsqrtf(v[k] * (1.0f / 2048.0f) + 1e-6f);
    __syncthreads();
}
#define PG8_ROW_RSTD(rs, ss, row0) float rs[2][4]; { const int lane_ = (int)(threadIdx.x & 63u); \
    const float v0_ = rsqrtf(ssp_sum((ss), (row0) + (lane_ >> 4) * 16) * (1.0f / 2048.0f) + 1e-6f), v1_ = rsqrtf(ssp_sum((ss), (row0) + HALF + (lane_ >> 4) * 16) * (1.0f / 2048.0f) + 1e-6f); \
    _Pragma("unroll") for (int m_ = 0; m_ < 4; ++m_) { rs[0][m_] = __shfl(v0_, (lane_ & 15) + 16 * m_); rs[1][m_] = __shfl(v1_, (lane_ & 15) + 16 * m_); } }
struct EpiStoreF32 {
    static constexpr bool PERM = false, AFTER_DRAIN = false;
    float* O; int ldc; const PG8_LAS float* rtab; mutable int ui;
    bf16_t* qkv;
    __device__ __forceinline__ void operator()(const f32x4 (&acc)[2][2][4][2], const Unit& u, int wr, int wc, int fr, int fq) const {
        const int row0 = u.pm * BM + wr * 64 + fr, col0 = u.pn * BM + wc * 32 + 4 * fq;
        const PG8_LAS float* rt = rtab + ui * 256 + wr * 64 + fr; ++ui;
#pragma unroll
        for (int ai = 0; ai < 2; ++ai)
#pragma unroll
            for (int m = 0; m < 4; ++m) { const int row = row0 + ai * HALF + m * 16; float* rowp = O + (size_t)row * ldc + col0;
                const float rs = rt[ai * HALF + m * 16];
                if (u.pn < 6 || (u.pn >> 1) == 4) {
                    const float sc = (u.pn < 2) ? 0.125f * 1.4426950408889634f : 1.0f;
                    bf16_t* bp = qkv + ((size_t)(u.pn < 6 ? (u.pn >> 1) : 3) * 8192 + row) * 512 + (u.pn & 1) * 256 + wc * 32 + 4 * fq;
#pragma unroll
                    for (int bj = 0; bj < 2; ++bj)
#pragma unroll
                        for (int n = 0; n < 2; ++n) { f32x4 v = acc[ai][bj][m][n] * rs; if (u.pn < 2) v = v * sc;
                            u32x2 w; w.x = cvt_pk_bf16(v[0], v[1]); w.y = cvt_pk_bf16(v[2], v[3]); *(u32x2*)(bp + bj * HALF + n * 16) = w; }
                } else {
#pragma unroll
                for (int bj = 0; bj < 2; ++bj)
#pragma unroll
                    for (int n = 0; n < 2; ++n) *(f32x4*)(rowp + bj * HALF + n * 16) = acc[ai][bj][m][n] * rs; } }
    }
};
struct EpiResid {
    static constexpr bool PERM = false, AFTER_DRAIN = false;
    const float* base; float* out; bf16_t* xb; float* ss; const float* gain; int ldc;
    __device__ __forceinline__ void operator()(const f32x4 (&acc)[2][2][4][2], const Unit& u, int wr, int wc, int fr, int fq) const {
        const int row0 = u.pm * BM + wr * 64 + fr, col0 = u.pn * BM + wc * 32 + 4 * fq;
        f32x4 gv[2][2];
#pragma unroll
        for (int bj = 0; bj < 2; ++bj)
#pragma unroll
            for (int n = 0; n < 2; ++n) gv[bj][n] = *(const f32x4*)(gain + col0 + bj * HALF + n * 16);
#pragma unroll
        for (int ai = 0; ai < 2; ++ai) {
            f32x4 pre[4][2][2];
#pragma unroll
            for (int m = 0; m < 4; ++m)
#pragma unroll
                for (int bj = 0; bj < 2; ++bj)
#pragma unroll
                    for (int n = 0; n < 2; ++n) pre[m][bj][n] = *(const f32x4*)(base + (size_t)(row0 + ai * HALF + m * 16) * ldc + col0 + bj * HALF + n * 16);
#pragma unroll
            for (int m = 0; m < 4; ++m) { const int row = row0 + ai * HALF + m * 16; const size_t off = (size_t)row * ldc + col0; float s = 0.f;
#pragma unroll
                for (int bj = 0; bj < 2; ++bj)
#pragma unroll
                    for (int n = 0; n < 2; ++n) { const f32x4 b = pre[m][bj][n]; const f32x4 v = b + acc[ai][bj][m][n];
                        *(f32x4*)(out + off + bj * HALF + n * 16) = v; s += (v[0] * v[0] + v[1] * v[1]) + (v[2] * v[2] + v[3] * v[3]);
                        if (xb) { const f32x4 y = v * gv[bj][n]; u32x2 w; w.x = cvt_pk_bf16(y[0], y[1]); w.y = cvt_pk_bf16(y[2], y[3]); *(u32x2*)(xb + off + bj * HALF + n * 16) = w; } }
                s += __shfl_xor(s, 16); s += __shfl_xor(s, 32);
                if (fq == 0) ss[((size_t)u.pn * 8192 + row) * 4 + wc] = s; }
            asm volatile("" ::: "memory");
        }
    }
};
struct EpiSwiglu {
    static constexpr bool PERM = true, AFTER_DRAIN = false;
    bf16_t* O; int ldc; const PG8_LAS float* rtab; mutable int ui;
    __device__ __forceinline__ void operator()(const f32x4 (&acc)[2][2][4][2], const Unit& u, int wr, int wc, int fr, int fq) const {
        const int row0 = u.pm * BM + wr * 64 + fr, col0 = u.pn * HALF + wc * 32 + 8 * fq;
        const PG8_LAS float* rt = rtab + ui * 256 + wr * 64 + fr; ++ui;
#pragma unroll
        for (int ai = 0; ai < 2; ++ai)
#pragma unroll
            for (int m = 0; m < 4; ++m) {
                const float rs = rt[ai * HALF + m * 16];
                float h[8];
#pragma unroll
                for (int n = 0; n < 2; ++n)
#pragma unroll
                    for (int e = 0; e < 4; ++e) { const float g = acc[ai][0][m][n][e] * rs, up = acc[ai][1][m][n][e] * rs; h[n * 4 + e] = g * __builtin_amdgcn_rcpf(1.0f + __builtin_amdgcn_exp2f(g * -1.4426950408889634f)) * up; }
                u32x4 w; w.x = cvt_pk_bf16(h[0], h[1]); w.y = cvt_pk_bf16(h[2], h[3]); w.z = cvt_pk_bf16(h[4], h[5]); w.w = cvt_pk_bf16(h[6], h[7]);
                *(u32x4*)(O + (size_t)(row0 + ai * HALF + m * 16) * ldc + col0) = w; }
    }
};
template <class Epi, class Sched, bool ALIGN_EPI = false, bool SP2 = false>
__device__ __forceinline__ void gemm_phase(PG8_LAS unsigned char* lds, const Gemm g, const Sched& S, const Epi& E, const int tid) {
    const int wid = __builtin_amdgcn_readfirstlane(tid >> 6), lane = tid & 63, wr = wid >> 2, wc = wid & 3, fr = lane & 15, fq = lane >> 4;
    const int K = g.K, nt = K / BK;
    unsigned voffA[2], voffB[2];
#pragma unroll
    for (int i = 0; i < 2; ++i) { int R, C; stage_rc(tid * 16 + i * 8192, R, C); const int Rb = Epi::PERM ? ((R & ~31) + perm32(R & 31)) : R;
        voffA[i] = (unsigned)(R * K + C) * 2u; voffB[i] = (unsigned)(Rb * K + C) * 2u; }
    const size_t kstep = (size_t)(BK * 2);
    const size_t hstep = (size_t)HALF * K * 2;
    const size_t tstep = 2 * hstep;
    const unsigned ldsw = (unsigned)wid * 1024u;
    const int aoff = lds_byte(wr * 64 + fr, fq * 8), boff = lds_byte(wc * 32 + fr, fq * 8);
#define PG8_SA(b, h) (((b) * 2 + (h)) * HTB)
#define PG8_SB(b, h) ((4 + (b) * 2 + (h)) * HTB)
#define PG8_STAGE(bufoff, gbase, voff) do { _Pragma("unroll") for (int _i = 0; _i < 2; ++_i) \
        __builtin_amdgcn_global_load_lds((const unsigned*)((const char*)(gbase) + (voff)[_i]), (PG8_LAS unsigned*)(lds + (bufoff) + ldsw + _i * 8192), 16, 0, 0); } while (0)
#define PG8_LDA(dst, b, h) do { _Pragma("unroll") for (int m = 0; m < 4; ++m) _Pragma("unroll") for (int k = 0; k < 2; ++k) dst[m][k] = *(const PG8_LAS bf16x8*)(lds + PG8_SA(b, h) + aoff + m * 2048 + k * 1024); } while (0)
#define PG8_LDB(dst, b, h) do { _Pragma("unroll") for (int n = 0; n < 2; ++n) _Pragma("unroll") for (int k = 0; k < 2; ++k) dst[n][k] = *(const PG8_LAS bf16x8*)(lds + PG8_SB(b, h) + boff + n * 2048 + k * 1024); } while (0)
#define PG8_MMA(ai, bj, At, Bt) do { __builtin_amdgcn_s_setprio(1); _Pragma("unroll") for (int m = 0; m < 4; ++m) _Pragma("unroll") for (int n = 0; n < 2; ++n) _Pragma("unroll") for (int k = 0; k < 2; ++k) \
        acc[ai][bj][m][n] = __builtin_amdgcn_mfma_f32_16x16x32_bf16(Bt[n][k], At[m][k], acc[ai][bj][m][n], 0, 0, 0); __builtin_amdgcn_s_setprio(0); } while (0)
#define PG8_WAIT_V(n) asm volatile("s_waitcnt vmcnt(" #n ")" ::: "memory")
#define PG8_WAIT_L(n) asm volatile("s_waitcnt lgkmcnt(" #n ")" ::: "memory")
#define PG8_BAR __builtin_amdgcn_s_barrier()
#define PG8_SCHED __builtin_amdgcn_sched_barrier(0)
    Unit cur, nxt; int ui = 0;
    if (!S.next(0, cur)) return;
    f32x4 acc[2][2][4][2];
#pragma unroll
    for (int a = 0; a < 2; ++a)
#pragma unroll
        for (int b = 0; b < 2; ++b)
#pragma unroll
            for (int m = 0; m < 4; ++m)
#pragma unroll
                for (int n = 0; n < 2; ++n) acc[a][b][m][n] = (f32x4){0.f, 0.f, 0.f, 0.f};
    bf16x8 At[4][2], B0[2][2], B1[2][2];
    const char* cA = (const char*)g.A + (size_t)cur.pm * tstep; const char* cB = (const char*)g.Bt + (size_t)cur.pn * tstep;
    S.a_ready(cur);
    if constexpr (SP2) {
        PG8_STAGE(PG8_SB(0, 0), cB, voffB); PG8_STAGE(PG8_SB(0, 1), cB + hstep, voffB); PG8_STAGE(PG8_SA(0, 0), cA, voffA); PG8_STAGE(PG8_SA(0, 1), cA + hstep, voffA);
        if (wr == 1) PG8_BAR;
        PG8_WAIT_V(2); PG8_BAR;
        PG8_STAGE(PG8_SB(1, 0), cB + kstep, voffB); PG8_STAGE(PG8_SA(1, 0), cA + kstep, voffA); PG8_STAGE(PG8_SB(1, 1), cB + hstep + kstep, voffB);
        PG8_WAIT_V(6); PG8_BAR;
    } else {
        PG8_STAGE(PG8_SB(0, 0), cB, voffB); PG8_STAGE(PG8_SA(0, 0), cA, voffA); PG8_STAGE(PG8_SB(0, 1), cB + hstep, voffB); PG8_STAGE(PG8_SA(0, 1), cA + hstep, voffA);
        if (wr == 1) PG8_BAR;
        PG8_WAIT_V(4); PG8_BAR;
        PG8_STAGE(PG8_SB(1, 0), cB + kstep, voffB); PG8_STAGE(PG8_SA(1, 0), cA + kstep, voffA); PG8_STAGE(PG8_SB(1, 1), cB + hstep + kstep, voffB);
        PG8_WAIT_V(6); PG8_BAR;
    }
    for (;;) {
        const bool has_next = S.next(ui + 1, nxt);
        const char* nA = has_next ? (const char*)g.A + (size_t)nxt.pm * tstep : cA; const char* nB = has_next ? (const char*)g.Bt + (size_t)nxt.pn * tstep : cB;
        for (int t = 0; t < nt; t += 2) {
            const bool last = (t == nt - 2);
            const char* a1 = cA + (size_t)(t + 1) * kstep;
            const char* a2 = last ? nA : cA + (size_t)(t + 2) * kstep; const char* b2 = last ? nB : cB + (size_t)(t + 2) * kstep;
            const char* a3 = a2 + kstep; const char* b3 = b2 + kstep;
            if (last && has_next) S.a_ready(nxt);
            if constexpr (SP2) {
            PG8_LDB(B0, 0, 0); PG8_LDB(B1, 0, 1); PG8_SCHED; PG8_LDA(At, 0, 0); PG8_STAGE(PG8_SA(1, 1), a1 + hstep, voffA);
            PG8_WAIT_V(8); PG8_WAIT_L(0); PG8_BAR; PG8_MMA(0, 0, At, B0); PG8_MMA(0, 1, At, B1); PG8_BAR; PG8_SCHED;
            PG8_LDA(At, 0, 1); PG8_STAGE(PG8_SB(0, 0), b2, voffB); PG8_STAGE(PG8_SB(0, 1), b2 + hstep, voffB); PG8_STAGE(PG8_SA(0, 0), a2, voffA);
            PG8_WAIT_V(8); PG8_WAIT_L(0); PG8_BAR; PG8_MMA(1, 0, At, B0); PG8_MMA(1, 1, At, B1); PG8_BAR; PG8_SCHED;
            PG8_LDB(B0, 1, 0); PG8_LDB(B1, 1, 1); PG8_SCHED; PG8_LDA(At, 1, 0); PG8_STAGE(PG8_SA(0, 1), a2 + hstep, voffA);
            PG8_WAIT_V(8); PG8_WAIT_L(0); PG8_BAR; PG8_MMA(0, 0, At, B0); PG8_MMA(0, 1, At, B1); PG8_BAR; PG8_SCHED;
            PG8_LDA(At, 1, 1); PG8_STAGE(PG8_SB(1, 0), b3, voffB); PG8_STAGE(PG8_SB(1, 1), b3 + hstep, voffB); PG8_STAGE(PG8_SA(1, 0), a3, voffA);
            PG8_WAIT_V(8); PG8_WAIT_L(0); PG8_BAR; PG8_MMA(1, 0, At, B0); PG8_MMA(1, 1, At, B1); PG8_BAR; PG8_SCHED;
            } else {
            PG8_LDB(B0, 0, 0); PG8_SCHED; PG8_LDA(At, 0, 0); PG8_STAGE(PG8_SA(1, 1), a1 + hstep, voffA);
            PG8_WAIT_L(8); PG8_BAR; PG8_WAIT_L(0); PG8_MMA(0, 0, At, B0); PG8_BAR; PG8_SCHED;
            PG8_LDB(B1, 0, 1); PG8_STAGE(PG8_SB(0, 0), b2, voffB);
            PG8_BAR; PG8_WAIT_L(0); PG8_MMA(0, 1, At, B1); PG8_BAR;
            PG8_LDA(At, 0, 1); PG8_STAGE(PG8_SA(0, 0), a2, voffA);
            PG8_BAR; PG8_WAIT_L(0); PG8_MMA(1, 0, At, B0); PG8_BAR; PG8_SCHED;
            PG8_STAGE(PG8_SB(0, 1), b2 + hstep, voffB);
            PG8_WAIT_V(6); PG8_BAR; PG8_MMA(1, 1, At, B1); PG8_BAR;
            PG8_LDB(B0, 1, 0); PG8_SCHED; PG8_LDA(At, 1, 0); PG8_STAGE(PG8_SA(0, 1), a2 + hstep, voffA);
            PG8_WAIT_L(8); PG8_BAR; PG8_WAIT_L(0); PG8_MMA(0, 0, At, B0); PG8_BAR; PG8_SCHED;
            PG8_LDB(B1, 1, 1); PG8_STAGE(PG8_SB(1, 0), b3, voffB);
            PG8_BAR; PG8_WAIT_L(0); PG8_MMA(0, 1, At, B1); PG8_BAR;
            PG8_LDA(At, 1, 1); PG8_STAGE(PG8_SA(1, 0), a3, voffA);
            PG8_BAR; PG8_WAIT_L(0); PG8_MMA(1, 0, At, B0); PG8_BAR; PG8_SCHED;
            PG8_STAGE(PG8_SB(1, 1), b3 + hstep, voffB);
            PG8_WAIT_V(6); PG8_BAR; PG8_MMA(1, 1, At, B1); PG8_BAR;
            }
        }
        if constexpr (ALIGN_EPI) { if (wr == 0) PG8_BAR; }
        if constexpr (!Epi::AFTER_DRAIN) { E(acc, cur, wr, wc, fr, fq); S.done(cur); }
        if (!has_next) break;
#pragma unroll
        for (int a = 0; a < 2; ++a)
#pragma unroll
            for (int b = 0; b < 2; ++b)
#pragma unroll
                for (int m = 0; m < 4; ++m)
#pragma unroll
                    for (int n = 0; n < 2; ++n) acc[a][b][m][n] = (f32x4){0.f, 0.f, 0.f, 0.f};
        cur = nxt; cA = nA; cB = nB; ++ui;
        if constexpr (ALIGN_EPI) { if (wr == 1) PG8_BAR; }
    }
    PG8_WAIT_V(0);
    if constexpr (!ALIGN_EPI) { if (wr == 0) PG8_BAR; }
    PG8_BAR;
    if constexpr (Epi::AFTER_DRAIN) { E.fused(acc, cur, wr, wc, fr, fq, lds, wid, lane); S.done(cur); }
#undef PG8_SA
#undef PG8_SB
#undef PG8_STAGE
#undef PG8_LDA
#undef PG8_LDB
#undef PG8_MMA
#undef PG8_WAIT_V
#undef PG8_WAIT_L
#undef PG8_BAR
#undef PG8_SCHED
}
}

#define LAS __attribute__((address_space(3)))
typedef unsigned short bf16_t;
typedef short bf16x8 __attribute__((ext_vector_type(8)));
typedef short s16x4 __attribute__((ext_vector_type(4)));
typedef float f32x4 __attribute__((ext_vector_type(4)));
typedef float f32x2 __attribute__((ext_vector_type(2)));
typedef unsigned u32x4 __attribute__((ext_vector_type(4)));
typedef unsigned u32x2 __attribute__((ext_vector_type(2)));
typedef LAS unsigned char* lds_t;

constexpr int NT = 8192, DM = 2048, SEQ = 2048, NB = 4, DEPTH = 4;
constexpr int INW = 5144, NPROJ = 5376, FFH = 5632;
constexpr int PC_FQ = 0, PC_FK = 512, PC_FV = 1024, PC_GQ = 1536, PC_GK = 1792, PC_GV = 2048, PC_GG = 2560, PC_LG = 3072, PC_LX = 4096, PC_FF = 5120, PC_GR = 5128;
constexpr float EPS = 1e-6f;
constexpr float LOG2E = 1.4426950408889634f;
constexpr int LDS_BYTES = 147456;

constexpr size_t MiB = 1u << 20;
constexpr size_t WS_WIN = 0, WS_WOUT = 21 * MiB, WS_WGU = 29 * MiB, WS_WDN = 73 * MiB;
constexpr size_t WS_XW = 96 * MiB;
constexpr size_t WS_HB = 160 * MiB;
constexpr size_t WS_PROJ = 192 * MiB;
constexpr size_t WS_MIX = 360 * MiB;
constexpr size_t WS_FOXO = 392 * MiB;
constexpr size_t WS_CBUF = 400 * MiB;
constexpr size_t WS_GQT = 401 * MiB;
constexpr size_t WS_GA = 405 * MiB;
constexpr size_t WS_GVT = 407 * MiB;
constexpr size_t WS_GU = 415 * MiB;
constexpr size_t WS_GS = 447 * MiB;
constexpr size_t WS_GDEC = 463 * MiB;
constexpr size_t WS_LA = 464 * MiB;
constexpr size_t WS_LU = 496 * MiB;
constexpr size_t WS_AGP = 528 * MiB, WS_AGH = 529 * MiB, WS_HIN = 530 * MiB;
constexpr size_t WS_SS1 = 532 * MiB, WS_SS2 = 537 * MiB;
constexpr size_t WS_CTL = 531 * MiB, CTL_BYTES = 16384;
constexpr size_t WS_GWT = 541 * MiB;
constexpr size_t WS_SMALL = 542 * MiB, SMALL_BYTES = 10 * MiB;
constexpr size_t SL_CBUF = 0, SL_GDEC = 256 * 1024, SL_GWT = 512 * 1024, SL_AGP = 1 * MiB, SL_AGH = 2 * MiB, SL_HIN = 3 * MiB, SL_GQT = 4 * MiB, SL_GA = 8 * MiB;
constexpr size_t WS_QKV = 582 * MiB;
constexpr size_t WS_END = 614 * MiB;

#define GAS __attribute__((address_space(1)))
struct Params { const float* in[22]; float* out; GAS unsigned char* ws; GAS unsigned char* wsl; };

__device__ __forceinline__ unsigned pk2(float lo, float hi) { unsigned r; asm("v_cvt_pk_bf16_f32 %0, %1, %2" : "=v"(r) : "v"(lo), "v"(hi)); return r; }
__device__ __forceinline__ bf16_t f2bf(float f) { return (bf16_t)(pk2(f, 0.f) & 0xffffu); }
__device__ __forceinline__ float bf2f(unsigned b) { return __uint_as_float(b << 16); }
__device__ __forceinline__ float logsig(float x) { return fminf(x, 0.f) - __logf(1.0f + __expf(-fabsf(x))); }
__device__ __forceinline__ float sigmoidf(float x) { return __builtin_amdgcn_rcpf(1.0f + __expf(-x)); }
__device__ __forceinline__ float neg_expm1_small(float y) {
    const float pl = y * (1.0f + y * (0.5f + y * (0.16666667f + y * (0.041666668f + y * (0.0083333338f + y * (0.0013888889f + y * 0.00019841270f))))));
    return (y > -0.25f) ? -pl : (1.0f - __expf(y));
}
__device__ __forceinline__ f32x4 mfma16(bf16x8 a, bf16x8 b, f32x4 c) { return __builtin_amdgcn_mfma_f32_16x16x32_bf16(a, b, c, 0, 0, 0); }
__device__ __forceinline__ float wave_sum(float v) {
#pragma unroll
    for (int o = 1; o < 64; o <<= 1) v += __shfl_xor(v, o);
    return v;
}
__device__ __forceinline__ bf16x8 pack8(f32x4 a, f32x4 b) {
    u32x4 w; w.x = pk2(a[0], a[1]); w.y = pk2(a[2], a[3]); w.z = pk2(b[0], b[1]); w.w = pk2(b[2], b[3]);
    return __builtin_bit_cast(bf16x8, w);
}

template <int MODE>
__device__ __forceinline__ void wconv_item(const float* W0, const float* W1, int Nsrc, int K, bf16_t* Bt, int NG, int item, int lane, const float* gain) {
    const int kb = item / NG, nb = item - kb * NG;
    const int kg = lane >> 4, ng = lane & 15;
    const int np = nb * 64 + ng * 4, k = kb * 32 + kg * 8;
    const float* src = W0; int c = np;
    if (MODE == 0) { c = np < 1536 ? np : np < 3072 ? np + 8 : np < 5120 ? np + 24 : np < 5128 ? np - 5120 + 1536 : np < 5144 ? np - 5128 + 3080 : -1; }
    if (MODE == 2) { const int pn = np >> 8, j = np & 255; src = j < 128 ? W0 : W1; c = pn * 128 + (j & 127); }
    f32x4 v[8];
#pragma unroll
    for (int i = 0; i < 8; ++i) v[i] = (c >= 0) ? *(const f32x4*)(src + (size_t)(k + i) * Nsrc + c) : (f32x4){0.f, 0.f, 0.f, 0.f};
    if (gain) { const f32x4 g0 = *(const f32x4*)(gain + k), g1 = *(const f32x4*)(gain + k + 4);
#pragma unroll
        for (int i = 0; i < 4; ++i) { v[i] = v[i] * g0[i]; v[4 + i] = v[4 + i] * g1[i]; } }
#pragma unroll
    for (int j = 0; j < 4; ++j) {
        u32x4 o; o.x = pk2(v[0][j], v[1][j]); o.y = pk2(v[2][j], v[3][j]); o.z = pk2(v[4][j], v[5][j]); o.w = pk2(v[6][j], v[7][j]);
        *(u32x4*)(Bt + (size_t)(np + j) * K + k) = o;
    }
}

__device__ __forceinline__ void prep_row(const float* xrow, bf16_t* orow, float* ss, int row, int lane, const float* g) {
    const f32x4* xr = (const f32x4*)xrow + lane; const f32x4* gr = (const f32x4*)g + lane;
    f32x4 v[8]; float s = 0.f;
#pragma unroll
    for (int j = 0; j < 8; ++j) { v[j] = xr[64 * j]; s += (v[j][0] * v[j][0] + v[j][1] * v[j][1]) + (v[j][2] * v[j][2] + v[j][3] * v[j][3]); }
    s = wave_sum(s);
    if (lane < 32) ss[((size_t)(lane >> 2) * 8192 + row) * 4 + (lane & 3)] = (lane == 0) ? s : 0.f;
#pragma unroll
    for (int j = 0; j < 8; ++j) { const f32x4 y = v[j] * gr[64 * j]; u32x2 w; w.x = pk2(y[0], y[1]); w.y = pk2(y[2], y[3]); ((u32x2*)orow)[lane + 64 * j] = w; }
}
__device__ __forceinline__ void final_row(const float* xrow, const float* g, float* orow, float ss, int lane) {
    const f32x4* xr = (const f32x4*)xrow + lane; const f32x4* gr = (const f32x4*)g + lane;
    const float rstd = rsqrtf(ss * (1.0f / 2048.0f) + EPS);
#pragma unroll
    for (int j = 0; j < 8; ++j) ((f32x4*)orow)[lane + 64 * j] = xr[64 * j] * rstd * gr[64 * j];
}

__device__ __forceinline__ void phase_wconv(const Params& p, int l, int mask, int w, int nw, int lane) {
    GAS unsigned char* ws = p.ws;
    constexpr int I_IN = 64 * 84, I_OUT = 64 * 32, I_GU = 64 * 176, I_DN = 176 * 32;
    const float* w_in = p.in[2] + (size_t)l * DM * INW;
    const float* w_out = p.in[16] + (size_t)l * DM * DM;
    const float* w_gate = p.in[18] + (size_t)l * DM * FFH;
    const float* w_up = p.in[19] + (size_t)l * DM * FFH;
    const float* w_down = p.in[20] + (size_t)l * FFH * DM;
    if (mask & 1) for (int it = w; it < I_IN; it += nw) wconv_item<0>(w_in, w_in, INW, DM, (bf16_t*)(ws + WS_WIN), 84, it, lane, nullptr);
    if (mask & 2) for (int it = w; it < I_OUT; it += nw) wconv_item<1>(w_out, w_out, DM, DM, (bf16_t*)(ws + WS_WOUT), 32, it, lane, nullptr);
    if (mask & 4) for (int it = w; it < I_GU; it += nw) wconv_item<2>(w_gate, w_up, FFH, DM, (bf16_t*)(ws + WS_WGU), 176, it, lane, nullptr);
    if (mask & 8) for (int it = w; it < I_DN; it += nw) wconv_item<1>(w_down, w_down, DM, FFH, (bf16_t*)(ws + WS_WDN), 32, it, lane, nullptr);
}

__device__ __forceinline__ void fox_cumsum(const Params& p, int l, int seq, int lane) {
    const float* proj = (const float*)(p.ws + WS_PROJ);
    float* cbuf = (float*)(p.wsl + SL_CBUF);
    const int b = seq >> 3, h = seq & 7;
    const float bias = p.in[3][l * 8 + h];
    const float* src = proj + (size_t)(b * SEQ + lane * 32) * NPROJ + PC_FF + h;
    float s = 0.f;
    for (int i = 0; i < 32; ++i) s += logsig(src[(size_t)i * NPROJ] + bias);
    float incl = s;
#pragma unroll
    for (int o = 1; o < 64; o <<= 1) { const float t = __shfl_up(incl, o); if (lane >= o) incl += t; }
    float run = incl - s;
    float* dst = cbuf + seq * SEQ + lane * 32;
    for (int i = 0; i < 32; ++i) { run += logsig(src[(size_t)i * NPROJ] + bias); dst[i] = run * LOG2E; }
}

__device__ __forceinline__ void gate_wt_prep(const Params& p, int l, int gid) {
    if (gid < 2 * 16 * 64 * 64) {
        const int d = gid & 63, e = (gid >> 6) & 63, n = (gid >> 12) & 15, g = gid >> 16;
        const float* w = (g == 0 ? p.in[10] : p.in[12]) + ((size_t)(l * 16 + n) * 64 + d) * 64 + e;
        ((bf16_t*)(p.wsl + SL_GWT))[gid] = f2bf(*w);
    }
}

__device__ __forceinline__ void gla_prep_witem(const Params& p, int l, int ch, lds_t wl_in, int lane_in) {
    int lane = lane_in; asm volatile("" : "+v"(lane));
    unsigned wlo_ = 0; asm volatile("" : "+s"(wlo_)); lds_t wl = wl_in + wlo_;
    const float* proj = (const float*)(p.ws + WS_PROJ);
    const int bh = ch >> 6, n = ch & 63, b = bh >> 2, h = bh & 3;
    const int t0 = b * SEQ + n * 32;
    LAS bf16_t* Qs = (LAS bf16_t*)(wl);
    LAS bf16_t* Ks = (LAS bf16_t*)(wl + 4608);
    LAS bf16_t* KstT = (LAS bf16_t*)(wl);
    LAS bf16_t* VT = (LAS bf16_t*)(wl + 5120);
    const int r = lane & 15, q = lane >> 4;
    float bcum[32];
    {
        const float* w2 = p.in[5] + (size_t)l * 16 * 256 + h * 64 + lane;
        const float gb = p.in[6][l * 256 + h * 64 + lane];
        float w2r[16];
#pragma unroll
        for (int i = 0; i < 16; ++i) w2r[i] = w2[i * 256];
        LAS float* grs = (LAS float*)(wl);
        { const float* gsrc = proj + (size_t)(t0 + (lane >> 1)) * NPROJ + PC_GR + (lane & 1) * 8;
          const f32x4 g0 = *(const f32x4*)gsrc, g1 = *(const f32x4*)(gsrc + 4);
          *(LAS f32x4*)(grs + lane * 8) = g0; *(LAS f32x4*)(grs + lane * 8 + 4) = g1; }
        float run = 0.f;
#pragma unroll
        for (int t = 0; t < 32; ++t) {
            f32x4 gr4[4];
#pragma unroll
            for (int i = 0; i < 4; ++i) gr4[i] = *(LAS f32x4*)(grs + t * 16 + 4 * i);
            float z = gb;
#pragma unroll
            for (int i = 0; i < 16; ++i) z += gr4[i >> 2][i & 3] * w2r[i];
            run += logsig(z) * (1.0f / 16.0f);
            bcum[t] = run;
        }
        asm volatile("" ::: "memory");
    }
    const float bl = bcum[31];
    unsigned kstp[16];
    {
        bf16_t* qtg = (bf16_t*)(p.wsl + SL_GQT) + (size_t)t0 * 256 + h * 64 + lane;
        float ksprev = 0.f;
#pragma unroll
        for (int t = 0; t < 32; ++t) {
            const float* prow = proj + (size_t)(t0 + t) * NPROJ;
            const float gq = prow[PC_GQ + h * 64 + lane], gk = prow[PC_GK + h * 64 + lane];
            const float bv = bcum[t];
            const float qt = gq * 0.125f * __expf(bv), kt = gk * __expf(-bv), ks = gk * __expf(bl - bv);
            const bf16_t qb16 = f2bf(qt);
            Qs[t * 72 + lane] = qb16; Ks[t * 72 + lane] = f2bf(kt);
            qtg[(size_t)t * 256] = qb16;
            if (t & 1) kstp[t >> 1] = pk2(ksprev, ks); else ksprev = ks;
            if ((t & 7) == 7) asm volatile("" ::: "memory");
        }
        ((float*)(p.wsl + SL_GDEC))[ch * 64 + lane] = __expf(bl);
    }
    {
        bf16_t* ab = (bf16_t*)(p.wsl + SL_GA) + (size_t)ch * 1024;
#pragma unroll
        for (int tt = 0; tt < 2; ++tt)
#pragma unroll
            for (int st = 0; st < 2; ++st) {
                f32x4 acc = {0.f, 0.f, 0.f, 0.f};
#pragma unroll
                for (int ks = 0; ks < 2; ++ks) {
                    const bf16x8 a = *(LAS bf16x8*)(Qs + (16 * tt + r) * 72 + 32 * ks + 8 * q);
                    const bf16x8 bb = *(LAS bf16x8*)(Ks + (16 * st + r) * 72 + 32 * ks + 8 * q);
                    acc = mfma16(a, bb, acc);
                }
#pragma unroll
                for (int j = 0; j < 4; ++j) { const int t = 16 * tt + 4 * q + j, s = 16 * st + r; ab[t * 32 + s] = f2bf(s <= t ? acc[j] : 0.f); }
            }
    }
#pragma unroll
    for (int i = 0; i < 4; ++i) { u32x4 w; w.x = kstp[4 * i]; w.y = kstp[4 * i + 1]; w.z = kstp[4 * i + 2]; w.w = kstp[4 * i + 3]; *(LAS u32x4*)(KstT + lane * 40 + 8 * i) = w; }
#pragma unroll
    for (int vv = 0; vv < 2; ++vv) {
        const int v = lane + 64 * vv;
        const bf16_t* vp = (const bf16_t*)(p.ws + WS_QKV) + ((size_t)3 * NT + t0) * 512 + h * 128 + v;
        unsigned vw[16];
#pragma unroll
        for (int t = 0; t < 32; t += 2) vw[t >> 1] = (unsigned)vp[(size_t)t * 512] | ((unsigned)vp[(size_t)(t + 1) * 512] << 16);
        bf16_t* vg = (bf16_t*)(p.ws + WS_GVT) + (size_t)ch * 4096 + v * 32;
#pragma unroll
        for (int i = 0; i < 4; ++i) { u32x4 w; w.x = vw[4 * i]; w.y = vw[4 * i + 1]; w.z = vw[4 * i + 2]; w.w = vw[4 * i + 3]; *(LAS u32x4*)(VT + v * 40 + 8 * i) = w; *(u32x4*)(vg + 8 * i) = w; }
    }
    {
        float* ub = (float*)(p.ws + WS_GU) + (size_t)ch * 8192;
        bf16x8 kb[4];
#pragma unroll
        for (int dt = 0; dt < 4; ++dt) kb[dt] = *(LAS bf16x8*)(KstT + (16 * dt + r) * 40 + 8 * q);
#pragma unroll
        for (int w = 0; w < 8; ++w) {
            const bf16x8 a = *(LAS bf16x8*)(VT + (16 * w + r) * 40 + 8 * q);
#pragma unroll
            for (int dt = 0; dt < 4; ++dt) {
                const f32x4 acc = mfma16(a, kb[dt], (f32x4){0.f, 0.f, 0.f, 0.f});
#pragma unroll
                for (int j = 0; j < 4; ++j) ub[(16 * w + 4 * q + j) * 64 + 16 * dt + r] = acc[j];
            }
        }
    }
}

__device__ __forceinline__ void lru_prep_witem(const Params& p, int l, int item, lds_t wl_in, int lane_in) {
    int lane = lane_in; asm volatile("" : "+v"(lane));
    unsigned wlo_ = 0; asm volatile("" : "+s"(wlo_)); lds_t wl = wl_in + wlo_;
    const float* proj = (const float*)(p.ws + WS_PROJ);
    const int gt = item >> 4, n = item & 15, tok0 = gt * 32, b = tok0 >> 11, p0 = tok0 & 2047, c0 = n * 64;
    LAS bf16_t* Xs = (LAS bf16_t*)(wl);
    LAS float* Xf = (LAS float*)(wl + 4608);
    const int r = lane & 15, q = lane >> 4;
    {
        const int c = c0 + lane;
        const float* cw = p.in[8] + (size_t)l * 4 * 1024 + c;
        const float w0 = cw[0], w1 = cw[1024], w2 = cw[2048], w3 = cw[3072], cb = p.in[9][l * 1024 + c];
        const float* lxp = proj + (size_t)(b * SEQ) * NPROJ + PC_LX + c;
        float x0 = p0 >= 3 ? lxp[(size_t)(p0 - 3) * NPROJ] : 0.f, x1 = p0 >= 2 ? lxp[(size_t)(p0 - 2) * NPROJ] : 0.f, x2 = p0 >= 1 ? lxp[(size_t)(p0 - 1) * NPROJ] : 0.f;
        float xv[32];
#pragma unroll
        for (int i = 0; i < 32; ++i) xv[i] = lxp[(size_t)(p0 + i) * NPROJ];
#pragma unroll
        for (int i = 0; i < 32; ++i) {
            const float x3 = xv[i];
            const float y = cb + w0 * x0 + w1 * x1 + w2 * x2 + w3 * x3;
            Xf[i * 68 + lane] = y; Xs[i * 72 + lane] = f2bf(y);
            x0 = x1; x1 = x2; x2 = x3;
        }
    }
    const bf16_t* gwt = (const bf16_t*)(p.wsl + SL_GWT);
    bf16x8 af[2][2];
#pragma unroll
    for (int tt = 0; tt < 2; ++tt)
#pragma unroll
        for (int ks = 0; ks < 2; ++ks) af[tt][ks] = *(LAS bf16x8*)(Xs + (16 * tt + r) * 72 + 32 * ks + 8 * q);
    float* la = (float*)(p.ws + WS_LA); float* lu = (float*)(p.ws + WS_LU);
#pragma unroll
    for (int et = 0; et < 4; ++et) {
        bf16x8 ba[2], bi[2];
#pragma unroll
        for (int ks = 0; ks < 2; ++ks) { ba[ks] = *(const bf16x8*)(gwt + ((size_t)(0 * 16 + n) * 64 + 16 * et + r) * 64 + 32 * ks + 8 * q); bi[ks] = *(const bf16x8*)(gwt + ((size_t)(1 * 16 + n) * 64 + 16 * et + r) * 64 + 32 * ks + 8 * q); }
        const int e = 16 * et + r, c = c0 + e;
        const float bba = p.in[11][l * 1024 + c], bbi = p.in[13][l * 1024 + c], lls = logsig(p.in[14][l * 1024 + c]);
        float av[2][4], uv[2][4];
#pragma unroll
        for (int tt = 0; tt < 2; ++tt) {
            f32x4 pa = {0.f, 0.f, 0.f, 0.f}, pi = {0.f, 0.f, 0.f, 0.f};
#pragma unroll
            for (int ks = 0; ks < 2; ++ks) { pa = mfma16(af[tt][ks], ba[ks], pa); pi = mfma16(af[tt][ks], bi[ks], pi); }
#pragma unroll
            for (int j = 0; j < 4; ++j) {
                const int t = 16 * tt + 4 * q + j;
                const float rg = sigmoidf(pa[j] + bba), ig = sigmoidf(pi[j] + bbi);
                const float loga = 8.0f * rg * lls;
                const float a = __expf(loga);
                const float u = __builtin_amdgcn_sqrtf(fmaxf(neg_expm1_small(2.0f * loga), 0.f)) * (ig * Xf[t * 68 + e]);
                la[(size_t)(tok0 + t) * 1024 + c] = a; lu[(size_t)(tok0 + t) * 1024 + c] = u;
                av[tt][j] = a; uv[tt][j] = u;
            }
            asm volatile("" ::: "memory");
        }
        float P = 1.f, H = 0.f;
#pragma unroll
        for (int tt = 0; tt < 2; ++tt)
#pragma unroll
            for (int qq = 0; qq < 4; ++qq) {
                if (q == qq) {
#pragma unroll
                    for (int j = 0; j < 4; ++j) { H = av[tt][j] * H + uv[tt][j]; P *= av[tt][j]; }
                }
                P = __shfl(P, r + 16 * qq); H = __shfl(H, r + 16 * qq);
            }
        if (q == 0) { ((float*)(p.wsl + SL_AGP))[gt * 1024 + c] = P; ((float*)(p.wsl + SL_AGH))[gt * 1024 + c] = H; }
    }
}

__device__ __forceinline__ void fox_attn_unit(const Params& p, int bh, int qb, lds_t lds, int tid, int wave, int lane) {
    const float* proj = (const float*)(p.ws + WS_PROJ);
    const float* cb = (const float*)(p.wsl + SL_CBUF) + bh * SEQ;
    const int b = bh >> 3, h = bh & 7;
    LAS bf16_t* Ks = (LAS bf16_t*)(lds);
    LAS bf16_t* Vt = (LAS bf16_t*)(lds + 9216);
    LAS float* cks = (LAS float*)(lds + 18432);
    const int r = lane & 15, q = lane >> 4;
    const int q0 = qb * 128, qw0 = q0 + 16 * wave, nkv = 2 * (qb + 1);
    const float C2 = 0.125f * LOG2E;
    bf16x8 qf[2];
    {
        const bf16_t* qp = (const bf16_t*)(p.ws + WS_QKV) + (size_t)(b * SEQ + qw0 + r) * 512 + h * 64 + 8 * q;
#pragma unroll
        for (int ks = 0; ks < 2; ++ks) qf[ks] = *(const bf16x8*)(qp + 32 * ks);
    }
    const float cq = cb[qw0 + r];
    float m = -1e30f, lsum = 0.f;
    f32x4 o[4];
#pragma unroll
    for (int i = 0; i < 4; ++i) o[i] = (f32x4){0.f, 0.f, 0.f, 0.f};
    const int lrow = tid >> 3, lch = (tid & 7) * 8;
    const bf16_t* kbase = (const bf16_t*)(p.ws + WS_QKV) + ((size_t)NT + b * SEQ + lrow) * 512 + h * 64 + lch;
    const int vrow = tid & 63, vch = (tid >> 6) * 8;
    const bf16_t* vbase = (const bf16_t*)(p.ws + WS_QKV) + ((size_t)2 * NT + b * SEQ + vrow) * 512 + h * 64 + vch;
    bf16x8 kA = *(const bf16x8*)kbase, vA = *(const bf16x8*)vbase;
    float ckA = tid < 64 ? cb[tid] : 0.f;
    bf16x8 kB = *(const bf16x8*)(kbase + (size_t)64 * 512), vB = *(const bf16x8*)(vbase + (size_t)64 * 512);
    float ckB = tid < 64 ? cb[64 + tid] : 0.f;
    constexpr int FOXBUF = 18432 + 256;
#define FOX_WRITE(KK, VV, CK, bufi, jn) { \
        LAS bf16_t* KsW = (LAS bf16_t*)(lds + (bufi) * FOXBUF); LAS bf16_t* VtW = (LAS bf16_t*)(lds + (bufi) * FOXBUF + 9216); LAS float* cksW = (LAS float*)(lds + (bufi) * FOXBUF + 18432); \
        *(LAS bf16x8*)(KsW + lrow * 72 + lch) = KK; \
        _Pragma("unroll") for (int i = 0; i < 8; ++i) VtW[(vch + i) * 72 + vrow] = (bf16_t)VV[i]; \
        if (tid < 64) cksW[tid] = CK; \
        if ((jn) < nkv) { const size_t off = (size_t)(jn) * 64 * 512; \
            KK = *(const bf16x8*)(kbase + off); VV = *(const bf16x8*)(vbase + off); \
            if (tid < 64) CK = cb[(jn) * 64 + tid]; } }
    __syncthreads();
    FOX_WRITE(kA, vA, ckA, 0, 2)
    asm volatile("s_waitcnt lgkmcnt(0)\n\ts_barrier" ::: "memory");
    for (int j0 = 0; j0 < nkv; j0 += 2) {
        { const int j = j0;
          FOX_WRITE(kB, vB, ckB, 1, j + 3)
          LAS bf16_t* KsX = (LAS bf16_t*)(lds); LAS bf16_t* VtX = (LAS bf16_t*)(lds + 9216); LAS float* cksX = (LAS float*)(lds + 18432);
        if (64 * j <= qw0 + 15) {
            f32x4 s[4]; float mx = -INFINITY;
            bf16x8 kfr[4][2]; f32x4 ckr[4]; s16x4 vlo[4][2], vhi[4][2];
#pragma unroll
            for (int st = 0; st < 4; ++st) {
#pragma unroll
                for (int ks = 0; ks < 2; ++ks) kfr[st][ks] = *(LAS bf16x8*)(KsX + (16 * st + r) * 72 + 32 * ks + 8 * q);
                ckr[st] = *(LAS f32x4*)(cksX + 16 * st + 4 * q);
            }
#pragma unroll
            for (int ds = 0; ds < 4; ++ds)
#pragma unroll
                for (int ks = 0; ks < 2; ++ks) { vlo[ds][ks] = *(LAS s16x4*)(VtX + (16 * ds + r) * 72 + 32 * ks + 4 * q); vhi[ds][ks] = *(LAS s16x4*)(VtX + (16 * ds + r) * 72 + 32 * ks + 16 + 4 * q); }
#pragma unroll
            for (int st = 0; st < 4; ++st) {
                f32x4 acc = {0.f, 0.f, 0.f, 0.f};
#pragma unroll
                for (int ks = 0; ks < 2; ++ks) acc = mfma16(kfr[st][ks], qf[ks], acc);
                const f32x4 ck = ckr[st];
#pragma unroll
                for (int jj = 0; jj < 4; ++jj) {
                    const int kv = 64 * j + 16 * st + 4 * q + jj;
                    float sv = acc[jj] + (cq - ck[jj]);
                    if (64 * j + 63 > qw0) sv = (kv <= qw0 + r) ? sv : -INFINITY;
                    s[st][jj] = sv; mx = fmaxf(mx, sv);
                }
            }
            mx = fmaxf(mx, __shfl_xor(mx, 16)); mx = fmaxf(mx, __shfl_xor(mx, 32));
            const float mnew = fmaxf(m, mx);
            const float alpha = __builtin_amdgcn_exp2f(m - mnew);
            m = mnew;
            float ps = 0.f;
#pragma unroll
            for (int st = 0; st < 4; ++st)
#pragma unroll
                for (int jj = 0; jj < 4; ++jj) { const float e = __builtin_amdgcn_exp2f(s[st][jj] - mnew); s[st][jj] = e; ps += e; }
            lsum = lsum * alpha + ps;
#pragma unroll
            for (int i = 0; i < 4; ++i) o[i] = o[i] * alpha;
            bf16x8 pf[2];
            pf[0] = pack8(s[0], s[1]); pf[1] = pack8(s[2], s[3]);
#pragma unroll
            for (int ds = 0; ds < 4; ++ds)
#pragma unroll
                for (int ks = 0; ks < 2; ++ks) {
                    const s16x4 lo = vlo[ds][ks], hi = vhi[ds][ks];
                    const bf16x8 a = {lo[0], lo[1], lo[2], lo[3], hi[0], hi[1], hi[2], hi[3]};
                    o[ds] = mfma16(a, pf[ks], o[ds]);
                }
        }
          asm volatile("s_waitcnt lgkmcnt(0)\n\ts_barrier" ::: "memory");
        }
        { const int j = j0 + 1;
          if (j + 1 < nkv) FOX_WRITE(kA, vA, ckA, 0, j + 3)
          LAS bf16_t* KsX = (LAS bf16_t*)(lds + FOXBUF); LAS bf16_t* VtX = (LAS bf16_t*)(lds + FOXBUF + 9216); LAS float* cksX = (LAS float*)(lds + FOXBUF + 18432);
        if (64 * j <= qw0 + 15) {
            f32x4 s[4]; float mx = -INFINITY;
            bf16x8 kfr[4][2]; f32x4 ckr[4]; s16x4 vlo[4][2], vhi[4][2];
#pragma unroll
            for (int st = 0; st < 4; ++st) {
#pragma unroll
                for (int ks = 0; ks < 2; ++ks) kfr[st][ks] = *(LAS bf16x8*)(KsX + (16 * st + r) * 72 + 32 * ks + 8 * q);
                ckr[st] = *(LAS f32x4*)(cksX + 16 * st + 4 * q);
            }
#pragma unroll
            for (int ds = 0; ds < 4; ++ds)
#pragma unroll
                for (int ks = 0; ks < 2; ++ks) { vlo[ds][ks] = *(LAS s16x4*)(VtX + (16 * ds + r) * 72 + 32 * ks + 4 * q); vhi[ds][ks] = *(LAS s16x4*)(VtX + (16 * ds + r) * 72 + 32 * ks + 16 + 4 * q); }
#pragma unroll
            for (int st = 0; st < 4; ++st) {
                f32x4 acc = {0.f, 0.f, 0.f, 0.f};
#pragma unroll
                for (int ks = 0; ks < 2; ++ks) acc = mfma16(kfr[st][ks], qf[ks], acc);
                const f32x4 ck = ckr[st];
#pragma unroll
                for (int jj = 0; jj < 4; ++jj) {
                    const int kv = 64 * j + 16 * st + 4 * q + jj;
                    float sv = acc[jj] + (cq - ck[jj]);
                    if (64 * j + 63 > qw0) sv = (kv <= qw0 + r) ? sv : -INFINITY;
                    s[st][jj] = sv; mx = fmaxf(mx, sv);
                }
            }
            mx = fmaxf(mx, __shfl_xor(mx, 16)); mx = fmaxf(mx, __shfl_xor(mx, 32));
            const float mnew = fmaxf(m, mx);
            const float alpha = __builtin_amdgcn_exp2f(m - mnew);
            m = mnew;
            float ps = 0.f;
#pragma unroll
            for (int st = 0; st < 4; ++st)
#pragma unroll
                for (int jj = 0; jj < 4; ++jj) { const float e = __builtin_amdgcn_exp2f(s[st][jj] - mnew); s[st][jj] = e; ps += e; }
            lsum = lsum * alpha + ps;
#pragma unroll
            for (int i = 0; i < 4; ++i) o[i] = o[i] * alpha;
            bf16x8 pf[2];
            pf[0] = pack8(s[0], s[1]); pf[1] = pack8(s[2], s[3]);
#pragma unroll
            for (int ds = 0; ds < 4; ++ds)
#pragma unroll
                for (int ks = 0; ks < 2; ++ks) {
                    const s16x4 lo = vlo[ds][ks], hi = vhi[ds][ks];
                    const bf16x8 a = {lo[0], lo[1], lo[2], lo[3], hi[0], hi[1], hi[2], hi[3]};
                    o[ds] = mfma16(a, pf[ks], o[ds]);
                }
        }
          asm volatile("s_waitcnt lgkmcnt(0)\n\ts_barrier" ::: "memory");
        }
    }
#undef FOX_WRITE
    lsum += __shfl_xor(lsum, 16); lsum += __shfl_xor(lsum, 32);
    const float inv = 1.0f / lsum;
    bf16_t* op = (bf16_t*)(p.ws + WS_FOXO) + (size_t)(b * SEQ + qw0 + r) * 512 + h * 64 + 4 * q;
#pragma unroll
    for (int ds = 0; ds < 4; ++ds) { u32x2 w; w.x = pk2(o[ds][0] * inv, o[ds][1] * inv); w.y = pk2(o[ds][2] * inv, o[ds][3] * inv); *(u32x2*)(op + 16 * ds) = w; }
}

__device__ __forceinline__ void gla_scan_item(const Params& p, int item, int tid) {
    const int bh = item >> 4, e = (item & 15) * 512 + tid, d = e & 63;
    const float* ub = (const float*)(p.ws + WS_GU) + (size_t)bh * 64 * 8192 + e;
    const float* dec = (const float*)(p.wsl + SL_GDEC) + (size_t)bh * 64 * 64 + d;
    bf16_t* sp = (bf16_t*)(p.ws + WS_GS) + (size_t)bh * 64 * 8192 + e;
    float st = 0.f;
#pragma unroll
    for (int n0 = 0; n0 < 64; n0 += 32) {
        float u[32], dc[32];
#pragma unroll
        for (int n = 0; n < 32; ++n) { u[n] = ub[(size_t)(n0 + n) * 8192]; dc[n] = dec[(n0 + n) * 64]; }
#pragma unroll
        for (int n = 0; n < 32; ++n) { sp[(size_t)(n0 + n) * 8192] = f2bf(st); st = dc[n] * st + u[n]; }
    }
}

__device__ __forceinline__ void lru_tilescan_item(const Params& p, int item, int tid) {
    const int gid = item * 512 + tid, b = gid >> 10, c = gid & 1023;
    const float* P = (const float*)(p.wsl + SL_AGP) + (size_t)b * 64 * 1024 + c;
    const float* H = (const float*)(p.wsl + SL_AGH) + (size_t)b * 64 * 1024 + c;
    float* hi = (float*)(p.wsl + SL_HIN) + (size_t)b * 64 * 1024 + c;
    float h = 0.f;
#pragma unroll
    for (int t0 = 0; t0 < 64; t0 += 32) {
        float a[32], u[32];
#pragma unroll
        for (int t = 0; t < 32; ++t) { a[t] = P[(t0 + t) * 1024]; u[t] = H[(t0 + t) * 1024]; }
#pragma unroll
        for (int t = 0; t < 32; ++t) { hi[(t0 + t) * 1024] = h; h = a[t] * h + u[t]; }
    }
}

__device__ __forceinline__ void fox_norm_rows4(const Params& p, int l, int tok0, int stride, int lane) {
    u32x4 w[4];
#pragma unroll
    for (int k = 0; k < 4; ++k) w[k] = *(const u32x4*)((const bf16_t*)(p.ws + WS_FOXO) + (size_t)(tok0 + k * stride) * 512 + lane * 8);
    const float* g = p.in[4] + l * 512 + lane * 8;
    const f32x4 g0 = *(const f32x4*)g, g1 = *(const f32x4*)(g + 4);
#pragma unroll
    for (int k = 0; k < 4; ++k) {
        float v[8];
#pragma unroll
        for (int i = 0; i < 4; ++i) { v[2 * i] = bf2f(w[k][i] & 0xffffu); v[2 * i + 1] = bf2f(w[k][i] >> 16); }
        float s = 0.f;
#pragma unroll
        for (int i = 0; i < 8; ++i) s += v[i] * v[i];
        const float rstd = rsqrtf(wave_sum(s) * (1.0f / 512.0f) + EPS);
        u32x4 ow; ow.x = pk2(v[0] * rstd * g0[0], v[1] * rstd * g0[1]); ow.y = pk2(v[2] * rstd * g0[2], v[3] * rstd * g0[3]);
        ow.z = pk2(v[4] * rstd * g1[0], v[5] * rstd * g1[1]); ow.w = pk2(v[6] * rstd * g1[2], v[7] * rstd * g1[3]);
        *(u32x4*)((bf16_t*)(p.ws + WS_MIX) + (size_t)(tok0 + k * stride) * 2048 + lane * 8) = ow;
    }
}

__device__ __forceinline__ void gla_out_witem(const Params& p, int l, int item, int lane) {
    const float* proj = (const float*)(p.ws + WS_PROJ);
    const int ch = item >> 1, tt = item & 1;
    const int bh = ch >> 6, n = ch & 63, b = bh >> 2, h = bh & 3;
    const int t0 = b * SEQ + n * 32;
    const int r = lane & 15, q = lane >> 4;
    const bf16_t* ab = (const bf16_t*)(p.wsl + SL_GA) + (size_t)ch * 1024;
    const bf16_t* vt = (const bf16_t*)(p.ws + WS_GVT) + (size_t)ch * 4096;
    const bf16_t* qt = (const bf16_t*)(p.wsl + SL_GQT) + (size_t)t0 * 256 + h * 64;
    const bf16_t* sp = (const bf16_t*)(p.ws + WS_GS) + (size_t)ch * 8192;
    const bf16x8 aa = *(const bf16x8*)(ab + (16 * tt + r) * 32 + 8 * q);
    const bf16x8 aq0 = *(const bf16x8*)(qt + (size_t)(16 * tt + r) * 256 + 8 * q), aq1 = *(const bf16x8*)(qt + (size_t)(16 * tt + r) * 256 + 32 + 8 * q);
    f32x4 acc[8];
#pragma unroll
    for (int w = 0; w < 8; ++w) {
        const int v = 16 * w + r;
        const bf16x8 bv = *(const bf16x8*)(vt + v * 32 + 8 * q);
        const bf16x8 bs0 = *(const bf16x8*)(sp + v * 64 + 8 * q), bs1 = *(const bf16x8*)(sp + v * 64 + 32 + 8 * q);
        f32x4 c = mfma16(aa, bv, (f32x4){0.f, 0.f, 0.f, 0.f});
        c = mfma16(aq0, bs0, c); c = mfma16(aq1, bs1, c);
        acc[w] = c;
    }
    float tot[4] = {0.f, 0.f, 0.f, 0.f};
#pragma unroll
    for (int w = 0; w < 8; ++w)
#pragma unroll
        for (int j = 0; j < 4; ++j) {
            float s = acc[w][j] * acc[w][j];
            s += __shfl_xor(s, 1); s += __shfl_xor(s, 2); s += __shfl_xor(s, 4); s += __shfl_xor(s, 8);
            tot[j] += s;
        }
#pragma unroll
    for (int j = 0; j < 4; ++j) {
        const int t = 16 * tt + 4 * q + j;
        const float rstd = rsqrtf(tot[j] * (1.0f / 128.0f) + EPS);
        const float* ggp = proj + (size_t)(t0 + t) * NPROJ + PC_GG + h * 128 + r;
        bf16_t* mp = (bf16_t*)(p.ws + WS_MIX) + (size_t)(t0 + t) * 2048 + 512 + h * 128 + r;
#pragma unroll
        for (int w = 0; w < 8; ++w) {
            const float gn = p.in[7][l * 128 + 16 * w + r];
            const float gg = ggp[16 * w];
            const float y = acc[w][j] * rstd * gn * (gg * sigmoidf(gg));
            mp[16 * w] = f2bf(y);
        }
    }
}

__device__ __forceinline__ float gelu_tanh(float x) {
    const float u = 0.7978845608028654f * (x + 0.044715f * x * x * x);
    const float t = 1.0f - 2.0f * __builtin_amdgcn_rcpf(1.0f + __expf(2.0f * u));
    return 0.5f * x * (1.0f + t);
}

__device__ __forceinline__ void lru_out_item(const Params& p, int l, int gt, lds_t lds, int tid, int wave, int lane) {
    const float* proj = (const float*)(p.ws + WS_PROJ);
    const int tok0 = gt * 32, c = 2 * tid;
    LAS float* part = (LAS float*)(lds);
    LAS float* rs = (LAS float*)(lds + 65536);
    const f32x2* la = (const f32x2*)((const float*)(p.ws + WS_LA) + (size_t)tok0 * 1024 + c);
    const f32x2* lu = (const f32x2*)((const float*)(p.ws + WS_LU) + (size_t)tok0 * 1024 + c);
    const float* lgp = proj + (size_t)tok0 * NPROJ + PC_LG + c;
    f32x2 h = *(const f32x2*)((const float*)(p.wsl + SL_HIN) + (size_t)gt * 1024 + c);
    f32x2 y[32];
    {
        f32x2 av[32], uv[32];
#pragma unroll
        for (int t = 0; t < 32; ++t) { av[t] = la[t * 512]; uv[t] = lu[t * 512]; }
#pragma unroll
        for (int t = 0; t < 32; ++t) { h = av[t] * h + uv[t]; y[t] = h; }
    }
    {
        f32x2 gv[32];
#pragma unroll
        for (int t = 0; t < 32; ++t) gv[t] = *(const f32x2*)(lgp + (size_t)t * NPROJ);
#pragma unroll
        for (int t = 0; t < 32; ++t) {
            y[t][0] = y[t][0] * gelu_tanh(gv[t][0]); y[t][1] = y[t][1] * gelu_tanh(gv[t][1]);
            part[t * 512 + tid] = y[t][0] * y[t][0] + y[t][1] * y[t][1];
        }
    }
    __syncthreads();
    {
        const int t = tid >> 4, k0 = tid & 15;
        float s = 0.f;
#pragma unroll 8
        for (int k = 0; k < 32; ++k) s += part[t * 512 + k0 + 16 * k];
        s += __shfl_xor(s, 1); s += __shfl_xor(s, 2); s += __shfl_xor(s, 4); s += __shfl_xor(s, 8);
        if (k0 == 0) rs[t] = rsqrtf(s * (1.0f / 1024.0f) + EPS);
    }
    __syncthreads();
    const f32x2 g = *(const f32x2*)(p.in[15] + l * 1024 + c);
    bf16_t* mix = (bf16_t*)(p.ws + WS_MIX) + (size_t)tok0 * 2048 + 1024 + c;
#pragma unroll
    for (int t = 0; t < 32; ++t) { const float rr = rs[t]; *(unsigned*)(mix + (size_t)t * 2048) = pk2(y[t][0] * rr * g[0], y[t][1] * rr * g[1]); }
    __syncthreads();
}

#define XB_TMO      128
#define XB_XCNT(j)  (256  + 64 * (j))
#define XB_XSUB(j)  (1280 + 64 * (j))
#define XB_XGEN(j)  (2304 + 64 * (j))
#define XB_TOP      3328
#define XB_TOPGEN   3392
#define XCD_BAR_WORDS 3456
#define XB_SPIN_CAP (1u << 18)

__device__ __forceinline__ unsigned xb_ld(unsigned* p)              { return __hip_atomic_load(p, __ATOMIC_RELAXED, __HIP_MEMORY_SCOPE_AGENT); }
__device__ __forceinline__ unsigned xb_add(unsigned* p, unsigned v) { return __hip_atomic_fetch_add(p, v, __ATOMIC_RELAXED, __HIP_MEMORY_SCOPE_AGENT); }
__device__ __forceinline__ unsigned xb_xcc_id() { return (unsigned)__builtin_amdgcn_s_getreg((3 << 11) | 20) & 0xFu; }
#define XB_SPIN(cond, bar) do { unsigned _sp = 0; while (cond) { __builtin_amdgcn_s_sleep(1); \
    if ((++_sp & 255u) == 0u) { if (xb_ld(&(bar)[XB_TMO])) break; if (_sp > XB_SPIN_CAP) { atomicAdd(&(bar)[XB_TMO], 1u); break; } } } } while (0)

struct XcdBarrier {
    unsigned* bar; unsigned x;
    volatile LAS unsigned* st;
};

__device__ __forceinline__ XcdBarrier xcd_barrier_post(unsigned* bar, volatile LAS unsigned* st) {
    XcdBarrier b; b.bar = bar; b.x = xb_xcc_id(); b.st = st;
    if (threadIdx.x == 0) (void)xb_add(&bar[XB_XCNT(b.x)], 1u);
    return b;
}
__device__ __forceinline__ void xcd_barrier_complete(unsigned* bar, unsigned x, unsigned& nloc, unsigned& nx) {
    const unsigned G = gridDim.x * gridDim.y * gridDim.z;
    unsigned sum, cnt, mine, sp = 0u;
    for (;;) {
        sum = 0u; cnt = 0u; mine = 0u;
#pragma unroll
        for (unsigned j = 0; j < 16; ++j) { const unsigned c = xb_ld(&bar[XB_XCNT(j)]); sum += c; cnt += (c > 0u) ? 1u : 0u; mine = (j == x) ? c : mine; }
        if (sum == G) break;
        __builtin_amdgcn_s_sleep(1);
        if ((++sp & 255u) == 0u) { if (xb_ld(&bar[XB_TMO])) break; if (sp > XB_SPIN_CAP) { atomicAdd(&bar[XB_TMO], 1u); break; } }
    }
    nloc = mine > 0u ? mine : 1u; nx = cnt > 0u ? cnt : 1u;
}

__device__ __forceinline__ void xcd_barrier(const XcdBarrier& b) {
    asm volatile("s_waitcnt vmcnt(0)" ::: "memory");
    __syncthreads();
    if (threadIdx.x == 0) {
        unsigned* bar = b.bar;
        __builtin_amdgcn_s_waitcnt(0);
        unsigned nloc = b.st[0], nx = b.st[1];
        if (nloc == 0u) { xcd_barrier_complete(bar, b.x, nloc, nx); b.st[0] = nloc; b.st[1] = nx; }
        const unsigned old = xb_add(&bar[XB_XSUB(b.x)], 1u);
        const unsigned gen = old / nloc;
        if (old + 1u == (gen + 1u) * nloc) {
            __builtin_amdgcn_fence(__ATOMIC_RELEASE, "agent");
            asm volatile("s_waitcnt vmcnt(0)" ::: "memory");
            const unsigned og = xb_add(&bar[XB_TOP], 1u);
            const unsigned tg = og / nx;
            if (og + 1u == (tg + 1u) * nx) xb_add(&bar[XB_TOPGEN], 1u);
            else XB_SPIN(xb_ld(&bar[XB_TOPGEN]) == tg, bar);
            __builtin_amdgcn_fence(__ATOMIC_ACQUIRE, "agent");
            xb_add(&bar[XB_XGEN(b.x)], 1u);
            asm volatile("s_waitcnt vmcnt(0)" ::: "memory");
        } else {
            XB_SPIN(xb_ld(&bar[XB_XGEN(b.x)]) == gen, bar);
            __builtin_amdgcn_fence(__ATOMIC_ACQUIRE, "agent");
            asm volatile("s_waitcnt vmcnt(0)" ::: "memory");
        }
    }
    __syncthreads();
}

__global__ void __launch_bounds__(512, 2) hymba_fwd(Params p0) {
    extern __shared__ __attribute__((aligned(16))) unsigned char lds_raw[];
    cg::grid_group grid = cg::this_grid();
    const int G = gridDim.x, bid = blockIdx.x, ngw = G * 8;
    volatile LAS unsigned* bst = (volatile LAS unsigned*)((lds_t)lds_raw + (LDS_BYTES - 64));
    if (threadIdx.x < 16) bst[threadIdx.x] = 0u;
    __syncthreads();
    const XcdBarrier bar = xcd_barrier_post((unsigned*)(p0.ws + WS_CTL), bst);
#define PHASE_BEGIN \
    int tid = threadIdx.x; asm volatile("" : "+v"(tid)); \
    const int lane = tid & 63, wave = __builtin_amdgcn_readfirstlane(tid >> 6); \
    unsigned lo_ = 0; asm volatile("" : "+s"(lo_)); lds_t lds = (lds_t)lds_raw + lo_; \
    Params p = p0; asm volatile("" : "+s"(p.ws)); p.wsl = p.ws + WS_SMALL + (size_t)lcur * SMALL_BYTES; \
    GAS unsigned char* ws = p.ws; const int gw = bid * 8 + wave; (void)gw; (void)lane; (void)lds; (void)ws;

#pragma clang loop unroll(disable)
    for (int l = 0; l < DEPTH; ++l) {
        const int lcur = l;
        if (l == 0) {
            {
                PHASE_BEGIN
                phase_wconv(p, 0, 1, gw, ngw, lane);
                for (int m = gw; m < NT; m += ngw) prep_row(p.in[0] + (size_t)m * DM, (bf16_t*)(ws + WS_HB) + (size_t)m * DM, (float*)(ws + WS_SS1), m, lane, p.in[1]);
            }
            if (p0.ws == nullptr) grid.sync();
            xcd_barrier(bar);
        }
        {
            PHASE_BEGIN
            pg8::Gemm g{(const bf16_t*)(ws + WS_HB), (const bf16_t*)(ws + WS_WIN), NT, NPROJ, DM}; pg8::StaticOrder S; S.init(NT, NPROJ, G, bid);
            gate_wt_prep(p, l, bid * 512 + tid);
            pg8::rstd_table((LAS float*)(lds + 131072), (const float*)(ws + WS_SS1 + (size_t)l * MiB), S, tid);
            pg8::EpiStoreF32 E{(float*)(ws + WS_PROJ), NPROJ, (const LAS float*)(lds + 131072), 0, (bf16_t*)(ws + WS_QKV)};
            pg8::gemm_phase<pg8::EpiStoreF32, pg8::StaticOrder, true, true>(lds, g, S, E, tid);
            { const int nfull = (NT / 256) * (NPROJ / 256) % G; if (nfull > 0 && bid >= nfull) phase_wconv(p, l, 2 | 4, (bid - nfull) * 8 + wave, (G - nfull) * 8, lane); else if (nfull == 0) phase_wconv(p, l, 2 | 4, gw, ngw, lane); }
        }
        xcd_barrier(bar);
        {
            PHASE_BEGIN
            if (gw < 32) fox_cumsum(p, l, gw, lane);
            {
                lds_t wl = lds + wave * 18432;
                if (G == 256) {
                    if (wave < 4) { gla_prep_witem(p, l, bid * 4 + wave, wl, lane); lru_prep_witem(p, l, bid * 16 + wave, wl, lane); }
                    else for (int k = 0; k < 3; ++k) lru_prep_witem(p, l, bid * 16 + 4 + (wave - 4) * 3 + k, wl, lane);
                } else
                for (int it = gw; it < 1024 + 4096; it += ngw) {
                    if (it < 1024) gla_prep_witem(p, l, it, wl, lane);
                    else lru_prep_witem(p, l, it - 1024, wl, lane);
                }
            }
        }
        xcd_barrier(bar);
        {
            PHASE_BEGIN
            for (int it = bid; it < 256; it += G) {
                const int bh = it >> 3, s = it & 7;
                fox_attn_unit(p, bh, 15 - s, lds, tid, wave, lane);
                fox_attn_unit(p, bh, s, lds, tid, wave, lane);
            }
            for (int it = bid; it < 256; it += G) gla_scan_item(p, it, tid);
            for (int it = G - 1 - bid; it < 8; it += G) lru_tilescan_item(p, it, tid);
        }
        xcd_barrier(bar);
        {
            PHASE_BEGIN
            for (int it = bid; it < 256; it += G) lru_out_item(p, l, it, lds, tid, wave, lane);
            for (int it = gw; it < 2048; it += ngw) gla_out_witem(p, l, it, lane);
            if (NT % (4 * ngw) == 0) { for (int tok = gw; tok < NT; tok += 4 * ngw) fox_norm_rows4(p, l, tok, ngw, lane); }
            else for (int tok = gw; tok < NT; tok += ngw) fox_norm_rows4(p, l, tok, 0, lane);
        }
        xcd_barrier(bar);
        {
            PHASE_BEGIN
            const float* xin = (l == 0) ? p.in[0] : (const float*)(ws + WS_XW);
            pg8::Gemm g{(const bf16_t*)(ws + WS_MIX), (const bf16_t*)(ws + WS_WOUT), NT, DM, DM}; pg8::StaticOrder S; S.init(NT, DM, G, bid);
            pg8::EpiResid E{xin, (float*)(ws + WS_XW), (bf16_t*)(ws + WS_HB), (float*)(ws + WS_SS2 + (size_t)l * MiB), p.in[17] + l * DM, DM};
            pg8::gemm_phase<pg8::EpiResid, pg8::StaticOrder, true, true>(lds, g, S, E, tid);
        }
        xcd_barrier(bar);
        {
            PHASE_BEGIN
            pg8::Gemm g{(const bf16_t*)(ws + WS_HB), (const bf16_t*)(ws + WS_WGU), NT, 2 * FFH, DM}; pg8::StaticOrder S; S.init(NT, 2 * FFH, G, bid);
            pg8::rstd_table((LAS float*)(lds + 131072), (const float*)(ws + WS_SS2 + (size_t)l * MiB), S, tid);
            pg8::EpiSwiglu E{(bf16_t*)(ws + WS_PROJ), FFH, (const LAS float*)(lds + 131072), 0};
            pg8::gemm_phase<pg8::EpiSwiglu, pg8::StaticOrder, true, true>(lds, g, S, E, tid);
            { const int nfull = (NT / 256) * (2 * FFH / 256) % G; const int msk = 8 | (l + 1 < DEPTH ? 1 : 0); const int ln = (l + 1 < DEPTH) ? l + 1 : l;
              if (nfull > 0 && bid >= nfull) { phase_wconv(p, l, 8, (bid - nfull) * 8 + wave, (G - nfull) * 8, lane); if (msk & 1) phase_wconv(p, ln, 1, (bid - nfull) * 8 + wave, (G - nfull) * 8, lane); }
              else if (nfull == 0) { phase_wconv(p, l, 8, gw, ngw, lane); if (msk & 1) phase_wconv(p, ln, 1, gw, ngw, lane); } }
        }
        xcd_barrier(bar);
        {
            PHASE_BEGIN
            pg8::Gemm g{(const bf16_t*)(ws + WS_PROJ), (const bf16_t*)(ws + WS_WDN), NT, DM, FFH}; pg8::StaticOrder S; S.init(NT, DM, G, bid);
            pg8::EpiResid E{(const float*)(ws + WS_XW), (float*)(ws + WS_XW), (l < DEPTH - 1) ? (bf16_t*)(ws + WS_HB) : (bf16_t*)nullptr, (float*)(ws + WS_SS1 + (size_t)(l + 1) * MiB), p.in[1] + (l < DEPTH - 1 ? l + 1 : 0) * DM, DM};
            pg8::gemm_phase<pg8::EpiResid, pg8::StaticOrder, true, true>(lds, g, S, E, tid);
        }
        xcd_barrier(bar);
    }
    {
        const int lcur = 0;
        PHASE_BEGIN
        for (int m = gw; m < NT; m += ngw) { const float sv = wave_sum(lane < 32 ? ((const float*)(ws + WS_SS1 + (size_t)DEPTH * MiB))[((size_t)(lane >> 2) * 8192 + m) * 4 + (lane & 3)] : 0.f);
            final_row((const float*)(ws + WS_XW) + (size_t)m * DM, p.in[21], p.out + (size_t)m * DM, sv, lane); }
    }
}

extern "C" void kernel_launch(void* const* d_in, const int* in_sizes, int n_in, void* d_out, int out_size, void* d_ws, size_t ws_size, hipStream_t stream) {
    static int grid_blocks = 0;
    if (grid_blocks == 0) {
        if (n_in != 22 || ws_size < WS_END) { fprintf(stderr, "kernel_launch: unexpected n_in %d / ws_size %zu\n", n_in, ws_size); grid_blocks = -1; return; }
        int dev = 0, cus = 0, per_cu = 0;
        hipGetDevice(&dev);
        hipDeviceGetAttribute(&cus, hipDeviceAttributeMultiprocessorCount, dev);
        hipFuncSetAttribute((const void*)hymba_fwd, hipFuncAttributeMaxDynamicSharedMemorySize, LDS_BYTES);
        hipOccupancyMaxActiveBlocksPerMultiprocessor(&per_cu, (const void*)hymba_fwd, 512, LDS_BYTES);
        if (per_cu < 1) { fprintf(stderr, "kernel_launch: occupancy query says %d blocks per CU\n", per_cu); per_cu = 1; }
        (void)hipGetLastError();
        grid_blocks = cus * 1;
    }
    if (grid_blocks < 0) return;
    Params p{};
    for (int i = 0; i < 22; ++i) p.in[i] = (const float*)d_in[i];
    p.out = (float*)d_out; p.ws = (GAS unsigned char*)d_ws;
    if (hipMemsetAsync((unsigned char*)d_ws + WS_CTL, 0, CTL_BYTES, stream) != hipSuccess) { fprintf(stderr, "kernel_launch: memset failed\n"); return; }
    void* args[] = {&p};
    hipError_t e = hipLaunchCooperativeKernel((const void*)hymba_fwd, dim3(grid_blocks), dim3(512), args, LDS_BYTES, stream);
    if (e != hipSuccess) fprintf(stderr, "cooperative launch failed: %s (grid %d)\n", hipGetErrorString(e), grid_blocks);
}
```

```cpp
#include <hip/hip_runtime.h>
#include <hip/hip_cooperative_groups.h>
#include <cstdio>
#include <cstdint>
namespace cg = cooperative_groups;
namespace pg8 {
#define PG8_LAS __attribute__((address_space(3)))
typedef unsigned short bf16_t;
typedef short bf16x8 __attribute__((ext_vector_type(8)));
typedef float f32x4 __attribute__((ext_vector_type(4)));
typedef unsigned u32x4 __attribute__((ext_vector_type(4)));
constexpr int BM = 256, BK = 64, HALF = 128, HTB = HALF * BK * 2  , STAGE_BYTES = 8 * HTB, NXCD = 8, WGM = 8;

__host__ __device__ __forceinline__ int lds_byte(int r, int c) { const int st = (r >> 4) * 2 + (c >> 5), rr = r & 15, cc = c & 31, ob = rr * 64 + cc * 2; return st * 1024 + (ob ^ (((ob >> 9) & 1) << 5)); }
__host__ __device__ __forceinline__ void stage_rc(int b, int& R, int& C) { const int st = b / 1024, sb = b % 1024, swz = sb ^ (((sb >> 9) & 1) << 5); R = (st >> 1) * 16 + swz / 64; C = (st & 1) * 32 + (swz % 64) / 2; }
__host__ __device__ __forceinline__ int perm32(int rho) { const int n = rho >> 4, i = rho & 15; return 8 * (i >> 2) + 4 * n + (i & 3); }

struct Unit { int pm, pn; };
struct Gemm { const bf16_t* A; const bf16_t* Bt; int M, N, K; };

struct StaticOrder {
    int nM, nN, nwg, G, c;
    __host__ __device__ void init(int M, int N, int G_, int c_) { nM = M / BM; nN = N / BM; nwg = nM * nN; G = G_; c = c_; }
    __host__ __device__ bool next(int i, Unit& u) const {
        const long L = (long)i * G + c; if (L >= nwg) return false;
        int wgid = (int)L; { const int q = nwg / NXCD, r = nwg % NXCD, xcd = wgid % NXCD, off = wgid / NXCD; wgid = (xcd < r ? xcd * (q + 1) : r * (q + 1) + (xcd - r) * q) + off; }
        const int nig = WGM * nN, gid = wgid / nig, fm = gid * WGM, gsz = (nM - fm) < WGM ? (nM - fm) : WGM;
        u.pm = fm + ((wgid % nig) % gsz); u.pn = (wgid % nig) / gsz; return true;
    }
    __device__ __forceinline__ void a_ready(const Unit&) const {}
    __device__ __forceinline__ void done(const Unit&) const {}
};

typedef unsigned u32x2 __attribute__((ext_vector_type(2)));
__device__ __forceinline__ unsigned cvt_pk_bf16(float lo, float hi) { unsigned r; asm("v_cvt_pk_bf16_f32 %0, %1, %2" : "=v"(r) : "v"(lo), "v"(hi)); return r; }
__device__ __forceinline__ float ssp_sum(const float* p, int row) {
    float s = 0.f;
#pragma unroll
    for (int i = 0; i < 8; ++i) { const f32x4 v = *(const f32x4*)(p + ((size_t)i * 8192 + row) * 4); s += (v[0] + v[1]) + (v[2] + v[3]); }
    return s;
}
template <class Sched> __device__ __forceinline__ void rstd_table(PG8_LAS float* rtab, const float* ss, const Sched& S, int tid) {
    float v[4]; bool ok[4];
#pragma unroll
    for (int k = 0; k < 4; ++k) { const int i = 2 * k + (tid >> 8); Unit u; ok[k] = S.next(i, u); v[k] = ok[k] ? ssp_sum(ss, u.pm * BM + (tid & 255)) : 0.f; }
#pragma unroll
    for (int k = 0; k < 4; ++k) if (ok[k]) rtab[(2 * k + (tid >> 8)) * 256 + (tid & 255)] = rsqrtf(v[k] * (1.0f / 2048.0f) + 1e-6f);
    __syncthreads();
}
#define PG8_ROW_RSTD(rs, ss, row0) float rs[2][4]; { const int lane_ = (int)(threadIdx.x & 63u); \
    const float v0_ = rsqrtf(ssp_sum((ss), (row0) + (lane_ >> 4) * 16) * (1.0f / 2048.0f) + 1e-6f), v1_ = rsqrtf(ssp_sum((ss), (row0) + HALF + (lane_ >> 4) * 16) * (1.0f / 2048.0f) + 1e-6f); \
    _Pragma("unroll") for (int m_ = 0; m_ < 4; ++m_) { rs[0][m_] = __shfl(v0_, (lane_ & 15) + 16 * m_); rs[1][m_] = __shfl(v1_, (lane_ & 15) + 16 * m_); } }
struct EpiStoreF32 {
    static constexpr bool PERM = false, AFTER_DRAIN = false;
    float* O; int ldc; const PG8_LAS float* rtab; mutable int ui;
    bf16_t* qkv;
    __device__ __forceinline__ void operator()(const f32x4 (&acc)[2][2][4][2], const Unit& u, int wr, int wc, int fr, int fq) const {
        const int row0 = u.pm * BM + wr * 64 + fr, col0 = u.pn * BM + wc * 32 + 4 * fq;
        const PG8_LAS float* rt = rtab + ui * 256 + wr * 64 + fr; ++ui;
#pragma unroll
        for (int ai = 0; ai < 2; ++ai)
#pragma unroll
            for (int m = 0; m < 4; ++m) { const int row = row0 + ai * HALF + m * 16; float* rowp = O + (size_t)row * ldc + col0;
                const float rs = rt[ai * HALF + m * 16];
                if (u.pn < 6 || (u.pn >> 1) == 4) {
                    const float sc = (u.pn < 2) ? 0.125f * 1.4426950408889634f : 1.0f;
                    bf16_t* bp = qkv + ((size_t)(u.pn < 6 ? (u.pn >> 1) : 3) * 8192 + row) * 512 + (u.pn & 1) * 256 + wc * 32 + 4 * fq;
#pragma unroll
                    for (int bj = 0; bj < 2; ++bj)
#pragma unroll
                        for (int n = 0; n < 2; ++n) { f32x4 v = acc[ai][bj][m][n] * rs; if (u.pn < 2) v = v * sc;
                            u32x2 w; w.x = cvt_pk_bf16(v[0], v[1]); w.y = cvt_pk_bf16(v[2], v[3]); *(u32x2*)(bp + bj * HALF + n * 16) = w; }
                } else {
#pragma unroll
                for (int bj = 0; bj < 2; ++bj)
#pragma unroll
                    for (int n = 0; n < 2; ++n) *(f32x4*)(rowp + bj * HALF + n * 16) = acc[ai][bj][m][n] * rs; } }
    }
};
struct EpiResid {
    static constexpr bool PERM = false, AFTER_DRAIN = false;
    const float* base; float* out; bf16_t* xb; float* ss; const float* gain; int ldc;
    __device__ __forceinline__ void operator()(const f32x4 (&acc)[2][2][4][2], const Unit& u, int wr, int wc, int fr, int fq) const {
        const int row0 = u.pm * BM + wr * 64 + fr, col0 = u.pn * BM + wc * 32 + 4 * fq;
        f32x4 gv[2][2];
#pragma unroll
        for (int bj = 0; bj < 2; ++bj)
#pragma unroll
            for (int n = 0; n < 2; ++n) gv[bj][n] = *(const f32x4*)(gain + col0 + bj * HALF + n * 16);
#pragma unroll
        for (int ai = 0; ai < 2; ++ai) {
            f32x4 pre[4][2][2];
#pragma unroll
            for (int m = 0; m < 4; ++m)
#pragma unroll
                for (int bj = 0; bj < 2; ++bj)
#pragma unroll
                    for (int n = 0; n < 2; ++n) pre[m][bj][n] = *(const f32x4*)(base + (size_t)(row0 + ai * HALF + m * 16) * ldc + col0 + bj * HALF + n * 16);
#pragma unroll
            for (int m = 0; m < 4; ++m) { const int row = row0 + ai * HALF + m * 16; const size_t off = (size_t)row * ldc + col0; float s = 0.f;
#pragma unroll
                for (int bj = 0; bj < 2; ++bj)
#pragma unroll
                    for (int n = 0; n < 2; ++n) { const f32x4 b = pre[m][bj][n]; const f32x4 v = b + acc[ai][bj][m][n];
                        *(f32x4*)(out + off + bj * HALF + n * 16) = v; s += (v[0] * v[0] + v[1] * v[1]) + (v[2] * v[2] + v[3] * v[3]);
                        if (xb) { const f32x4 y = v * gv[bj][n]; u32x2 w; w.x = cvt_pk_bf16(y[0], y[1]); w.y = cvt_pk_bf16(y[2], y[3]); *(u32x2*)(xb + off + bj * HALF + n * 16) = w; } }
                s += __shfl_xor(s, 16); s += __shfl_xor(s, 32);
                if (fq == 0) ss[((size_t)u.pn * 8192 + row) * 4 + wc] = s; }
            asm volatile("" ::: "memory");
        }
    }
};
struct EpiSwiglu {
    static constexpr bool PERM = true, AFTER_DRAIN = false;
    bf16_t* O; int ldc; const PG8_LAS float* rtab; mutable int ui;
    __device__ __forceinline__ void operator()(const f32x4 (&acc)[2][2][4][2], const Unit& u, int wr, int wc, int fr, int fq) const {
        const int row0 = u.pm * BM + wr * 64 + fr, col0 = u.pn * HALF + wc * 32 + 8 * fq;
        const PG8_LAS float* rt = rtab + ui * 256 + wr * 64 + fr; ++ui;
#pragma unroll
        for (int ai = 0; ai < 2; ++ai)
#pragma unroll
            for (int m = 0; m < 4; ++m) {
                const float rs = rt[ai * HALF + m * 16];
                float h[8];
#pragma unroll
                for (int n = 0; n < 2; ++n)
#pragma unroll
                    for (int e = 0; e < 4; ++e) { const float g = acc[ai][0][m][n][e] * rs, up = acc[ai][1][m][n][e] * rs; h[n * 4 + e] = g * __builtin_amdgcn_rcpf(1.0f + __builtin_amdgcn_exp2f(g * -1.4426950408889634f)) * up; }
                u32x4 w; w.x = cvt_pk_bf16(h[0], h[1]); w.y = cvt_pk_bf16(h[2], h[3]); w.z = cvt_pk_bf16(h[4], h[5]); w.w = cvt_pk_bf16(h[6], h[7]);
                *(u32x4*)(O + (size_t)(row0 + ai * HALF + m * 16) * ldc + col0) = w; }
    }
};
template <class Epi, class Sched, bool ALIGN_EPI = false, bool SP2 = false>
__device__ __forceinline__ void gemm_phase(PG8_LAS unsigned char* lds, const Gemm g, const Sched& S, const Epi& E, const int tid) {
    const int wid = __builtin_amdgcn_readfirstlane(tid >> 6), lane = tid & 63, wr = wid >> 2, wc = wid & 3, fr = lane & 15, fq = lane >> 4;
    const int K = g.K, nt = K / BK;
    unsigned voffA[2], voffB[2];
#pragma unroll
    for (int i = 0; i < 2; ++i) { int R, C; stage_rc(tid * 16 + i * 8192, R, C); const int Rb = Epi::PERM ? ((R & ~31) + perm32(R & 31)) : R;
        voffA[i] = (unsigned)(R * K + C) * 2u; voffB[i] = (unsigned)(Rb * K + C) * 2u; }
    const size_t kstep = (size_t)(BK * 2);
    const size_t hstep = (size_t)HALF * K * 2;
    const size_t tstep = 2 * hstep;
    const unsigned ldsw = (unsigned)wid * 1024u;
    const int aoff = lds_byte(wr * 64 + fr, fq * 8), boff = lds_byte(wc * 32 + fr, fq * 8);
#define PG8_SA(b, h) (((b) * 2 + (h)) * HTB)
#define PG8_SB(b, h) ((4 + (b) * 2 + (h)) * HTB)
#define PG8_STAGE(bufoff, gbase, voff) do { _Pragma("unroll") for (int _i = 0; _i < 2; ++_i) \
        __builtin_amdgcn_global_load_lds((const unsigned*)((const char*)(gbase) + (voff)[_i]), (PG8_LAS unsigned*)(lds + (bufoff) + ldsw + _i * 8192), 16, 0, 0); } while (0)
#define PG8_LDA(dst, b, h) do { _Pragma("unroll") for (int m = 0; m < 4; ++m) _Pragma("unroll") for (int k = 0; k < 2; ++k) dst[m][k] = *(const PG8_LAS bf16x8*)(lds + PG8_SA(b, h) + aoff + m * 2048 + k * 1024); } while (0)
#define PG8_LDB(dst, b, h) do { _Pragma("unroll") for (int n = 0; n < 2; ++n) _Pragma("unroll") for (int k = 0; k < 2; ++k) dst[n][k] = *(const PG8_LAS bf16x8*)(lds + PG8_SB(b, h) + boff + n * 2048 + k * 1024); } while (0)
#define PG8_MMA(ai, bj, At, Bt) do { __builtin_amdgcn_s_setprio(1); _Pragma("unroll") for (int m = 0; m < 4; ++m) _Pragma("unroll") for (int n = 0; n < 2; ++n) _Pragma("unroll") for (int k = 0; k < 2; ++k) \
        acc[ai][bj][m][n] = __builtin_amdgcn_mfma_f32_16x16x32_bf16(Bt[n][k], At[m][k], acc[ai][bj][m][n], 0, 0, 0); __builtin_amdgcn_s_setprio(0); } while (0)
#define PG8_WAIT_V(n) asm volatile("s_waitcnt vmcnt(" #n ")" ::: "memory")
#define PG8_WAIT_L(n) asm volatile("s_waitcnt lgkmcnt(" #n ")" ::: "memory")
#define PG8_BAR __builtin_amdgcn_s_barrier()
#define PG8_SCHED __builtin_amdgcn_sched_barrier(0)
    Unit cur, nxt; int ui = 0;
    if (!S.next(0, cur)) return;
    f32x4 acc[2][2][4][2];
#pragma unroll
    for (int a = 0; a < 2; ++a)
#pragma unroll
        for (int b = 0; b < 2; ++b)
#pragma unroll
            for (int m = 0; m < 4; ++m)
#pragma unroll
                for (int n = 0; n < 2; ++n) acc[a][b][m][n] = (f32x4){0.f, 0.f, 0.f, 0.f};
    bf16x8 At[4][2], B0[2][2], B1[2][2];
    const char* cA = (const char*)g.A + (size_t)cur.pm * tstep; const char* cB = (const char*)g.Bt + (size_t)cur.pn * tstep;
    S.a_ready(cur);
    if constexpr (SP2) {
        PG8_STAGE(PG8_SB(0, 0), cB, voffB); PG8_STAGE(PG8_SB(0, 1), cB + hstep, voffB); PG8_STAGE(PG8_SA(0, 0), cA, voffA); PG8_STAGE(PG8_SA(0, 1), cA + hstep, voffA);
        if (wr == 1) PG8_BAR;
        PG8_WAIT_V(2); PG8_BAR;
        PG8_STAGE(PG8_SB(1, 0), cB + kstep, voffB); PG8_STAGE(PG8_SA(1, 0), cA + kstep, voffA); PG8_STAGE(PG8_SB(1, 1), cB + hstep + kstep, voffB);
        PG8_WAIT_V(6); PG8_BAR;
    } else {
        PG8_STAGE(PG8_SB(0, 0), cB, voffB); PG8_STAGE(PG8_SA(0, 0), cA, voffA); PG8_STAGE(PG8_SB(0, 1), cB + hstep, voffB); PG8_STAGE(PG8_SA(0, 1), cA + hstep, voffA);
        if (wr == 1) PG8_BAR;
        PG8_WAIT_V(4); PG8_BAR;
        PG8_STAGE(PG8_SB(1, 0), cB + kstep, voffB); PG8_STAGE(PG8_SA(1, 0), cA + kstep, voffA); PG8_STAGE(PG8_SB(1, 1), cB + hstep + kstep, voffB);
        PG8_WAIT_V(6); PG8_BAR;
    }
    for (;;) {
        const bool has_next = S.next(ui + 1, nxt);
        const char* nA = has_next ? (const char*)g.A + (size_t)nxt.pm * tstep : cA; const char* nB = has_next ? (const char*)g.Bt + (size_t)nxt.pn * tstep : cB;
        for (int t = 0; t < nt; t += 2) {
            const bool last = (t == nt - 2);
            const char* a1 = cA + (size_t)(t + 1) * kstep;
            const char* a2 = last ? nA : cA + (size_t)(t + 2) * kstep; const char* b2 = last ? nB : cB + (size_t)(t + 2) * kstep;
            const char* a3 = a2 + kstep; const char* b3 = b2 + kstep;
            if (last && has_next) S.a_ready(nxt);
            if constexpr (SP2) {
            PG8_LDB(B0, 0, 0); PG8_LDB(B1, 0, 1); PG8_SCHED; PG8_LDA(At, 0, 0); PG8_STAGE(PG8_SA(1, 1), a1 + hstep, voffA);
            PG8_WAIT_V(8); PG8_WAIT_L(0); PG8_BAR; PG8_MMA(0, 0, At, B0); PG8_MMA(0, 1, At, B1); PG8_BAR; PG8_SCHED;
            PG8_LDA(At, 0, 1); PG8_STAGE(PG8_SB(0, 0), b2, voffB); PG8_STAGE(PG8_SB(0, 1), b2 + hstep, voffB); PG8_STAGE(PG8_SA(0, 0), a2, voffA);
            PG8_WAIT_V(8); PG8_WAIT_L(0); PG8_BAR; PG8_MMA(1, 0, At, B0); PG8_MMA(1, 1, At, B1); PG8_BAR; PG8_SCHED;
            PG8_LDB(B0, 1, 0); PG8_LDB(B1, 1, 1); PG8_SCHED; PG8_LDA(At, 1, 0); PG8_STAGE(PG8_SA(0, 1), a2 + hstep, voffA);
            PG8_WAIT_V(8); PG8_WAIT_L(0); PG8_BAR; PG8_MMA(0, 0, At, B0); PG8_MMA(0, 1, At, B1); PG8_BAR; PG8_SCHED;
            PG8_LDA(At, 1, 1); PG8_STAGE(PG8_SB(1, 0), b3, voffB); PG8_STAGE(PG8_SB(1, 1), b3 + hstep, voffB); PG8_STAGE(PG8_SA(1, 0), a3, voffA);
            PG8_WAIT_V(8); PG8_WAIT_L(0); PG8_BAR; PG8_MMA(1, 0, At, B0); PG8_MMA(1, 1, At, B1); PG8_BAR; PG8_SCHED;
            } else {
            PG8_LDB(B0, 0, 0); PG8_SCHED; PG8_LDA(At, 0, 0); PG8_STAGE(PG8_SA(1, 1), a1 + hstep, voffA);
            PG8_WAIT_L(8); PG8_BAR; PG8_WAIT_L(0); PG8_MMA(0, 0, At, B0); PG8_BAR; PG8_SCHED;
            PG8_LDB(B1, 0, 1); PG8_STAGE(PG8_SB(0, 0), b2, voffB);
            PG8_BAR; PG8_WAIT_L(0); PG8_MMA(0, 1, At, B1); PG8_BAR;
            PG8_LDA(At, 0, 1); PG8_STAGE(PG8_SA(0, 0), a2, voffA);
            PG8_BAR; PG8_WAIT_L(0); PG8_MMA(1, 0, At, B0); PG8_BAR; PG8_SCHED;
            PG8_STAGE(PG8_SB(0, 1), b2 + hstep, voffB);
            PG8_WAIT_V(6); PG8_BAR; PG8_MMA(1, 1, At, B1); PG8_BAR;
            PG8_LDB(B0, 1, 0); PG8_SCHED; PG8_LDA(At, 1, 0); PG8_STAGE(PG8_SA(0, 1), a2 + hstep, voffA);
            PG8_WAIT_L(8); PG8_BAR; PG8_WAIT_L(0); PG8_MMA(0, 0, At, B0); PG8_BAR; PG8_SCHED;
            PG8_LDB(B1, 1, 1); PG8_STAGE(PG8_SB(1, 0), b3, voffB);
            PG8_BAR; PG8_WAIT_L(0); PG8_MMA(0, 1, At, B1); PG8_BAR;
            PG8_LDA(At, 1, 1); PG8_STAGE(PG8_SA(1, 0), a3, voffA);
            PG8_BAR; PG8_WAIT_L(0); PG8_MMA(1, 0, At, B0); PG8_BAR; PG8_SCHED;
            PG8_STAGE(PG8_SB(1, 1), b3 + hstep, voffB);
            PG8_WAIT_V(6); PG8_BAR; PG8_MMA(1, 1, At, B1); PG8_BAR;
            }
        }
        if constexpr (ALIGN_EPI) { if (wr == 0) PG8_BAR; }
        if constexpr (!Epi::AFTER_DRAIN) { E(acc, cur, wr, wc, fr, fq); S.done(cur); }
        if (!has_next) break;
#pragma unroll
        for (int a = 0; a < 2; ++a)
#pragma unroll
            for (int b = 0; b < 2; ++b)
#pragma unroll
                for (int m = 0; m < 4; ++m)
#pragma unroll
                    for (int n = 0; n < 2; ++n) acc[a][b][m][n] = (f32x4){0.f, 0.f, 0.f, 0.f};
        cur = nxt; cA = nA; cB = nB; ++ui;
        if constexpr (ALIGN_EPI) { if (wr == 1) PG8_BAR; }
    }
    PG8_WAIT_V(0);
    if constexpr (!ALIGN_EPI) { if (wr == 0) PG8_BAR; }
    PG8_BAR;
    if constexpr (Epi::AFTER_DRAIN) { E.fused(acc, cur, wr, wc, fr, fq, lds, wid, lane); S.done(cur); }
#undef PG8_SA
#undef PG8_SB
#undef PG8_STAGE
#undef PG8_LDA
#undef PG8_LDB
#undef PG8_MMA
#undef PG8_WAIT_V
#undef PG8_WAIT_L
#undef PG8_BAR
#undef PG8_SCHED
}
}

#define LAS __attribute__((address_space(3)))
typedef unsigned short bf16_t;
typedef short bf16x8 __attribute__((ext_vector_type(8)));
typedef short s16x4 __attribute__((ext_vector_type(4)));
typedef float f32x4 __attribute__((ext_vector_type(4)));
typedef float f32x2 __attribute__((ext_vector_type(2)));
typedef unsigned u32x4 __attribute__((ext_vector_type(4)));
typedef unsigned u32x2 __attribute__((ext_vector_type(2)));
typedef LAS unsigned char* lds_t;

constexpr int NT = 8192, DM = 2048, SEQ = 2048, NB = 4, DEPTH = 4;
constexpr int INW = 5144, NPROJ = 5376, FFH = 5632;
constexpr int PC_FQ = 0, PC_FK = 512, PC_FV = 1024, PC_GQ = 1536, PC_GK = 1792, PC_GV = 2048, PC_GG = 2560, PC_LG = 3072, PC_LX = 4096, PC_FF = 5120, PC_GR = 5128;
constexpr float EPS = 1e-6f;
constexpr float LOG2E = 1.4426950408889634f;
constexpr int LDS_BYTES = 147456;

constexpr size_t MiB = 1u << 20;
constexpr size_t WS_WIN = 0, WS_WOUT = 21 * MiB, WS_WGU = 29 * MiB, WS_WDN = 73 * MiB;
constexpr size_t WS_XW = 96 * MiB;
constexpr size_t WS_HB = 160 * MiB;
constexpr size_t WS_PROJ = 192 * MiB;
constexpr size_t WS_MIX = 360 * MiB;
constexpr size_t WS_FOXO = 392 * MiB;
constexpr size_t WS_CBUF = 400 * MiB;
constexpr size_t WS_GQT = 401 * MiB;
constexpr size_t WS_GA = 405 * MiB;
constexpr size_t WS_GVT = 407 * MiB;
constexpr size_t WS_GU = 415 * MiB;
constexpr size_t WS_GS = 447 * MiB;
constexpr size_t WS_GDEC = 463 * MiB;
constexpr size_t WS_LA = 464 * MiB;
constexpr size_t WS_LU = 496 * MiB;
constexpr size_t WS_AGP = 528 * MiB, WS_AGH = 529 * MiB, WS_HIN = 530 * MiB;
constexpr size_t WS_SS1 = 532 * MiB, WS_SS2 = 537 * MiB;
constexpr size_t WS_CTL = 531 * MiB, CTL_BYTES = 16384;
constexpr size_t WS_GWT = 541 * MiB;
constexpr size_t WS_SMALL = 542 * MiB, SMALL_BYTES = 10 * MiB;
constexpr size_t SL_CBUF = 0, SL_GDEC = 256 * 1024, SL_GWT = 512 * 1024, SL_AGP = 1 * MiB, SL_AGH = 2 * MiB, SL_HIN = 3 * MiB, SL_GQT = 4 * MiB, SL_GA = 8 * MiB;
constexpr size_t WS_QKV = 582 * MiB;
constexpr size_t WS_END = 614 * MiB;

#define GAS __attribute__((address_space(1)))
struct Params { const float* in[22]; float* out; GAS unsigned char* ws; GAS unsigned char* wsl; };

__device__ __forceinline__ unsigned pk2(float lo, float hi) { unsigned r; asm("v_cvt_pk_bf16_f32 %0, %1, %2" : "=v"(r) : "v"(lo), "v"(hi)); return r; }
__device__ __forceinline__ bf16_t f2bf(float f) { return (bf16_t)(pk2(f, 0.f) & 0xffffu); }
__device__ __forceinline__ float bf2f(unsigned b) { return __uint_as_float(b << 16); }
__device__ __forceinline__ float logsig(float x) { return fminf(x, 0.f) - __logf(1.0f + __expf(-fabsf(x))); }
__device__ __forceinline__ float sigmoidf(float x) { return __builtin_amdgcn_rcpf(1.0f + __expf(-x)); }
__device__ __forceinline__ float neg_expm1_small(float y) {
    const float pl = y * (1.0f + y * (0.5f + y * (0.16666667f + y * (0.041666668f + y * (0.0083333338f + y * (0.0013888889f + y * 0.00019841270f))))));
    return (y > -0.25f) ? -pl : (1.0f - __expf(y));
}
__device__ __forceinline__ f32x4 mfma16(bf16x8 a, bf16x8 b, f32x4 c) { return __builtin_amdgcn_mfma_f32_16x16x32_bf16(a, b, c, 0, 0, 0); }
__device__ __forceinline__ float wave_sum(float v) {
#pragma unroll
    for (int o = 1; o < 64; o <<= 1) v += __shfl_xor(v, o);
    return v;
}
__device__ __forceinline__ bf16x8 pack8(f32x4 a, f32x4 b) {
    u32x4 w; w.x = pk2(a[0], a[1]); w.y = pk2(a[2], a[3]); w.z = pk2(b[0], b[1]); w.w = pk2(b[2], b[3]);
    return __builtin_bit_cast(bf16x8, w);
}

template <int MODE>
__device__ __forceinline__ void wconv_item(const float* W0, const float* W1, int Nsrc, int K, bf16_t* Bt, int NG, int item, int lane, const float* gain) {
    const int kb = item / NG, nb = item - kb * NG;
    const int kg = lane >> 4, ng = lane & 15;
    const int np = nb * 64 + ng * 4, k = kb * 32 + kg * 8;
    const float* src = W0; int c = np;
    if (MODE == 0) { c = np < 1536 ? np : np < 3072 ? np + 8 : np < 5120 ? np + 24 : np < 5128 ? np - 5120 + 1536 : np < 5144 ? np - 5128 + 3080 : -1; }
    if (MODE == 2) { const int pn = np >> 8, j = np & 255; src = j < 128 ? W0 : W1; c = pn * 128 + (j & 127); }
    f32x4 v[8];
#pragma unroll
    for (int i = 0; i < 8; ++i) v[i] = (c >= 0) ? *(const f32x4*)(src + (size_t)(k + i) * Nsrc + c) : (f32x4){0.f, 0.f, 0.f, 0.f};
    if (gain) { const f32x4 g0 = *(const f32x4*)(gain + k), g1 = *(const f32x4*)(gain + k + 4);
#pragma unroll
        for (int i = 0; i < 4; ++i) { v[i] = v[i] * g0[i]; v[4 + i] = v[4 + i] * g1[i]; } }
#pragma unroll
    for (int j = 0; j < 4; ++j) {
        u32x4 o; o.x = pk2(v[0][j], v[1][j]); o.y = pk2(v[2][j], v[3][j]); o.z = pk2(v[4][j], v[5][j]); o.w = pk2(v[6][j], v[7][j]);
        *(u32x4*)(Bt + (size_t)(np + j) * K + k) = o;
    }
}

__device__ __forceinline__ void prep_row(const float* xrow, bf16_t* orow, float* ss, int row, int lane, const float* g) {
    const f32x4* xr = (const f32x4*)xrow + lane; const f32x4* gr = (const f32x4*)g + lane;
    f32x4 v[8]; float s = 0.f;
#pragma unroll
    for (int j = 0; j < 8; ++j) { v[j] = xr[64 * j]; s += (v[j][0] * v[j][0] + v[j][1] * v[j][1]) + (v[j][2] * v[j][2] + v[j][3] * v[j][3]); }
    s = wave_sum(s);
    if (lane < 32) ss[((size_t)(lane >> 2) * 8192 + row) * 4 + (lane & 3)] = (lane == 0) ? s : 0.f;
#pragma unroll
    for (int j = 0; j < 8; ++j) { const f32x4 y = v[j] * gr[64 * j]; u32x2 w; w.x = pk2(y[0], y[1]); w.y = pk2(y[2], y[3]); ((u32x2*)orow)[lane + 64 * j] = w; }
}
__device__ __forceinline__ void final_row(const float* xrow, const float* g, float* orow, float ss, int lane) {
    const f32x4* xr = (const f32x4*)xrow + lane; const f32x4* gr = (const f32x4*)g + lane;
    const float rstd = rsqrtf(ss * (1.0f / 2048.0f) + EPS);
#pragma unroll
    for (int j = 0; j < 8; ++j) ((f32x4*)orow)[lane + 64 * j] = xr[64 * j] * rstd * gr[64 * j];
}

__device__ __forceinline__ void phase_wconv(const Params& p, int l, int mask, int w, int nw, int lane) {
    GAS unsigned char* ws = p.ws;
    constexpr int I_IN = 64 * 84, I_OUT = 64 * 32, I_GU = 64 * 176, I_DN = 176 * 32;
    const float* w_in = p.in[2] + (size_t)l * DM * INW;
    const float* w_out = p.in[16] + (size_t)l * DM * DM;
    const float* w_gate = p.in[18] + (size_t)l * DM * FFH;
    const float* w_up = p.in[19] + (size_t)l * DM * FFH;
    const float* w_down = p.in[20] + (size_t)l * FFH * DM;
    if (mask & 1) for (int it = w; it < I_IN; it += nw) wconv_item<0>(w_in, w_in, INW, DM, (bf16_t*)(ws + WS_WIN), 84, it, lane, nullptr);
    if (mask & 2) for (int it = w; it < I_OUT; it += nw) wconv_item<1>(w_out, w_out, DM, DM, (bf16_t*)(ws + WS_WOUT), 32, it, lane, nullptr);
    if (mask & 4) for (int it = w; it < I_GU; it += nw) wconv_item<2>(w_gate, w_up, FFH, DM, (bf16_t*)(ws + WS_WGU), 176, it, lane, nullptr);
    if (mask & 8) for (int it = w; it < I_DN; it += nw) wconv_item<1>(w_down, w_down, DM, FFH, (bf16_t*)(ws + WS_WDN), 32, it, lane, nullptr);
}

__device__ __forceinline__ void fox_cumsum(const Params& p, int l, int seq, int lane) {
    const float* proj = (const float*)(p.ws + WS_PROJ);
    float* cbuf = (float*)(p.wsl + SL_CBUF);
    const int b = seq >> 3, h = seq & 7;
    const float bias = p.in[3][l * 8 + h];
    const float* src = proj + (size_t)(b * SEQ + lane * 32) * NPROJ + PC_FF + h;
    float ls[32];
#pragma unroll
    for (int i = 0; i < 32; ++i) ls[i] = src[(size_t)i * NPROJ];
    float s = 0.f;
#pragma unroll
    for (int i = 0; i < 32; ++i) { ls[i] = logsig(ls[i] + bias); s += ls[i]; }
    float incl = s;
#pragma unroll
    for (int o = 1; o < 64; o <<= 1) { const float t = __shfl_up(incl, o); if (lane >= o) incl += t; }
    float run = incl - s;
    float* dst = cbuf + seq * SEQ + lane * 32;
#pragma unroll
    for (int i = 0; i < 32; ++i) { run += ls[i]; dst[i] = run * LOG2E; }
}

__device__ __forceinline__ void gate_wt_prep(const Params& p, int l, int gid) {
    if (gid < 2 * 16 * 64 * 64) {
        const int d = gid & 63, e = (gid >> 6) & 63, n = (gid >> 12) & 15, g = gid >> 16;
        const float* w = (g == 0 ? p.in[10] : p.in[12]) + ((size_t)(l * 16 + n) * 64 + d) * 64 + e;
        ((bf16_t*)(p.wsl + SL_GWT))[gid] = f2bf(*w);
    }
}

__device__ __forceinline__ void gla_prep_witem(const Params& p, int l, int ch, lds_t wl_in, int lane_in) {
    int lane = lane_in; asm volatile("" : "+v"(lane));
    unsigned wlo_ = 0; asm volatile("" : "+s"(wlo_)); lds_t wl = wl_in + wlo_;
    const float* proj = (const float*)(p.ws + WS_PROJ);
    const int bh = ch >> 6, n = ch & 63, b = bh >> 2, h = bh & 3;
    const int t0 = b * SEQ + n * 32;
    LAS bf16_t* Qs = (LAS bf16_t*)(wl);
    LAS bf16_t* Ks = (LAS bf16_t*)(wl + 4608);
    LAS bf16_t* KstT = (LAS bf16_t*)(wl);
    LAS bf16_t* VT = (LAS bf16_t*)(wl + 5120);
    const int r = lane & 15, q = lane >> 4;
    float bcum[32];
    {
        const float* w2 = p.in[5] + (size_t)l * 16 * 256 + h * 64 + lane;
        const float gb = p.in[6][l * 256 + h * 64 + lane];
        float w2r[16];
#pragma unroll
        for (int i = 0; i < 16; ++i) w2r[i] = w2[i * 256];
        LAS float* grs = (LAS float*)(wl);
        { const float* gsrc = proj + (size_t)(t0 + (lane >> 1)) * NPROJ + PC_GR + (lane & 1) * 8;
          const f32x4 g0 = *(const f32x4*)gsrc, g1 = *(const f32x4*)(gsrc + 4);
          *(LAS f32x4*)(grs + lane * 8) = g0; *(LAS f32x4*)(grs + lane * 8 + 4) = g1; }
        float run = 0.f;
#pragma unroll
        for (int t = 0; t < 32; ++t) {
            f32x4 gr4[4];
#pragma unroll
            for (int i = 0; i < 4; ++i) gr4[i] = *(LAS f32x4*)(grs + t * 16 + 4 * i);
            float z = gb;
#pragma unroll
            for (int i = 0; i < 16; ++i) z += gr4[i >> 2][i & 3] * w2r[i];
            run += logsig(z) * (1.0f / 16.0f);
            bcum[t] = run;
        }
        asm volatile("" ::: "memory");
    }
    const float bl = bcum[31];
    unsigned kstp[16];
    {
        bf16_t* qtg = (bf16_t*)(p.wsl + SL_GQT) + (size_t)t0 * 256 + h * 64 + lane;
        float ksprev = 0.f;
#pragma unroll
        for (int t = 0; t < 32; ++t) {
            const float* prow = proj + (size_t)(t0 + t) * NPROJ;
            const float gq = prow[PC_GQ + h * 64 + lane], gk = prow[PC_GK + h * 64 + lane];
            const float bv = bcum[t];
            const float qt = gq * 0.125f * __expf(bv), kt = gk * __expf(-bv), ks = gk * __expf(bl - bv);
            const bf16_t qb16 = f2bf(qt);
            Qs[t * 72 + lane] = qb16; Ks[t * 72 + lane] = f2bf(kt);
            qtg[(size_t)t * 256] = qb16;
            if (t & 1) kstp[t >> 1] = pk2(ksprev, ks); else ksprev = ks;
            if ((t & 7) == 7) asm volatile("" ::: "memory");
        }
        ((float*)(p.wsl + SL_GDEC))[ch * 64 + lane] = __expf(bl);
    }
    {
        bf16_t* ab = (bf16_t*)(p.wsl + SL_GA) + (size_t)ch * 1024;
#pragma unroll
        for (int tt = 0; tt < 2; ++tt)
#pragma unroll
            for (int st = 0; st < 2; ++st) {
                f32x4 acc = {0.f, 0.f, 0.f, 0.f};
#pragma unroll
                for (int ks = 0; ks < 2; ++ks) {
                    const bf16x8 a = *(LAS bf16x8*)(Qs + (16 * tt + r) * 72 + 32 * ks + 8 * q);
                    const bf16x8 bb = *(LAS bf16x8*)(Ks + (16 * st + r) * 72 + 32 * ks + 8 * q);
                    acc = mfma16(a, bb, acc);
                }
#pragma unroll
                for (int j = 0; j < 4; ++j) { const int t = 16 * tt + 4 * q + j, s = 16 * st + r; ab[t * 32 + s] = f2bf(s <= t ? acc[j] : 0.f); }
            }
    }
#pragma unroll
    for (int i = 0; i < 4; ++i) { u32x4 w; w.x = kstp[4 * i]; w.y = kstp[4 * i + 1]; w.z = kstp[4 * i + 2]; w.w = kstp[4 * i + 3]; *(LAS u32x4*)(KstT + lane * 40 + 8 * i) = w; }
#pragma unroll
    for (int vv = 0; vv < 2; ++vv) {
        const int v = lane + 64 * vv;
        const bf16_t* vp = (const bf16_t*)(p.ws + WS_QKV) + ((size_t)3 * NT + t0) * 512 + h * 128 + v;
        unsigned vw[16];
#pragma unroll
        for (int t = 0; t < 32; t += 2) vw[t >> 1] = (unsigned)vp[(size_t)t * 512] | ((unsigned)vp[(size_t)(t + 1) * 512] << 16);
        bf16_t* vg = (bf16_t*)(p.ws + WS_GVT) + (size_t)ch * 4096 + v * 32;
#pragma unroll
        for (int i = 0; i < 4; ++i) { u32x4 w; w.x = vw[4 * i]; w.y = vw[4 * i + 1]; w.z = vw[4 * i + 2]; w.w = vw[4 * i + 3]; *(LAS u32x4*)(VT + v * 40 + 8 * i) = w; *(u32x4*)(vg + 8 * i) = w; }
    }
    {
        float* ub = (float*)(p.ws + WS_GU) + (size_t)ch * 8192;
        bf16x8 kb[4];
#pragma unroll
        for (int dt = 0; dt < 4; ++dt) kb[dt] = *(LAS bf16x8*)(KstT + (16 * dt + r) * 40 + 8 * q);
#pragma unroll
        for (int w = 0; w < 8; ++w) {
            const bf16x8 a = *(LAS bf16x8*)(VT + (16 * w + r) * 40 + 8 * q);
#pragma unroll
            for (int dt = 0; dt < 4; ++dt) {
                const f32x4 acc = mfma16(a, kb[dt], (f32x4){0.f, 0.f, 0.f, 0.f});
#pragma unroll
                for (int j = 0; j < 4; ++j) ub[(16 * w + 4 * q + j) * 64 + 16 * dt + r] = acc[j];
            }
        }
    }
}

__device__ __forceinline__ void lru_prep_witem(const Params& p, int l, int item, lds_t wl_in, int lane_in) {
    int lane = lane_in; asm volatile("" : "+v"(lane));
    unsigned wlo_ = 0; asm volatile("" : "+s"(wlo_)); lds_t wl = wl_in + wlo_;
    const float* proj = (const float*)(p.ws + WS_PROJ);
    const int gt = item >> 4, n = item & 15, tok0 = gt * 32, b = tok0 >> 11, p0 = tok0 & 2047, c0 = n * 64;
    LAS bf16_t* Xs = (LAS bf16_t*)(wl);
    LAS float* Xf = (LAS float*)(wl + 4608);
    const int r = lane & 15, q = lane >> 4;
    {
        const int c = c0 + lane;
        const float* cw = p.in[8] + (size_t)l * 4 * 1024 + c;
        const float w0 = cw[0], w1 = cw[1024], w2 = cw[2048], w3 = cw[3072], cb = p.in[9][l * 1024 + c];
        const float* lxp = proj + (size_t)(b * SEQ) * NPROJ + PC_LX + c;
        float x0 = p0 >= 3 ? lxp[(size_t)(p0 - 3) * NPROJ] : 0.f, x1 = p0 >= 2 ? lxp[(size_t)(p0 - 2) * NPROJ] : 0.f, x2 = p0 >= 1 ? lxp[(size_t)(p0 - 1) * NPROJ] : 0.f;
        float xv[32];
#pragma unroll
        for (int i = 0; i < 32; ++i) xv[i] = lxp[(size_t)(p0 + i) * NPROJ];
#pragma unroll
        for (int i = 0; i < 32; ++i) {
            const float x3 = xv[i];
            const float y = cb + w0 * x0 + w1 * x1 + w2 * x2 + w3 * x3;
            Xf[i * 68 + lane] = y; Xs[i * 72 + lane] = f2bf(y);
            x0 = x1; x1 = x2; x2 = x3;
        }
    }
    const bf16_t* gwt = (const bf16_t*)(p.wsl + SL_GWT);
    bf16x8 af[2][2];
#pragma unroll
    for (int tt = 0; tt < 2; ++tt)
#pragma unroll
        for (int ks = 0; ks < 2; ++ks) af[tt][ks] = *(LAS bf16x8*)(Xs + (16 * tt + r) * 72 + 32 * ks + 8 * q);
    float* la = (float*)(p.ws + WS_LA); float* lu = (float*)(p.ws + WS_LU);
#pragma unroll
    for (int et = 0; et < 4; ++et) {
        bf16x8 ba[2], bi[2];
#pragma unroll
        for (int ks = 0; ks < 2; ++ks) { ba[ks] = *(const bf16x8*)(gwt + ((size_t)(0 * 16 + n) * 64 + 16 * et + r) * 64 + 32 * ks + 8 * q); bi[ks] = *(const bf16x8*)(gwt + ((size_t)(1 * 16 + n) * 64 + 16 * et + r) * 64 + 32 * ks + 8 * q); }
        const int e = 16 * et + r, c = c0 + e;
        const float bba = p.in[11][l * 1024 + c], bbi = p.in[13][l * 1024 + c], lls = logsig(p.in[14][l * 1024 + c]);
        float av[2][4], uv[2][4];
#pragma unroll
        for (int tt = 0; tt < 2; ++tt) {
            f32x4 pa = {0.f, 0.f, 0.f, 0.f}, pi = {0.f, 0.f, 0.f, 0.f};
#pragma unroll
            for (int ks = 0; ks < 2; ++ks) { pa = mfma16(af[tt][ks], ba[ks], pa); pi = mfma16(af[tt][ks], bi[ks], pi); }
#pragma unroll
            for (int j = 0; j < 4; ++j) {
                const int t = 16 * tt + 4 * q + j;
                const float rg = sigmoidf(pa[j] + bba), ig = sigmoidf(pi[j] + bbi);
                const float loga = 8.0f * rg * lls;
                const float a = __expf(loga);
                const float u = __builtin_amdgcn_sqrtf(fmaxf(neg_expm1_small(2.0f * loga), 0.f)) * (ig * Xf[t * 68 + e]);
                la[(size_t)(tok0 + t) * 1024 + c] = a; lu[(size_t)(tok0 + t) * 1024 + c] = u;
                av[tt][j] = a; uv[tt][j] = u;
            }
            asm volatile("" ::: "memory");
        }
        float P = 1.f, H = 0.f;
#pragma unroll
        for (int tt = 0; tt < 2; ++tt)
#pragma unroll
            for (int qq = 0; qq < 4; ++qq) {
                if (q == qq) {
#pragma unroll
                    for (int j = 0; j < 4; ++j) { H = av[tt][j] * H + uv[tt][j]; P *= av[tt][j]; }
                }
                P = __shfl(P, r + 16 * qq); H = __shfl(H, r + 16 * qq);
            }
        if (q == 0) { ((float*)(p.wsl + SL_AGP))[gt * 1024 + c] = P; ((float*)(p.wsl + SL_AGH))[gt * 1024 + c] = H; }
    }
}

__device__ __forceinline__ void fox_attn_unit(const Params& p, int bh, int qb, lds_t lds, int tid, int wave, int lane) {
    const float* proj = (const float*)(p.ws + WS_PROJ);
    const float* cb = (const float*)(p.wsl + SL_CBUF) + bh * SEQ;
    const int b = bh >> 3, h = bh & 7;
    LAS bf16_t* Ks = (LAS bf16_t*)(lds);
    LAS bf16_t* Vt = (LAS bf16_t*)(lds + 9216);
    LAS float* cks = (LAS float*)(lds + 18432);
    const int r = lane & 15, q = lane >> 4;
    const int q0 = qb * 128, qw0 = q0 + 16 * wave, nkv = 2 * (qb + 1);
    const float C2 = 0.125f * LOG2E;
    bf16x8 qf[2];
    {
        const bf16_t* qp = (const bf16_t*)(p.ws + WS_QKV) + (size_t)(b * SEQ + qw0 + r) * 512 + h * 64 + 8 * q;
#pragma unroll
        for (int ks = 0; ks < 2; ++ks) qf[ks] = *(const bf16x8*)(qp + 32 * ks);
    }
    const float cq = cb[qw0 + r];
    float m = -1e30f, lsum = 0.f;
    f32x4 o[4];
#pragma unroll
    for (int i = 0; i < 4; ++i) o[i] = (f32x4){0.f, 0.f, 0.f, 0.f};
    const int lrow = tid >> 3, lch = (tid & 7) * 8;
    const bf16_t* kbase = (const bf16_t*)(p.ws + WS_QKV) + ((size_t)NT + b * SEQ + lrow) * 512 + h * 64 + lch;
    const int vrow = tid & 63, vch = (tid >> 6) * 8;
    const bf16_t* vbase = (const bf16_t*)(p.ws + WS_QKV) + ((size_t)2 * NT + b * SEQ + vrow) * 512 + h * 64 + vch;
    bf16x8 kA = *(const bf16x8*)kbase, vA = *(const bf16x8*)vbase;
    float ckA = tid < 64 ? cb[tid] : 0.f;
    bf16x8 kB = *(const bf16x8*)(kbase + (size_t)64 * 512), vB = *(const bf16x8*)(vbase + (size_t)64 * 512);
    float ckB = tid < 64 ? cb[64 + tid] : 0.f;
    constexpr int FOXBUF = 18432 + 256;
#define FOX_WRITE(KK, VV, CK, bufi, jn) { \
        LAS bf16_t* KsW = (LAS bf16_t*)(lds + (bufi) * FOXBUF); LAS bf16_t* VtW = (LAS bf16_t*)(lds + (bufi) * FOXBUF + 9216); LAS float* cksW = (LAS float*)(lds + (bufi) * FOXBUF + 18432); \
        *(LAS bf16x8*)(KsW + lrow * 72 + lch) = KK; \
        _Pragma("unroll") for (int i = 0; i < 8; ++i) VtW[(vch + i) * 72 + vrow] = (bf16_t)VV[i]; \
        if (tid < 64) cksW[tid] = CK; \
        if ((jn) < nkv) { const size_t off = (size_t)(jn) * 64 * 512; \
            KK = *(const bf16x8*)(kbase + off); VV = *(const bf16x8*)(vbase + off); \
            if (tid < 64) CK = cb[(jn) * 64 + tid]; } }
    __syncthreads();
    FOX_WRITE(kA, vA, ckA, 0, 2)
    asm volatile("s_waitcnt lgkmcnt(0)\n\ts_barrier" ::: "memory");
    for (int j0 = 0; j0 < nkv; j0 += 2) {
        { const int j = j0;
          FOX_WRITE(kB, vB, ckB, 1, j + 3)
          LAS bf16_t* KsX = (LAS bf16_t*)(lds); LAS bf16_t* VtX = (LAS bf16_t*)(lds + 9216); LAS float* cksX = (LAS float*)(lds + 18432);
        if (64 * j <= qw0 + 15) {
            f32x4 s[4]; float mx = -INFINITY;
            bf16x8 kfr[4][2]; f32x4 ckr[4]; s16x4 vlo[4][2], vhi[4][2];
#pragma unroll
            for (int st = 0; st < 4; ++st) {
#pragma unroll
                for (int ks = 0; ks < 2; ++ks) kfr[st][ks] = *(LAS bf16x8*)(KsX + (16 * st + r) * 72 + 32 * ks + 8 * q);
                ckr[st] = *(LAS f32x4*)(cksX + 16 * st + 4 * q);
            }
#pragma unroll
            for (int ds = 0; ds < 4; ++ds)
#pragma unroll
                for (int ks = 0; ks < 2; ++ks) { vlo[ds][ks] = *(LAS s16x4*)(VtX + (16 * ds + r) * 72 + 32 * ks + 4 * q); vhi[ds][ks] = *(LAS s16x4*)(VtX + (16 * ds + r) * 72 + 32 * ks + 16 + 4 * q); }
#pragma unroll
            for (int st = 0; st < 4; ++st) {
                f32x4 acc = {0.f, 0.f, 0.f, 0.f};
#pragma unroll
                for (int ks = 0; ks < 2; ++ks) acc = mfma16(kfr[st][ks], qf[ks], acc);
                const f32x4 ck = ckr[st];
#pragma unroll
                for (int jj = 0; jj < 4; ++jj) {
                    const int kv = 64 * j + 16 * st + 4 * q + jj;
                    float sv = acc[jj] + (cq - ck[jj]);
                    if (64 * j + 63 > qw0) sv = (kv <= qw0 + r) ? sv : -INFINITY;
                    s[st][jj] = sv; mx = fmaxf(mx, sv);
                }
            }
            mx = fmaxf(mx, __shfl_xor(mx, 16)); mx = fmaxf(mx, __shfl_xor(mx, 32));
            const float mnew = fmaxf(m, mx);
            const float alpha = __builtin_amdgcn_exp2f(m - mnew);
            m = mnew;
            float ps = 0.f;
#pragma unroll
            for (int st = 0; st < 4; ++st)
#pragma unroll
                for (int jj = 0; jj < 4; ++jj) { const float e = __builtin_amdgcn_exp2f(s[st][jj] - mnew); s[st][jj] = e; ps += e; }
            lsum = lsum * alpha + ps;
#pragma unroll
            for (int i = 0; i < 4; ++i) o[i] = o[i] * alpha;
            bf16x8 pf[2];
            pf[0] = pack8(s[0], s[1]); pf[1] = pack8(s[2], s[3]);
#pragma unroll
            for (int ds = 0; ds < 4; ++ds)
#pragma unroll
                for (int ks = 0; ks < 2; ++ks) {
                    const s16x4 lo = vlo[ds][ks], hi = vhi[ds][ks];
                    const bf16x8 a = {lo[0], lo[1], lo[2], lo[3], hi[0], hi[1], hi[2], hi[3]};
                    o[ds] = mfma16(a, pf[ks], o[ds]);
                }
        }
          asm volatile("s_waitcnt lgkmcnt(0)\n\ts_barrier" ::: "memory");
        }
        { const int j = j0 + 1;
          if (j + 1 < nkv) FOX_WRITE(kA, vA, ckA, 0, j + 3)
          LAS bf16_t* KsX = (LAS bf16_t*)(lds + FOXBUF); LAS bf16_t* VtX = (LAS bf16_t*)(lds + FOXBUF + 9216); LAS float* cksX = (LAS float*)(lds + FOXBUF + 18432);
        if (64 * j <= qw0 + 15) {
            f32x4 s[4]; float mx = -INFINITY;
            bf16x8 kfr[4][2]; f32x4 ckr[4]; s16x4 vlo[4][2], vhi[4][2];
#pragma unroll
            for (int st = 0; st < 4; ++st) {
#pragma unroll
                for (int ks = 0; ks < 2; ++ks) kfr[st][ks] = *(LAS bf16x8*)(KsX + (16 * st + r) * 72 + 32 * ks + 8 * q);
                ckr[st] = *(LAS f32x4*)(cksX + 16 * st + 4 * q);
            }
#pragma unroll
            for (int ds = 0; ds < 4; ++ds)
#pragma unroll
                for (int ks = 0; ks < 2; ++ks) { vlo[ds][ks] = *(LAS s16x4*)(VtX + (16 * ds + r) * 72 + 32 * ks + 4 * q); vhi[ds][ks] = *(LAS s16x4*)(VtX + (16 * ds + r) * 72 + 32 * ks + 16 + 4 * q); }
#pragma unroll
            for (int st = 0; st < 4; ++st) {
                f32x4 acc = {0.f, 0.f, 0.f, 0.f};
#pragma unroll
                for (int ks = 0; ks < 2; ++ks) acc = mfma16(kfr[st][ks], qf[ks], acc);
                const f32x4 ck = ckr[st];
#pragma unroll
                for (int jj = 0; jj < 4; ++jj) {
                    const int kv = 64 * j + 16 * st + 4 * q + jj;
                    float sv = acc[jj] + (cq - ck[jj]);
                    if (64 * j + 63 > qw0) sv = (kv <= qw0 + r) ? sv : -INFINITY;
                    s[st][jj] = sv; mx = fmaxf(mx, sv);
                }
            }
            mx = fmaxf(mx, __shfl_xor(mx, 16)); mx = fmaxf(mx, __shfl_xor(mx, 32));
            const float mnew = fmaxf(m, mx);
            const float alpha = __builtin_amdgcn_exp2f(m - mnew);
            m = mnew;
            float ps = 0.f;
#pragma unroll
            for (int st = 0; st < 4; ++st)
#pragma unroll
                for (int jj = 0; jj < 4; ++jj) { const float e = __builtin_amdgcn_exp2f(s[st][jj] - mnew); s[st][jj] = e; ps += e; }
            lsum = lsum * alpha + ps;
#pragma unroll
            for (int i = 0; i < 4; ++i) o[i] = o[i] * alpha;
            bf16x8 pf[2];
            pf[0] = pack8(s[0], s[1]); pf[1] = pack8(s[2], s[3]);
#pragma unroll
            for (int ds = 0; ds < 4; ++ds)
#pragma unroll
                for (int ks = 0; ks < 2; ++ks) {
                    const s16x4 lo = vlo[ds][ks], hi = vhi[ds][ks];
                    const bf16x8 a = {lo[0], lo[1], lo[2], lo[3], hi[0], hi[1], hi[2], hi[3]};
                    o[ds] = mfma16(a, pf[ks], o[ds]);
                }
        }
          asm volatile("s_waitcnt lgkmcnt(0)\n\ts_barrier" ::: "memory");
        }
    }
#undef FOX_WRITE
    lsum += __shfl_xor(lsum, 16); lsum += __shfl_xor(lsum, 32);
    const float inv = 1.0f / lsum;
    bf16_t* op = (bf16_t*)(p.ws + WS_FOXO) + (size_t)(b * SEQ + qw0 + r) * 512 + h * 64 + 4 * q;
#pragma unroll
    for (int ds = 0; ds < 4; ++ds) { u32x2 w; w.x = pk2(o[ds][0] * inv, o[ds][1] * inv); w.y = pk2(o[ds][2] * inv, o[ds][3] * inv); *(u32x2*)(op + 16 * ds) = w; }
}

__device__ __forceinline__ void gla_scan_item(const Params& p, int item, int tid) {
    const int bh = item >> 4, e = (item & 15) * 512 + tid, d = e & 63;
    const float* ub = (const float*)(p.ws + WS_GU) + (size_t)bh * 64 * 8192 + e;
    const float* dec = (const float*)(p.wsl + SL_GDEC) + (size_t)bh * 64 * 64 + d;
    bf16_t* sp = (bf16_t*)(p.ws + WS_GS) + (size_t)bh * 64 * 8192 + e;
    float st = 0.f;
#pragma unroll
    for (int n0 = 0; n0 < 64; n0 += 32) {
        float u[32], dc[32];
#pragma unroll
        for (int n = 0; n < 32; ++n) { u[n] = ub[(size_t)(n0 + n) * 8192]; dc[n] = dec[(n0 + n) * 64]; }
#pragma unroll
        for (int n = 0; n < 32; ++n) { sp[(size_t)(n0 + n) * 8192] = f2bf(st); st = dc[n] * st + u[n]; }
    }
}

__device__ __forceinline__ void lru_tilescan_item(const Params& p, int item, int tid) {
    const int gid = item * 512 + tid, b = gid >> 10, c = gid & 1023;
    const float* P = (const float*)(p.wsl + SL_AGP) + (size_t)b * 64 * 1024 + c;
    const float* H = (const float*)(p.wsl + SL_AGH) + (size_t)b * 64 * 1024 + c;
    float* hi = (float*)(p.wsl + SL_HIN) + (size_t)b * 64 * 1024 + c;
    float h = 0.f;
#pragma unroll
    for (int t0 = 0; t0 < 64; t0 += 32) {
        float a[32], u[32];
#pragma unroll
        for (int t = 0; t < 32; ++t) { a[t] = P[(t0 + t) * 1024]; u[t] = H[(t0 + t) * 1024]; }
#pragma unroll
        for (int t = 0; t < 32; ++t) { hi[(t0 + t) * 1024] = h; h = a[t] * h + u[t]; }
    }
}

__device__ __forceinline__ void fox_norm_rows4(const Params& p, int l, int tok0, int stride, int lane) {
    u32x4 w[4];
#pragma unroll
    for (int k = 0; k < 4; ++k) w[k] = *(const u32x4*)((const bf16_t*)(p.ws + WS_FOXO) + (size_t)(tok0 + k * stride) * 512 + lane * 8);
    const float* g = p.in[4] + l * 512 + lane * 8;
    const f32x4 g0 = *(const f32x4*)g, g1 = *(const f32x4*)(g + 4);
#pragma unroll
    for (int k = 0; k < 4; ++k) {
        float v[8];
#pragma unroll
        for (int i = 0; i < 4; ++i) { v[2 * i] = bf2f(w[k][i] & 0xffffu); v[2 * i + 1] = bf2f(w[k][i] >> 16); }
        float s = 0.f;
#pragma unroll
        for (int i = 0; i < 8; ++i) s += v[i] * v[i];
        const float rstd = rsqrtf(wave_sum(s) * (1.0f / 512.0f) + EPS);
        u32x4 ow; ow.x = pk2(v[0] * rstd * g0[0], v[1] * rstd * g0[1]); ow.y = pk2(v[2] * rstd * g0[2], v[3] * rstd * g0[3]);
        ow.z = pk2(v[4] * rstd * g1[0], v[5] * rstd * g1[1]); ow.w = pk2(v[6] * rstd * g1[2], v[7] * rstd * g1[3]);
        *(u32x4*)((bf16_t*)(p.ws + WS_MIX) + (size_t)(tok0 + k * stride) * 2048 + lane * 8) = ow;
    }
}

__device__ __forceinline__ void gla_out_witem(const Params& p, int l, int item, int lane) {
    const float* proj = (const float*)(p.ws + WS_PROJ);
    const int ch = item >> 1, tt = item & 1;
    const int bh = ch >> 6, n = ch & 63, b = bh >> 2, h = bh & 3;
    const int t0 = b * SEQ + n * 32;
    const int r = lane & 15, q = lane >> 4;
    const bf16_t* ab = (const bf16_t*)(p.wsl + SL_GA) + (size_t)ch * 1024;
    const bf16_t* vt = (const bf16_t*)(p.ws + WS_GVT) + (size_t)ch * 4096;
    const bf16_t* qt = (const bf16_t*)(p.wsl + SL_GQT) + (size_t)t0 * 256 + h * 64;
    const bf16_t* sp = (const bf16_t*)(p.ws + WS_GS) + (size_t)ch * 8192;
    const bf16x8 aa = *(const bf16x8*)(ab + (16 * tt + r) * 32 + 8 * q);
    const bf16x8 aq0 = *(const bf16x8*)(qt + (size_t)(16 * tt + r) * 256 + 8 * q), aq1 = *(const bf16x8*)(qt + (size_t)(16 * tt + r) * 256 + 32 + 8 * q);
    f32x4 acc[8];
#pragma unroll
    for (int w = 0; w < 8; ++w) {
        const int v = 16 * w + r;
        const bf16x8 bv = *(const bf16x8*)(vt + v * 32 + 8 * q);
        const bf16x8 bs0 = *(const bf16x8*)(sp + v * 64 + 8 * q), bs1 = *(const bf16x8*)(sp + v * 64 + 32 + 8 * q);
        f32x4 c = mfma16(aa, bv, (f32x4){0.f, 0.f, 0.f, 0.f});
        c = mfma16(aq0, bs0, c); c = mfma16(aq1, bs1, c);
        acc[w] = c;
    }
    float tot[4] = {0.f, 0.f, 0.f, 0.f};
#pragma unroll
    for (int w = 0; w < 8; ++w)
#pragma unroll
        for (int j = 0; j < 4; ++j) {
            float s = acc[w][j] * acc[w][j];
            s += __shfl_xor(s, 1); s += __shfl_xor(s, 2); s += __shfl_xor(s, 4); s += __shfl_xor(s, 8);
            tot[j] += s;
        }
#pragma unroll
    for (int j = 0; j < 4; ++j) {
        const int t = 16 * tt + 4 * q + j;
        const float rstd = rsqrtf(tot[j] * (1.0f / 128.0f) + EPS);
        const float* ggp = proj + (size_t)(t0 + t) * NPROJ + PC_GG + h * 128 + r;
        bf16_t* mp = (bf16_t*)(p.ws + WS_MIX) + (size_t)(t0 + t) * 2048 + 512 + h * 128 + r;
#pragma unroll
        for (int w = 0; w < 8; ++w) {
            const float gn = p.in[7][l * 128 + 16 * w + r];
            const float gg = ggp[16 * w];
            const float y = acc[w][j] * rstd * gn * (gg * sigmoidf(gg));
            mp[16 * w] = f2bf(y);
        }
    }
}

__device__ __forceinline__ float gelu_tanh(float x) {
    const float u = 0.7978845608028654f * (x + 0.044715f * x * x * x);
    const float t = 1.0f - 2.0f * __builtin_amdgcn_rcpf(1.0f + __expf(2.0f * u));
    return 0.5f * x * (1.0f + t);
}

__device__ __forceinline__ void lru_out_item(const Params& p, int l, int gt, lds_t lds, int tid, int wave, int lane) {
    const float* proj = (const float*)(p.ws + WS_PROJ);
    const int tok0 = gt * 32, c = 2 * tid;
    LAS float* part = (LAS float*)(lds);
    LAS float* rs = (LAS float*)(lds + 65536);
    const f32x2* la = (const f32x2*)((const float*)(p.ws + WS_LA) + (size_t)tok0 * 1024 + c);
    const f32x2* lu = (const f32x2*)((const float*)(p.ws + WS_LU) + (size_t)tok0 * 1024 + c);
    const float* lgp = proj + (size_t)tok0 * NPROJ + PC_LG + c;
    f32x2 h = *(const f32x2*)((const float*)(p.wsl + SL_HIN) + (size_t)gt * 1024 + c);
    f32x2 y[32];
    {
        f32x2 av[32], uv[32];
#pragma unroll
        for (int t = 0; t < 32; ++t) { av[t] = la[t * 512]; uv[t] = lu[t * 512]; }
#pragma unroll
        for (int t = 0; t < 32; ++t) { h = av[t] * h + uv[t]; y[t] = h; }
    }
    {
        f32x2 gv[32];
#pragma unroll
        for (int t = 0; t < 32; ++t) gv[t] = *(const f32x2*)(lgp + (size_t)t * NPROJ);
#pragma unroll
        for (int t = 0; t < 32; ++t) {
            y[t][0] = y[t][0] * gelu_tanh(gv[t][0]); y[t][1] = y[t][1] * gelu_tanh(gv[t][1]);
            part[t * 512 + tid] = y[t][0] * y[t][0] + y[t][1] * y[t][1];
        }
    }
    __syncthreads();
    {
        const int t = tid >> 4, k0 = tid & 15;
        float s = 0.f;
#pragma unroll 8
        for (int k = 0; k < 32; ++k) s += part[t * 512 + k0 + 16 * k];
        s += __shfl_xor(s, 1); s += __shfl_xor(s, 2); s += __shfl_xor(s, 4); s += __shfl_xor(s, 8);
        if (k0 == 0) rs[t] = rsqrtf(s * (1.0f / 1024.0f) + EPS);
    }
    __syncthreads();
    const f32x2 g = *(const f32x2*)(p.in[15] + l * 1024 + c);
    bf16_t* mix = (bf16_t*)(p.ws + WS_MIX) + (size_t)tok0 * 2048 + 1024 + c;
#pragma unroll
    for (int t = 0; t < 32; ++t) { const float rr = rs[t]; *(unsigned*)(mix + (size_t)t * 2048) = pk2(y[t][0] * rr * g[0], y[t][1] * rr * g[1]); }
    __syncthreads();
}

#define XB_TMO      128
#define XB_XCNT(j)  (256  + 64 * (j))
#define XB_XSUB(j)  (1280 + 64 * (j))
#define XB_XGEN(j)  (2304 + 64 * (j))
#define XB_TOP      3328
#define XB_TOPGEN   3392
#define XCD_BAR_WORDS 3456
#define XB_SPIN_CAP (1u << 18)

__device__ __forceinline__ unsigned xb_ld(unsigned* p)              { return __hip_atomic_load(p, __ATOMIC_RELAXED, __HIP_MEMORY_SCOPE_AGENT); }
__device__ __forceinline__ unsigned xb_add(unsigned* p, unsigned v) { return __hip_atomic_fetch_add(p, v, __ATOMIC_RELAXED, __HIP_MEMORY_SCOPE_AGENT); }
__device__ __forceinline__ unsigned xb_xcc_id() { return (unsigned)__builtin_amdgcn_s_getreg((3 << 11) | 20) & 0xFu; }
#define XB_SPIN(cond, bar) do { unsigned _sp = 0; while (cond) { __builtin_amdgcn_s_sleep(1); \
    if ((++_sp & 255u) == 0u) { if (xb_ld(&(bar)[XB_TMO])) break; if (_sp > XB_SPIN_CAP) { atomicAdd(&(bar)[XB_TMO], 1u); break; } } } } while (0)

struct XcdBarrier {
    unsigned* bar; unsigned x;
    volatile LAS unsigned* st;
};

__device__ __forceinline__ XcdBarrier xcd_barrier_post(unsigned* bar, volatile LAS unsigned* st) {
    XcdBarrier b; b.bar = bar; b.x = xb_xcc_id(); b.st = st;
    if (threadIdx.x == 0) (void)xb_add(&bar[XB_XCNT(b.x)], 1u);
    return b;
}
__device__ __forceinline__ void xcd_barrier_complete(unsigned* bar, unsigned x, unsigned& nloc, unsigned& nx) {
    const unsigned G = gridDim.x * gridDim.y * gridDim.z;
    unsigned sum, cnt, mine, sp = 0u;
    for (;;) {
        sum = 0u; cnt = 0u; mine = 0u;
#pragma unroll
        for (unsigned j = 0; j < 16; ++j) { const unsigned c = xb_ld(&bar[XB_XCNT(j)]); sum += c; cnt += (c > 0u) ? 1u : 0u; mine = (j == x) ? c : mine; }
        if (sum == G) break;
        __builtin_amdgcn_s_sleep(1);
        if ((++sp & 255u) == 0u) { if (xb_ld(&bar[XB_TMO])) break; if (sp > XB_SPIN_CAP) { atomicAdd(&bar[XB_TMO], 1u); break; } }
    }
    nloc = mine > 0u ? mine : 1u; nx = cnt > 0u ? cnt : 1u;
}

__device__ __forceinline__ void xcd_barrier(const XcdBarrier& b) {
    asm volatile("s_waitcnt vmcnt(0)" ::: "memory");
    __syncthreads();
    if (threadIdx.x == 0) {
        unsigned* bar = b.bar;
        __builtin_amdgcn_s_waitcnt(0);
        unsigned nloc = b.st[0], nx = b.st[1];
        if (nloc == 0u) { xcd_barrier_complete(bar, b.x, nloc, nx); b.st[0] = nloc; b.st[1] = nx; }
        const unsigned old = xb_add(&bar[XB_XSUB(b.x)], 1u);
        const unsigned gen = old / nloc;
        if (old + 1u == (gen + 1u) * nloc) {
            __builtin_amdgcn_fence(__ATOMIC_RELEASE, "agent");
            asm volatile("s_waitcnt vmcnt(0)" ::: "memory");
            const unsigned og = xb_add(&bar[XB_TOP], 1u);
            const unsigned tg = og / nx;
            if (og + 1u == (tg + 1u) * nx) xb_add(&bar[XB_TOPGEN], 1u);
            else XB_SPIN(xb_ld(&bar[XB_TOPGEN]) == tg, bar);
            __builtin_amdgcn_fence(__ATOMIC_ACQUIRE, "agent");
            xb_add(&bar[XB_XGEN(b.x)], 1u);
            asm volatile("s_waitcnt vmcnt(0)" ::: "memory");
        } else {
            XB_SPIN(xb_ld(&bar[XB_XGEN(b.x)]) == gen, bar);
            __builtin_amdgcn_fence(__ATOMIC_ACQUIRE, "agent");
            asm volatile("s_waitcnt vmcnt(0)" ::: "memory");
        }
    }
    __syncthreads();
}

__global__ void __launch_bounds__(512, 2) hymba_fwd(Params p0) {
    extern __shared__ __attribute__((aligned(16))) unsigned char lds_raw[];
    cg::grid_group grid = cg::this_grid();
    const int G = gridDim.x, bid = blockIdx.x, ngw = G * 8;
    volatile LAS unsigned* bst = (volatile LAS unsigned*)((lds_t)lds_raw + (LDS_BYTES - 64));
    if (threadIdx.x < 16) bst[threadIdx.x] = 0u;
    __syncthreads();
    const XcdBarrier bar = xcd_barrier_post((unsigned*)(p0.ws + WS_CTL), bst);
#define PHASE_BEGIN \
    int tid = threadIdx.x; asm volatile("" : "+v"(tid)); \
    const int lane = tid & 63, wave = __builtin_amdgcn_readfirstlane(tid >> 6); \
    unsigned lo_ = 0; asm volatile("" : "+s"(lo_)); lds_t lds = (lds_t)lds_raw + lo_; \
    Params p = p0; asm volatile("" : "+s"(p.ws)); p.wsl = p.ws + WS_SMALL + (size_t)lcur * SMALL_BYTES; \
    GAS unsigned char* ws = p.ws; const int gw = bid * 8 + wave; (void)gw; (void)lane; (void)lds; (void)ws;

#pragma clang loop unroll(disable)
    for (int l = 0; l < DEPTH; ++l) {
        const int lcur = l;
        if (l == 0) {
            {
                PHASE_BEGIN
                phase_wconv(p, 0, 1, gw, ngw, lane);
                for (int m = gw; m < NT; m += ngw) prep_row(p.in[0] + (size_t)m * DM, (bf16_t*)(ws + WS_HB) + (size_t)m * DM, (float*)(ws + WS_SS1), m, lane, p.in[1]);
            }
            if (p0.ws == nullptr) grid.sync();
            xcd_barrier(bar);
        }
        {
            PHASE_BEGIN
            pg8::Gemm g{(const bf16_t*)(ws + WS_HB), (const bf16_t*)(ws + WS_WIN), NT, NPROJ, DM}; pg8::StaticOrder S; S.init(NT, NPROJ, G, bid);
            gate_wt_prep(p, l, bid * 512 + tid);
            pg8::rstd_table((LAS float*)(lds + 131072), (const float*)(ws + WS_SS1 + (size_t)l * MiB), S, tid);
            pg8::EpiStoreF32 E{(float*)(ws + WS_PROJ), NPROJ, (const LAS float*)(lds + 131072), 0, (bf16_t*)(ws + WS_QKV)};
            pg8::gemm_phase<pg8::EpiStoreF32, pg8::StaticOrder, true, true>(lds, g, S, E, tid);
            { const int nfull = (NT / 256) * (NPROJ / 256) % G; if (nfull > 0 && bid >= nfull) phase_wconv(p, l, 2 | 4, (bid - nfull) * 8 + wave, (G - nfull) * 8, lane); else if (nfull == 0) phase_wconv(p, l, 2 | 4, gw, ngw, lane); }
        }
        xcd_barrier(bar);
        {
            PHASE_BEGIN
            if (gw < 32) fox_cumsum(p, l, gw, lane);
            {
                lds_t wl = lds + wave * 18432;
                if (G == 256) {
                    if (wave < 4) { gla_prep_witem(p, l, bid * 4 + wave, wl, lane); lru_prep_witem(p, l, bid * 16 + wave, wl, lane); }
                    else for (int k = 0; k < 3; ++k) lru_prep_witem(p, l, bid * 16 + 4 + (wave - 4) * 3 + k, wl, lane);
                } else
                for (int it = gw; it < 1024 + 4096; it += ngw) {
                    if (it < 1024) gla_prep_witem(p, l, it, wl, lane);
                    else lru_prep_witem(p, l, it - 1024, wl, lane);
                }
            }
        }
        xcd_barrier(bar);
        {
            PHASE_BEGIN
            for (int it = bid; it < 256; it += G) {
                const int bh = it >> 3, s = it & 7;
                fox_attn_unit(p, bh, 15 - s, lds, tid, wave, lane);
                fox_attn_unit(p, bh, s, lds, tid, wave, lane);
            }
            for (int it = bid; it < 256; it += G) gla_scan_item(p, it, tid);
            for (int it = G - 1 - bid; it < 8; it += G) lru_tilescan_item(p, it, tid);
        }
        xcd_barrier(bar);
        {
            PHASE_BEGIN
            for (int it = bid; it < 256; it += G) lru_out_item(p, l, it, lds, tid, wave, lane);
            for (int it = gw; it < 2048; it += ngw) gla_out_witem(p, l, it, lane);
            if (NT % (4 * ngw) == 0) { for (int tok = gw; tok < NT; tok += 4 * ngw) fox_norm_rows4(p, l, tok, ngw, lane); }
            else for (int tok = gw; tok < NT; tok += ngw) fox_norm_rows4(p, l, tok, 0, lane);
        }
        xcd_barrier(bar);
        {
            PHASE_BEGIN
            const float* xin = (l == 0) ? p.in[0] : (const float*)(ws + WS_XW);
            pg8::Gemm g{(const bf16_t*)(ws + WS_MIX), (const bf16_t*)(ws + WS_WOUT), NT, DM, DM}; pg8::StaticOrder S; S.init(NT, DM, G, bid);
            pg8::EpiResid E{xin, (float*)(ws + WS_XW), (bf16_t*)(ws + WS_HB), (float*)(ws + WS_SS2 + (size_t)l * MiB), p.in[17] + l * DM, DM};
            pg8::gemm_phase<pg8::EpiResid, pg8::StaticOrder, true, true>(lds, g, S, E, tid);
        }
        xcd_barrier(bar);
        {
            PHASE_BEGIN
            pg8::Gemm g{(const bf16_t*)(ws + WS_HB), (const bf16_t*)(ws + WS_WGU), NT, 2 * FFH, DM}; pg8::StaticOrder S; S.init(NT, 2 * FFH, G, bid);
            pg8::rstd_table((LAS float*)(lds + 131072), (const float*)(ws + WS_SS2 + (size_t)l * MiB), S, tid);
            pg8::EpiSwiglu E{(bf16_t*)(ws + WS_PROJ), FFH, (const LAS float*)(lds + 131072), 0};
            pg8::gemm_phase<pg8::EpiSwiglu, pg8::StaticOrder, true, true>(lds, g, S, E, tid);
            { const int nfull = (NT / 256) * (2 * FFH / 256) % G; const int msk = 8 | (l + 1 < DEPTH ? 1 : 0); const int ln = (l + 1 < DEPTH) ? l + 1 : l;
              if (nfull > 0 && bid >= nfull) { phase_wconv(p, l, 8, (bid - nfull) * 8 + wave, (G - nfull) * 8, lane); if (msk & 1) phase_wconv(p, ln, 1, (bid - nfull) * 8 + wave, (G - nfull) * 8, lane); }
              else if (nfull == 0) { phase_wconv(p, l, 8, gw, ngw, lane); if (msk & 1) phase_wconv(p, ln, 1, gw, ngw, lane); } }
        }
        xcd_barrier(bar);
        {
            PHASE_BEGIN
            pg8::Gemm g{(const bf16_t*)(ws + WS_PROJ), (const bf16_t*)(ws + WS_WDN), NT, DM, FFH}; pg8::StaticOrder S; S.init(NT, DM, G, bid);
            pg8::EpiResid E{(const float*)(ws + WS_XW), (float*)(ws + WS_XW), (l < DEPTH - 1) ? (bf16_t*)(ws + WS_HB) : (bf16_t*)nullptr, (float*)(ws + WS_SS1 + (size_t)(l + 1) * MiB), p.in[1] + (l < DEPTH - 1 ? l + 1 : 0) * DM, DM};
            pg8::gemm_phase<pg8::EpiResid, pg8::StaticOrder, true, true>(lds, g, S, E, tid);
        }
        xcd_barrier(bar);
    }
    {
        const int lcur = 0;
        PHASE_BEGIN
        for (int m = gw; m < NT; m += ngw) { const float sv = wave_sum(lane < 32 ? ((const float*)(ws + WS_SS1 + (size_t)DEPTH * MiB))[((size_t)(lane >> 2) * 8192 + m) * 4 + (lane & 3)] : 0.f);
            final_row((const float*)(ws + WS_XW) + (size_t)m * DM, p.in[21], p.out + (size_t)m * DM, sv, lane); }
    }
}

extern "C" void kernel_launch(void* const* d_in, const int* in_sizes, int n_in, void* d_out, int out_size, void* d_ws, size_t ws_size, hipStream_t stream) {
    static int grid_blocks = 0;
    if (grid_blocks == 0) {
        if (n_in != 22 || ws_size < WS_END) { fprintf(stderr, "kernel_launch: unexpected n_in %d / ws_size %zu\n", n_in, ws_size); grid_blocks = -1; return; }
        int dev = 0, cus = 0, per_cu = 0;
        hipGetDevice(&dev);
        hipDeviceGetAttribute(&cus, hipDeviceAttributeMultiprocessorCount, dev);
        hipFuncSetAttribute((const void*)hymba_fwd, hipFuncAttributeMaxDynamicSharedMemorySize, LDS_BYTES);
        hipOccupancyMaxActiveBlocksPerMultiprocessor(&per_cu, (const void*)hymba_fwd, 512, LDS_BYTES);
        if (per_cu < 1) { fprintf(stderr, "kernel_launch: occupancy query says %d blocks per CU\n", per_cu); per_cu = 1; }
        (void)hipGetLastError();
        grid_blocks = cus * 1;
    }
    if (grid_blocks < 0) return;
    Params p{};
    for (int i = 0; i < 22; ++i) p.in[i] = (const float*)d_in[i];
    p.out = (float*)d_out; p.ws = (GAS unsigned char*)d_ws;
    if (hipMemsetAsync((unsigned char*)d_ws + WS_CTL, 0, CTL_BYTES, stream) != hipSuccess) { fprintf(stderr, "kernel_launch: memset failed\n"); return; }
    void* args[] = {&p};
    hipError_t e = hipLaunchCooperativeKernel((const void*)hymba_fwd, dim3(grid_blocks), dim3(512), args, LDS_BYTES, stream);
    if (e != hipSuccess) fprintf(stderr, "cooperative launch failed: %s (grid %d)\n", hipGetErrorString(e), grid_blocks);
}
```

```cpp
#include <hip/hip_runtime.h>
#include <hip/hip_cooperative_groups.h>
#include <cstdio>
#include <cstdint>
namespace cg = cooperative_groups;
namespace pg8 {
#define PG8_LAS __attribute__((address_space(3)))
typedef unsigned short bf16_t;
typedef short bf16x8 __attribute__((ext_vector_type(8)));
typedef float f32x4 __attribute__((ext_vector_type(4)));
typedef unsigned u32x4 __attribute__((ext_vector_type(4)));
constexpr int BM = 256, BK = 64, HALF = 128, HTB = HALF * BK * 2  , STAGE_BYTES = 8 * HTB, NXCD = 8, WGM = 8;

__host__ __device__ __forceinline__ int lds_byte(int r, int c) { const int st = (r >> 4) * 2 + (c >> 5), rr = r & 15, cc = c & 31, ob = rr * 64 + cc * 2; return st * 1024 + (ob ^ (((ob >> 9) & 1) << 5)); }
__host__ __device__ __forceinline__ void stage_rc(int b, int& R, int& C) { const int st = b / 1024, sb = b % 1024, swz = sb ^ (((sb >> 9) & 1) << 5); R = (st >> 1) * 16 + swz / 64; C = (st & 1) * 32 + (swz % 64) / 2; }
__host__ __device__ __forceinline__ int perm32(int rho) { const int n = rho >> 4, i = rho & 15; return 8 * (i >> 2) + 4 * n + (i & 3); }

struct Unit { int pm, pn; };
struct Gemm { const bf16_t* A; const bf16_t* Bt; int M, N, K; };

struct StaticOrder {
    int nM, nN, nwg, G, c;
    __host__ __device__ void init(int M, int N, int G_, int c_) { nM = M / BM; nN = N / BM; nwg = nM * nN; G = G_; c = c_; }
    __host__ __device__ bool next(int i, Unit& u) const {
        const long L = (long)i * G + c; if (L >= nwg) return false;
        int wgid = (int)L; { const int q = nwg / NXCD, r = nwg % NXCD, xcd = wgid % NXCD, off = wgid / NXCD; wgid = (xcd < r ? xcd * (q + 1) : r * (q + 1) + (xcd - r) * q) + off; }
        const int nig = WGM * nN, gid = wgid / nig, fm = gid * WGM, gsz = (nM - fm) < WGM ? (nM - fm) : WGM;
        u.pm = fm + ((wgid % nig) % gsz); u.pn = (wgid % nig) / gsz; return true;
    }
    __device__ __forceinline__ void a_ready(const Unit&) const {}
    __device__ __forceinline__ void done(const Unit&) const {}
};

typedef unsigned u32x2 __attribute__((ext_vector_type(2)));
__device__ __forceinline__ unsigned cvt_pk_bf16(float lo, float hi) { unsigned r; asm("v_cvt_pk_bf16_f32 %0, %1, %2" : "=v"(r) : "v"(lo), "v"(hi)); return r; }
__device__ __forceinline__ float ssp_sum(const float* p, int row) {
    float s = 0.f;
#pragma unroll
    for (int i = 0; i < 8; ++i) { const f32x4 v = *(const f32x4*)(p + ((size_t)i * 8192 + row) * 4); s += (v[0] + v[1]) + (v[2] + v[3]); }
    return s;
}
template <class Sched> __device__ __forceinline__ void rstd_table(PG8_LAS float* rtab, const float* ss, const Sched& S, int tid) {
    float v[4]; bool ok[4];
#pragma unroll
    for (int k = 0; k < 4; ++k) { const int i = 2 * k + (tid >> 8); Unit u; ok[k] = S.next(i, u); v[k] = ok[k] ? ssp_sum(ss, u.pm * BM + (tid & 255)) : 0.f; }
#pragma unroll
    for (int k = 0; k < 4; ++k) if (ok[k]) rtab[(2 * k + (tid >> 8)) * 256 + (tid & 255)] = rsqrtf(v[k] * (1.0f / 2048.0f) + 1e-6f);
    __syncthreads();
}
#define PG8_ROW_RSTD(rs, ss, row0) float rs[2][4]; { const int lane_ = (int)(threadIdx.x & 63u); \
    const float v0_ = rsqrtf(ssp_sum((ss), (row0) + (lane_ >> 4) * 16) * (1.0f / 2048.0f) + 1e-6f), v1_ = rsqrtf(ssp_sum((ss), (row0) + HALF + (lane_ >> 4) * 16) * (1.0f / 2048.0f) + 1e-6f); \
    _Pragma("unroll") for (int m_ = 0; m_ < 4; ++m_) { rs[0][m_] = __shfl(v0_, (lane_ & 15) + 16 * m_); rs[1][m_] = __shfl(v1_, (lane_ & 15) + 16 * m_); } }
struct EpiStoreF32 {
    static constexpr bool PERM = false, AFTER_DRAIN = false;
    float* O; int ldc; const PG8_LAS float* rtab; mutable int ui;
    bf16_t* qkv;
    __device__ __forceinline__ void operator()(const f32x4 (&acc)[2][2][4][2], const Unit& u, int wr, int wc, int fr, int fq) const {
        const int row0 = u.pm * BM + wr * 64 + fr, col0 = u.pn * BM + wc * 32 + 4 * fq;
        const PG8_LAS float* rt = rtab + ui * 256 + wr * 64 + fr; ++ui;
#pragma unroll
        for (int ai = 0; ai < 2; ++ai)
#pragma unroll
            for (int m = 0; m < 4; ++m) { const int row = row0 + ai * HALF + m * 16; float* rowp = O + (size_t)row * ldc + col0;
                const float rs = rt[ai * HALF + m * 16];
                if (u.pn < 6 || (u.pn >> 1) == 4) {
                    const float sc = (u.pn < 2) ? 0.125f * 1.4426950408889634f : 1.0f;
                    bf16_t* bp = qkv + ((size_t)(u.pn < 6 ? (u.pn >> 1) : 3) * 8192 + row) * 512 + (u.pn & 1) * 256 + wc * 32 + 4 * fq;
#pragma unroll
                    for (int bj = 0; bj < 2; ++bj)
#pragma unroll
                        for (int n = 0; n < 2; ++n) { f32x4 v = acc[ai][bj][m][n] * rs; if (u.pn < 2) v = v * sc;
                            u32x2 w; w.x = cvt_pk_bf16(v[0], v[1]); w.y = cvt_pk_bf16(v[2], v[3]); *(u32x2*)(bp + bj * HALF + n * 16) = w; }
                } else {
#pragma unroll
                for (int bj = 0; bj < 2; ++bj)
#pragma unroll
                    for (int n = 0; n < 2; ++n) *(f32x4*)(rowp + bj * HALF + n * 16) = acc[ai][bj][m][n] * rs; } }
    }
};
struct EpiResid {
    static constexpr bool PERM = false, AFTER_DRAIN = false;
    const float* base; float* out; bf16_t* xb; float* ss; const float* gain; int ldc;
    __device__ __forceinline__ void operator()(const f32x4 (&acc)[2][2][4][2], const Unit& u, int wr, int wc, int fr, int fq) const {
        const int row0 = u.pm * BM + wr * 64 + fr, col0 = u.pn * BM + wc * 32 + 4 * fq;
        f32x4 gv[2][2];
#pragma unroll
        for (int bj = 0; bj < 2; ++bj)
#pragma unroll
            for (int n = 0; n < 2; ++n) gv[bj][n] = *(const f32x4*)(gain + col0 + bj * HALF + n * 16);
#pragma unroll
        for (int ai = 0; ai < 2; ++ai) {
            f32x4 pre[4][2][2];
#pragma unroll
            for (int m = 0; m < 4; ++m)
#pragma unroll
                for (int bj = 0; bj < 2; ++bj)
#pragma unroll
                    for (int n = 0; n < 2; ++n) pre[m][bj][n] = *(const f32x4*)(base + (size_t)(row0 + ai * HALF + m * 16) * ldc + col0 + bj * HALF + n * 16);
#pragma unroll
            for (int m = 0; m < 4; ++m) { const int row = row0 + ai * HALF + m * 16; const size_t off = (size_t)row * ldc + col0; float s = 0.f;
#pragma unroll
                for (int bj = 0; bj < 2; ++bj)
#pragma unroll
                    for (int n = 0; n < 2; ++n) { const f32x4 b = pre[m][bj][n]; const f32x4 v = b + acc[ai][bj][m][n];
                        *(f32x4*)(out + off + bj * HALF + n * 16) = v; s += (v[0] * v[0] + v[1] * v[1]) + (v[2] * v[2] + v[3] * v[3]);
                        if (xb) { const f32x4 y = v * gv[bj][n]; u32x2 w; w.x = cvt_pk_bf16(y[0], y[1]); w.y = cvt_pk_bf16(y[2], y[3]); *(u32x2*)(xb + off + bj * HALF + n * 16) = w; } }
                s += __shfl_xor(s, 16); s += __shfl_xor(s, 32);
                if (fq == 0) ss[((size_t)u.pn * 8192 + row) * 4 + wc] = s; }
            asm volatile("" ::: "memory");
        }
    }
};
struct EpiSwiglu {
    static constexpr bool PERM = true, AFTER_DRAIN = false;
    bf16_t* O; int ldc; const PG8_LAS float* rtab; mutable int ui;
    __device__ __forceinline__ void operator()(const f32x4 (&acc)[2][2][4][2], const Unit& u, int wr, int wc, int fr, int fq) const {
        const int row0 = u.pm * BM + wr * 64 + fr, col0 = u.pn * HALF + wc * 32 + 8 * fq;
        const PG8_LAS float* rt = rtab + ui * 256 + wr * 64 + fr; ++ui;
#pragma unroll
        for (int ai = 0; ai < 2; ++ai)
#pragma unroll
            for (int m = 0; m < 4; ++m) {
                const float rs = rt[ai * HALF + m * 16];
                float h[8];
#pragma unroll
                for (int n = 0; n < 2; ++n)
#pragma unroll
                    for (int e = 0; e < 4; ++e) { const float g = acc[ai][0][m][n][e] * rs, up = acc[ai][1][m][n][e] * rs; h[n * 4 + e] = g * __builtin_amdgcn_rcpf(1.0f + __builtin_amdgcn_exp2f(g * -1.4426950408889634f)) * up; }
                u32x4 w; w.x = cvt_pk_bf16(h[0], h[1]); w.y = cvt_pk_bf16(h[2], h[3]); w.z = cvt_pk_bf16(h[4], h[5]); w.w = cvt_pk_bf16(h[6], h[7]);
                *(u32x4*)(O + (size_t)(row0 + ai * HALF + m * 16) * ldc + col0) = w; }
    }
};
template <class Epi, class Sched, bool ALIGN_EPI = false, bool SP2 = false>
__device__ __forceinline__ void gemm_phase(PG8_LAS unsigned char* lds, const Gemm g, const Sched& S, const Epi& E, const int tid) {
    const int wid = __builtin_amdgcn_readfirstlane(tid >> 6), lane = tid & 63, wr = wid >> 2, wc = wid & 3, fr = lane & 15, fq = lane >> 4;
    const int K = g.K, nt = K / BK;
    unsigned voffA[2], voffB[2];
#pragma unroll
    for (int i = 0; i < 2; ++i) { int R, C; stage_rc(tid * 16 + i * 8192, R, C); const int Rb = Epi::PERM ? ((R & ~31) + perm32(R & 31)) : R;
        voffA[i] = (unsigned)(R * K + C) * 2u; voffB[i] = (unsigned)(Rb * K + C) * 2u; }
    const size_t kstep = (size_t)(BK * 2);
    const size_t hstep = (size_t)HALF * K * 2;
    const size_t tstep = 2 * hstep;
    const unsigned ldsw = (unsigned)wid * 1024u;
    const int aoff = lds_byte(wr * 64 + fr, fq * 8), boff = lds_byte(wc * 32 + fr, fq * 8);
#define PG8_SA(b, h) (((b) * 2 + (h)) * HTB)
#define PG8_SB(b, h) ((4 + (b) * 2 + (h)) * HTB)
#define PG8_STAGE(bufoff, gbase, voff) do { _Pragma("unroll") for (int _i = 0; _i < 2; ++_i) \
        __builtin_amdgcn_global_load_lds((const unsigned*)((const char*)(gbase) + (voff)[_i]), (PG8_LAS unsigned*)(lds + (bufoff) + ldsw + _i * 8192), 16, 0, 0); } while (0)
#define PG8_LDA(dst, b, h) do { _Pragma("unroll") for (int m = 0; m < 4; ++m) _Pragma("unroll") for (int k = 0; k < 2; ++k) dst[m][k] = *(const PG8_LAS bf16x8*)(lds + PG8_SA(b, h) + aoff + m * 2048 + k * 1024); } while (0)
#define PG8_LDB(dst, b, h) do { _Pragma("unroll") for (int n = 0; n < 2; ++n) _Pragma("unroll") for (int k = 0; k < 2; ++k) dst[n][k] = *(const PG8_LAS bf16x8*)(lds + PG8_SB(b, h) + boff + n * 2048 + k * 1024); } while (0)
#define PG8_MMA(ai, bj, At, Bt) do { __builtin_amdgcn_s_setprio(1); _Pragma("unroll") for (int m = 0; m < 4; ++m) _Pragma("unroll") for (int n = 0; n < 2; ++n) _Pragma("unroll") for (int k = 0; k < 2; ++k) \
        acc[ai][bj][m][n] = __builtin_amdgcn_mfma_f32_16x16x32_bf16(Bt[n][k], At[m][k], acc[ai][bj][m][n], 0, 0, 0); __builtin_amdgcn_s_setprio(0); } while (0)
#define PG8_WAIT_V(n) asm volatile("s_waitcnt vmcnt(" #n ")" ::: "memory")
#define PG8_WAIT_L(n) asm volatile("s_waitcnt lgkmcnt(" #n ")" ::: "memory")
#define PG8_BAR __builtin_amdgcn_s_barrier()
#define PG8_SCHED __builtin_amdgcn_sched_barrier(0)
    Unit cur, nxt; int ui = 0;
    if (!S.next(0, cur)) return;
    f32x4 acc[2][2][4][2];
#pragma unroll
    for (int a = 0; a < 2; ++a)
#pragma unroll
        for (int b = 0; b < 2; ++b)
#pragma unroll
            for (int m = 0; m < 4; ++m)
#pragma unroll
                for (int n = 0; n < 2; ++n) acc[a][b][m][n] = (f32x4){0.f, 0.f, 0.f, 0.f};
    bf16x8 At[4][2], B0[2][2], B1[2][2];
    const char* cA = (const char*)g.A + (size_t)cur.pm * tstep; const char* cB = (const char*)g.Bt + (size_t)cur.pn * tstep;
    S.a_ready(cur);
    if constexpr (SP2) {
        PG8_STAGE(PG8_SB(0, 0), cB, voffB); PG8_STAGE(PG8_SB(0, 1), cB + hstep, voffB); PG8_STAGE(PG8_SA(0, 0), cA, voffA); PG8_STAGE(PG8_SA(0, 1), cA + hstep, voffA);
        if (wr == 1) PG8_BAR;
        PG8_WAIT_V(2); PG8_BAR;
        PG8_STAGE(PG8_SB(1, 0), cB + kstep, voffB); PG8_STAGE(PG8_SA(1, 0), cA + kstep, voffA); PG8_STAGE(PG8_SB(1, 1), cB + hstep + kstep, voffB);
        PG8_WAIT_V(6); PG8_BAR;
    } else {
        PG8_STAGE(PG8_SB(0, 0), cB, voffB); PG8_STAGE(PG8_SA(0, 0), cA, voffA); PG8_STAGE(PG8_SB(0, 1), cB + hstep, voffB); PG8_STAGE(PG8_SA(0, 1), cA + hstep, voffA);
        if (wr == 1) PG8_BAR;
        PG8_WAIT_V(4); PG8_BAR;
        PG8_STAGE(PG8_SB(1, 0), cB + kstep, voffB); PG8_STAGE(PG8_SA(1, 0), cA + kstep, voffA); PG8_STAGE(PG8_SB(1, 1), cB + hstep + kstep, voffB);
        PG8_WAIT_V(6); PG8_BAR;
    }
    for (;;) {
        const bool has_next = S.next(ui + 1, nxt);
        const char* nA = has_next ? (const char*)g.A + (size_t)nxt.pm * tstep : cA; const char* nB = has_next ? (const char*)g.Bt + (size_t)nxt.pn * tstep : cB;
        for (int t = 0; t < nt; t += 2) {
            const bool last = (t == nt - 2);
            const char* a1 = cA + (size_t)(t + 1) * kstep;
            const char* a2 = last ? nA : cA + (size_t)(t + 2) * kstep; const char* b2 = last ? nB : cB + (size_t)(t + 2) * kstep;
            const char* a3 = a2 + kstep; const char* b3 = b2 + kstep;
            if (last && has_next) S.a_ready(nxt);
            if constexpr (SP2) {
            PG8_LDB(B0, 0, 0); PG8_LDB(B1, 0, 1); PG8_SCHED; PG8_LDA(At, 0, 0); PG8_STAGE(PG8_SA(1, 1), a1 + hstep, voffA);
            PG8_WAIT_V(8); PG8_WAIT_L(0); PG8_BAR; PG8_MMA(0, 0, At, B0); PG8_MMA(0, 1, At, B1); PG8_BAR; PG8_SCHED;
            PG8_LDA(At, 0, 1); PG8_STAGE(PG8_SB(0, 0), b2, voffB); PG8_STAGE(PG8_SB(0, 1), b2 + hstep, voffB); PG8_STAGE(PG8_SA(0, 0), a2, voffA);
            PG8_WAIT_V(8); PG8_WAIT_L(0); PG8_BAR; PG8_MMA(1, 0, At, B0); PG8_MMA(1, 1, At, B1); PG8_BAR; PG8_SCHED;
            PG8_LDB(B0, 1, 0); PG8_LDB(B1, 1, 1); PG8_SCHED; PG8_LDA(At, 1, 0); PG8_STAGE(PG8_SA(0, 1), a2 + hstep, voffA);
            PG8_WAIT_V(8); PG8_WAIT_L(0); PG8_BAR; PG8_MMA(0, 0, At, B0); PG8_MMA(0, 1, At, B1); PG8_BAR; PG8_SCHED;
            PG8_LDA(At, 1, 1); PG8_STAGE(PG8_SB(1, 0), b3, voffB); PG8_STAGE(PG8_SB(1, 1), b3 + hstep, voffB); PG8_STAGE(PG8_SA(1, 0), a3, voffA);
            PG8_WAIT_V(8); PG8_WAIT_L(0); PG8_BAR; PG8_MMA(1, 0, At, B0); PG8_MMA(1, 1, At, B1); PG8_BAR; PG8_SCHED;
            } else {
            PG8_LDB(B0, 0, 0); PG8_SCHED; PG8_LDA(At, 0, 0); PG8_STAGE(PG8_SA(1, 1), a1 + hstep, voffA);
            PG8_WAIT_L(8); PG8_BAR; PG8_WAIT_L(0); PG8_MMA(0, 0, At, B0); PG8_BAR; PG8_SCHED;
            PG8_LDB(B1, 0, 1); PG8_STAGE(PG8_SB(0, 0), b2, voffB);
            PG8_BAR; PG8_WAIT_L(0); PG8_MMA(0, 1, At, B1); PG8_BAR;
            PG8_LDA(At, 0, 1); PG8_STAGE(PG8_SA(0, 0), a2, voffA);
            PG8_BAR; PG8_WAIT_L(0); PG8_MMA(1, 0, At, B0); PG8_BAR; PG8_SCHED;
            PG8_STAGE(PG8_SB(0, 1), b2 + hstep, voffB);
            PG8_WAIT_V(6); PG8_BAR; PG8_MMA(1, 1, At, B1); PG8_BAR;
            PG8_LDB(B0, 1, 0); PG8_SCHED; PG8_LDA(At, 1, 0); PG8_STAGE(PG8_SA(0, 1), a2 + hstep, voffA);
            PG8_WAIT_L(8); PG8_BAR; PG8_WAIT_L(0); PG8_MMA(0, 0, At, B0); PG8_BAR; PG8_SCHED;
            PG8_LDB(B1, 1, 1); PG8_STAGE(PG8_SB(1, 0), b3, voffB);
            PG8_BAR; PG8_WAIT_L(0); PG8_MMA(0, 1, At, B1); PG8_BAR;
            PG8_LDA(At, 1, 1); PG8_STAGE(PG8_SA(1, 0), a3, voffA);
            PG8_BAR; PG8_WAIT_L(0); PG8_MMA(1, 0, At, B0); PG8_BAR; PG8_SCHED;
            PG8_STAGE(PG8_SB(1, 1), b3 + hstep, voffB);
            PG8_WAIT_V(6); PG8_BAR; PG8_MMA(1, 1, At, B1); PG8_BAR;
            }
        }
        if constexpr (ALIGN_EPI) { if (wr == 0) PG8_BAR; }
        if constexpr (!Epi::AFTER_DRAIN) { E(acc, cur, wr, wc, fr, fq); S.done(cur); }
        if (!has_next) break;
#pragma unroll
        for (int a = 0; a < 2; ++a)
#pragma unroll
            for (int b = 0; b < 2; ++b)
#pragma unroll
                for (int m = 0; m < 4; ++m)
#pragma unroll
                    for (int n = 0; n < 2; ++n) acc[a][b][m][n] = (f32x4){0.f, 0.f, 0.f, 0.f};
        cur = nxt; cA = nA; cB = nB; ++ui;
        if constexpr (ALIGN_EPI) { if (wr == 1) PG8_BAR; }
    }
    PG8_WAIT_V(0);
    if constexpr (!ALIGN_EPI) { if (wr == 0) PG8_BAR; }
    PG8_BAR;
    if constexpr (Epi::AFTER_DRAIN) { E.fused(acc, cur, wr, wc, fr, fq, lds, wid, lane); S.done(cur); }
#undef PG8_SA
#undef PG8_SB
#undef PG8_STAGE
#undef PG8_LDA
#undef PG8_LDB
#undef PG8_MMA
#undef PG8_WAIT_V
#undef PG8_WAIT_L
#undef PG8_BAR
#undef PG8_SCHED
}
}

#define LAS __attribute__((address_space(3)))
typedef unsigned short bf16_t;
typedef short bf16x8 __attribute__((ext_vector_type(8)));
typedef short s16x4 __attribute__((ext_vector_type(4)));
typedef float f32x4 __attribute__((ext_vector_type(4)));
typedef float f32x2 __attribute__((ext_vector_type(2)));
typedef unsigned u32x4 __attribute__((ext_vector_type(4)));
typedef unsigned u32x2 __attribute__((ext_vector_type(2)));
typedef LAS unsigned char* lds_t;

constexpr int NT = 8192, DM = 2048, SEQ = 2048, NB = 4, DEPTH = 4;
constexpr int INW = 5144, NPROJ = 5376, FFH = 5632;
constexpr int PC_FQ = 0, PC_FK = 512, PC_FV = 1024, PC_GQ = 1536, PC_GK = 1792, PC_GV = 2048, PC_GG = 2560, PC_LG = 3072, PC_LX = 4096, PC_FF = 5120, PC_GR = 5128;
constexpr float EPS = 1e-6f;
constexpr float LOG2E = 1.4426950408889634f;
constexpr int LDS_BYTES = 147456;

constexpr size_t MiB = 1u << 20;
constexpr size_t WS_WIN = 0, WS_WOUT = 21 * MiB, WS_WGU = 29 * MiB, WS_WDN = 73 * MiB;
constexpr size_t WS_XW = 96 * MiB;
constexpr size_t WS_HB = 160 * MiB;
constexpr size_t WS_PROJ = 192 * MiB;
constexpr size_t WS_MIX = 360 * MiB;
constexpr size_t WS_FOXO = 392 * MiB;
constexpr size_t WS_CBUF = 400 * MiB;
constexpr size_t WS_GQT = 401 * MiB;
constexpr size_t WS_GA = 405 * MiB;
constexpr size_t WS_GVT = 407 * MiB;
constexpr size_t WS_GU = 415 * MiB;
constexpr size_t WS_GS = 447 * MiB;
constexpr size_t WS_GDEC = 463 * MiB;
constexpr size_t WS_LA = 464 * MiB;
constexpr size_t WS_LU = 496 * MiB;
constexpr size_t WS_AGP = 528 * MiB, WS_AGH = 529 * MiB, WS_HIN = 530 * MiB;
constexpr size_t WS_SS1 = 532 * MiB, WS_SS2 = 537 * MiB;
constexpr size_t WS_CTL = 531 * MiB, CTL_BYTES = 16384;
constexpr size_t WS_GWT = 541 * MiB;
constexpr size_t WS_SMALL = 542 * MiB, SMALL_BYTES = 10 * MiB;
constexpr size_t SL_CBUF = 0, SL_GDEC = 256 * 1024, SL_GWT = 512 * 1024, SL_AGP = 1 * MiB, SL_AGH = 2 * MiB, SL_HIN = 3 * MiB, SL_GQT = 4 * MiB, SL_GA = 8 * MiB;
constexpr size_t WS_QKV = 582 * MiB;
constexpr size_t WS_END = 614 * MiB;

#define GAS __attribute__((address_space(1)))
struct Params { const float* in[22]; float* out; GAS unsigned char* ws; GAS unsigned char* wsl; };

__device__ __forceinline__ unsigned pk2(float lo, float hi) { unsigned r; asm("v_cvt_pk_bf16_f32 %0, %1, %2" : "=v"(r) : "v"(lo), "v"(hi)); return r; }
__device__ __forceinline__ bf16_t f2bf(float f) { return (bf16_t)(pk2(f, 0.f) & 0xffffu); }
__device__ __forceinline__ float bf2f(unsigned b) { return __uint_as_float(b << 16); }
__device__ __forceinline__ float logsig(float x) { return fminf(x, 0.f) - __logf(1.0f + __expf(-fabsf(x))); }
__device__ __forceinline__ float sigmoidf(float x) { return __builtin_amdgcn_rcpf(1.0f + __expf(-x)); }
__device__ __forceinline__ float neg_expm1_small(float y) {
    const float pl = y * (1.0f + y * (0.5f + y * (0.16666667f + y * (0.041666668f + y * (0.0083333338f + y * (0.0013888889f + y * 0.00019841270f))))));
    return (y > -0.25f) ? -pl : (1.0f - __expf(y));
}
__device__ __forceinline__ f32x4 mfma16(bf16x8 a, bf16x8 b, f32x4 c) { return __builtin_amdgcn_mfma_f32_16x16x32_bf16(a, b, c, 0, 0, 0); }
__device__ __forceinline__ float wave_sum(float v) {
#pragma unroll
    for (int o = 1; o < 64; o <<= 1) v += __shfl_xor(v, o);
    return v;
}
__device__ __forceinline__ bf16x8 pack8(f32x4 a, f32x4 b) {
    u32x4 w; w.x = pk2(a[0], a[1]); w.y = pk2(a[2], a[3]); w.z = pk2(b[0], b[1]); w.w = pk2(b[2], b[3]);
    return __builtin_bit_cast(bf16x8, w);
}

template <int MODE>
__device__ __forceinline__ void wconv_item(const float* W0, const float* W1, int Nsrc, int K, bf16_t* Bt, int NG, int item, int lane, const float* gain) {
    const int kb = item / NG, nb = item - kb * NG;
    const int kg = lane >> 4, ng = lane & 15;
    const int np = nb * 64 + ng * 4, k = kb * 32 + kg * 8;
    const float* src = W0; int c = np;
    if (MODE == 0) { c = np < 1536 ? np : np < 3072 ? np + 8 : np < 5120 ? np + 24 : np < 5128 ? np - 5120 + 1536 : np < 5144 ? np - 5128 + 3080 : -1; }
    if (MODE == 2) { const int pn = np >> 8, j = np & 255; src = j < 128 ? W0 : W1; c = pn * 128 + (j & 127); }
    f32x4 v[8];
#pragma unroll
    for (int i = 0; i < 8; ++i) v[i] = (c >= 0) ? *(const f32x4*)(src + (size_t)(k + i) * Nsrc + c) : (f32x4){0.f, 0.f, 0.f, 0.f};
    if (gain) { const f32x4 g0 = *(const f32x4*)(gain + k), g1 = *(const f32x4*)(gain + k + 4);
#pragma unroll
        for (int i = 0; i < 4; ++i) { v[i] = v[i] * g0[i]; v[4 + i] = v[4 + i] * g1[i]; } }
#pragma unroll
    for (int j = 0; j < 4; ++j) {
        u32x4 o; o.x = pk2(v[0][j], v[1][j]); o.y = pk2(v[2][j], v[3][j]); o.z = pk2(v[4][j], v[5][j]); o.w = pk2(v[6][j], v[7][j]);
        *(u32x4*)(Bt + (size_t)(np + j) * K + k) = o;
    }
}

__device__ __forceinline__ void prep_row(const float* xrow, bf16_t* orow, float* ss, int row, int lane, const float* g) {
    const f32x4* xr = (const f32x4*)xrow + lane; const f32x4* gr = (const f32x4*)g + lane;
    f32x4 v[8]; float s = 0.f;
#pragma unroll
    for (int j = 0; j < 8; ++j) { v[j] = xr[64 * j]; s += (v[j][0] * v[j][0] + v[j][1] * v[j][1]) + (v[j][2] * v[j][2] + v[j][3] * v[j][3]); }
    s = wave_sum(s);
    if (lane < 32) ss[((size_t)(lane >> 2) * 8192 + row) * 4 + (lane & 3)] = (lane == 0) ? s : 0.f;
#pragma unroll
    for (int j = 0; j < 8; ++j) { const f32x4 y = v[j] * gr[64 * j]; u32x2 w; w.x = pk2(y[0], y[1]); w.y = pk2(y[2], y[3]); ((u32x2*)orow)[lane + 64 * j] = w; }
}
__device__ __forceinline__ void final_row(const float* xrow, const float* g, float* orow, float ss, int lane) {
    const f32x4* xr = (const f32x4*)xrow + lane; const f32x4* gr = (const f32x4*)g + lane;
    const float rstd = rsqrtf(ss * (1.0f / 2048.0f) + EPS);
#pragma unroll
    for (int j = 0; j < 8; ++j) ((f32x4*)orow)[lane + 64 * j] = xr[64 * j] * rstd * gr[64 * j];
}

__device__ __forceinline__ void phase_wconv(const Params& p, int l, int mask, int w, int nw, int lane) {
    GAS unsigned char* ws = p.ws;
    constexpr int I_IN = 64 * 84, I_OUT = 64 * 32, I_GU = 64 * 176, I_DN = 176 * 32;
    const float* w_in = p.in[2] + (size_t)l * DM * INW;
    const float* w_out = p.in[16] + (size_t)l * DM * DM;
    const float* w_gate = p.in[18] + (size_t)l * DM * FFH;
    const float* w_up = p.in[19] + (size_t)l * DM * FFH;
    const float* w_down = p.in[20] + (size_t)l * FFH * DM;
    if (mask & 1) for (int it = w; it < I_IN; it += nw) wconv_item<0>(w_in, w_in, INW, DM, (bf16_t*)(ws + WS_WIN), 84, it, lane, nullptr);
    if (mask & 2) for (int it = w; it < I_OUT; it += nw) wconv_item<1>(w_out, w_out, DM, DM, (bf16_t*)(ws + WS_WOUT), 32, it, lane, nullptr);
    if (mask & 4) for (int it = w; it < I_GU; it += nw) wconv_item<2>(w_gate, w_up, FFH, DM, (bf16_t*)(ws + WS_WGU), 176, it, lane, nullptr);
    if (mask & 8) for (int it = w; it < I_DN; it += nw) wconv_item<1>(w_down, w_down, DM, FFH, (bf16_t*)(ws + WS_WDN), 32, it, lane, nullptr);
}

__device__ __forceinline__ void fox_cumsum(const Params& p, int l, int seq, int lane) {
    const float* proj = (const float*)(p.ws + WS_PROJ);
    float* cbuf = (float*)(p.wsl + SL_CBUF);
    const int b = seq >> 3, h = seq & 7;
    const float bias = p.in[3][l * 8 + h];
    const float* src = proj + (size_t)(b * SEQ + lane * 32) * NPROJ + PC_FF + h;
    float ls[32];
#pragma unroll
    for (int i = 0; i < 32; ++i) ls[i] = src[(size_t)i * NPROJ];
    float s = 0.f;
#pragma unroll
    for (int i = 0; i < 32; ++i) { ls[i] = logsig(ls[i] + bias); s += ls[i]; }
    float incl = s;
#pragma unroll
    for (int o = 1; o < 64; o <<= 1) { const float t = __shfl_up(incl, o); if (lane >= o) incl += t; }
    float run = incl - s;
    float* dst = cbuf + seq * SEQ + lane * 32;
#pragma unroll
    for (int i = 0; i < 32; ++i) { run += ls[i]; dst[i] = run * LOG2E; }
}

__device__ __forceinline__ void gate_wt_prep(const Params& p, int l, int gid) {
    if (gid < 2 * 16 * 64 * 64) {
        const int d = gid & 63, e = (gid >> 6) & 63, n = (gid >> 12) & 15, g = gid >> 16;
        const float* w = (g == 0 ? p.in[10] : p.in[12]) + ((size_t)(l * 16 + n) * 64 + d) * 64 + e;
        ((bf16_t*)(p.wsl + SL_GWT))[gid] = f2bf(*w);
    }
}

__device__ __forceinline__ void gla_prep_witem(const Params& p, int l, int ch, lds_t wl_in, int lane_in) {
    int lane = lane_in; asm volatile("" : "+v"(lane));
    unsigned wlo_ = 0; asm volatile("" : "+s"(wlo_)); lds_t wl = wl_in + wlo_;
    const float* proj = (const float*)(p.ws + WS_PROJ);
    const int bh = ch >> 6, n = ch & 63, b = bh >> 2, h = bh & 3;
    const int t0 = b * SEQ + n * 32;
    LAS bf16_t* Qs = (LAS bf16_t*)(wl);
    LAS bf16_t* Ks = (LAS bf16_t*)(wl + 4608);
    LAS bf16_t* KstT = (LAS bf16_t*)(wl);
    LAS bf16_t* VT = (LAS bf16_t*)(wl + 5120);
    const int r = lane & 15, q = lane >> 4;
    float bcum[32];
    {
        const float* w2 = p.in[5] + (size_t)l * 16 * 256 + h * 64 + lane;
        const float gb = p.in[6][l * 256 + h * 64 + lane];
        float w2r[16];
#pragma unroll
        for (int i = 0; i < 16; ++i) w2r[i] = w2[i * 256];
        LAS float* grs = (LAS float*)(wl);
        { const float* gsrc = proj + (size_t)(t0 + (lane >> 1)) * NPROJ + PC_GR + (lane & 1) * 8;
          const f32x4 g0 = *(const f32x4*)gsrc, g1 = *(const f32x4*)(gsrc + 4);
          *(LAS f32x4*)(grs + lane * 8) = g0; *(LAS f32x4*)(grs + lane * 8 + 4) = g1; }
        float run = 0.f;
#pragma unroll
        for (int t = 0; t < 32; ++t) {
            f32x4 gr4[4];
#pragma unroll
            for (int i = 0; i < 4; ++i) gr4[i] = *(LAS f32x4*)(grs + t * 16 + 4 * i);
            float z = gb;
#pragma unroll
            for (int i = 0; i < 16; ++i) z += gr4[i >> 2][i & 3] * w2r[i];
            run += logsig(z) * (1.0f / 16.0f);
            bcum[t] = run;
        }
        asm volatile("" ::: "memory");
    }
    const float bl = bcum[31];
    unsigned kstp[16];
    {
        bf16_t* qtg = (bf16_t*)(p.wsl + SL_GQT) + (size_t)t0 * 256 + h * 64 + lane;
        float ksprev = 0.f;
        float gqv[32], gkv[32];
#pragma unroll
        for (int t = 0; t < 32; ++t) { const float* prow = proj + (size_t)(t0 + t) * NPROJ; gqv[t] = prow[PC_GQ + h * 64 + lane]; gkv[t] = prow[PC_GK + h * 64 + lane]; }
#pragma unroll
        for (int t = 0; t < 32; ++t) {
            const float gq = gqv[t], gk = gkv[t];
            const float bv = bcum[t];
            const float qt = gq * 0.125f * __expf(bv), kt = gk * __expf(-bv), ks = gk * __expf(bl - bv);
            const bf16_t qb16 = f2bf(qt);
            Qs[t * 72 + lane] = qb16; Ks[t * 72 + lane] = f2bf(kt);
            qtg[(size_t)t * 256] = qb16;
            if (t & 1) kstp[t >> 1] = pk2(ksprev, ks); else ksprev = ks;
        }
        ((float*)(p.wsl + SL_GDEC))[ch * 64 + lane] = __expf(bl);
    }
    {
        bf16_t* ab = (bf16_t*)(p.wsl + SL_GA) + (size_t)ch * 1024;
#pragma unroll
        for (int tt = 0; tt < 2; ++tt)
#pragma unroll
            for (int st = 0; st < 2; ++st) {
                f32x4 acc = {0.f, 0.f, 0.f, 0.f};
#pragma unroll
                for (int ks = 0; ks < 2; ++ks) {
                    const bf16x8 a = *(LAS bf16x8*)(Qs + (16 * tt + r) * 72 + 32 * ks + 8 * q);
                    const bf16x8 bb = *(LAS bf16x8*)(Ks + (16 * st + r) * 72 + 32 * ks + 8 * q);
                    acc = mfma16(a, bb, acc);
                }
#pragma unroll
                for (int j = 0; j < 4; ++j) { const int t = 16 * tt + 4 * q + j, s = 16 * st + r; ab[t * 32 + s] = f2bf(s <= t ? acc[j] : 0.f); }
            }
    }
#pragma unroll
    for (int i = 0; i < 4; ++i) { u32x4 w; w.x = kstp[4 * i]; w.y = kstp[4 * i + 1]; w.z = kstp[4 * i + 2]; w.w = kstp[4 * i + 3]; *(LAS u32x4*)(KstT + lane * 40 + 8 * i) = w; }
#pragma unroll
    for (int vv = 0; vv < 2; ++vv) {
        const int v = lane + 64 * vv;
        const bf16_t* vp = (const bf16_t*)(p.ws + WS_QKV) + ((size_t)3 * NT + t0) * 512 + h * 128 + v;
        unsigned vw[16];
#pragma unroll
        for (int t = 0; t < 32; t += 2) vw[t >> 1] = (unsigned)vp[(size_t)t * 512] | ((unsigned)vp[(size_t)(t + 1) * 512] << 16);
        bf16_t* vg = (bf16_t*)(p.ws + WS_GVT) + (size_t)ch * 4096 + v * 32;
#pragma unroll
        for (int i = 0; i < 4; ++i) { u32x4 w; w.x = vw[4 * i]; w.y = vw[4 * i + 1]; w.z = vw[4 * i + 2]; w.w = vw[4 * i + 3]; *(LAS u32x4*)(VT + v * 40 + 8 * i) = w; *(u32x4*)(vg + 8 * i) = w; }
    }
    {
        float* ub = (float*)(p.ws + WS_GU) + (size_t)ch * 8192;
        bf16x8 kb[4];
#pragma unroll
        for (int dt = 0; dt < 4; ++dt) kb[dt] = *(LAS bf16x8*)(KstT + (16 * dt + r) * 40 + 8 * q);
#pragma unroll
        for (int w = 0; w < 8; ++w) {
            const bf16x8 a = *(LAS bf16x8*)(VT + (16 * w + r) * 40 + 8 * q);
#pragma unroll
            for (int dt = 0; dt < 4; ++dt) {
                const f32x4 acc = mfma16(a, kb[dt], (f32x4){0.f, 0.f, 0.f, 0.f});
#pragma unroll
                for (int j = 0; j < 4; ++j) ub[(16 * w + 4 * q + j) * 64 + 16 * dt + r] = acc[j];
            }
        }
    }
}

__device__ __forceinline__ void lru_prep_witem(const Params& p, int l, int item, lds_t wl_in, int lane_in) {
    int lane = lane_in; asm volatile("" : "+v"(lane));
    unsigned wlo_ = 0; asm volatile("" : "+s"(wlo_)); lds_t wl = wl_in + wlo_;
    const float* proj = (const float*)(p.ws + WS_PROJ);
    const int gt = item >> 4, n = item & 15, tok0 = gt * 32, b = tok0 >> 11, p0 = tok0 & 2047, c0 = n * 64;
    LAS bf16_t* Xs = (LAS bf16_t*)(wl);
    LAS float* Xf = (LAS float*)(wl + 4608);
    const int r = lane & 15, q = lane >> 4;
    {
        const int c = c0 + lane;
        const float* cw = p.in[8] + (size_t)l * 4 * 1024 + c;
        const float w0 = cw[0], w1 = cw[1024], w2 = cw[2048], w3 = cw[3072], cb = p.in[9][l * 1024 + c];
        const float* lxp = proj + (size_t)(b * SEQ) * NPROJ + PC_LX + c;
        float x0 = p0 >= 3 ? lxp[(size_t)(p0 - 3) * NPROJ] : 0.f, x1 = p0 >= 2 ? lxp[(size_t)(p0 - 2) * NPROJ] : 0.f, x2 = p0 >= 1 ? lxp[(size_t)(p0 - 1) * NPROJ] : 0.f;
        float xv[32];
#pragma unroll
        for (int i = 0; i < 32; ++i) xv[i] = lxp[(size_t)(p0 + i) * NPROJ];
#pragma unroll
        for (int i = 0; i < 32; ++i) {
            const float x3 = xv[i];
            const float y = cb + w0 * x0 + w1 * x1 + w2 * x2 + w3 * x3;
            Xf[i * 68 + lane] = y; Xs[i * 72 + lane] = f2bf(y);
            x0 = x1; x1 = x2; x2 = x3;
        }
    }
    const bf16_t* gwt = (const bf16_t*)(p.wsl + SL_GWT);
    bf16x8 af[2][2];
#pragma unroll
    for (int tt = 0; tt < 2; ++tt)
#pragma unroll
        for (int ks = 0; ks < 2; ++ks) af[tt][ks] = *(LAS bf16x8*)(Xs + (16 * tt + r) * 72 + 32 * ks + 8 * q);
    float* la = (float*)(p.ws + WS_LA); float* lu = (float*)(p.ws + WS_LU);
    bf16x8 bav[4][2], biv[4][2]; float bbav[4], bbiv[4], lamv[4];
#pragma unroll
    for (int et = 0; et < 4; ++et) {
#pragma unroll
        for (int ks = 0; ks < 2; ++ks) { bav[et][ks] = *(const bf16x8*)(gwt + ((size_t)(0 * 16 + n) * 64 + 16 * et + r) * 64 + 32 * ks + 8 * q); biv[et][ks] = *(const bf16x8*)(gwt + ((size_t)(1 * 16 + n) * 64 + 16 * et + r) * 64 + 32 * ks + 8 * q); }
        const int c = c0 + 16 * et + r;
        bbav[et] = p.in[11][l * 1024 + c]; bbiv[et] = p.in[13][l * 1024 + c]; lamv[et] = p.in[14][l * 1024 + c];
    }
#pragma unroll
    for (int et = 0; et < 4; ++et) {
        bf16x8 ba[2], bi[2];
#pragma unroll
        for (int ks = 0; ks < 2; ++ks) { ba[ks] = bav[et][ks]; bi[ks] = biv[et][ks]; }
        const int e = 16 * et + r, c = c0 + e;
        const float bba = bbav[et], bbi = bbiv[et], lls = logsig(lamv[et]);
        float av[2][4], uv[2][4];
#pragma unroll
        for (int tt = 0; tt < 2; ++tt) {
            f32x4 pa = {0.f, 0.f, 0.f, 0.f}, pi = {0.f, 0.f, 0.f, 0.f};
#pragma unroll
            for (int ks = 0; ks < 2; ++ks) { pa = mfma16(af[tt][ks], ba[ks], pa); pi = mfma16(af[tt][ks], bi[ks], pi); }
#pragma unroll
            for (int j = 0; j < 4; ++j) {
                const int t = 16 * tt + 4 * q + j;
                const float rg = sigmoidf(pa[j] + bba), ig = sigmoidf(pi[j] + bbi);
                const float loga = 8.0f * rg * lls;
                const float a = __expf(loga);
                const float u = __builtin_amdgcn_sqrtf(fmaxf(neg_expm1_small(2.0f * loga), 0.f)) * (ig * Xf[t * 68 + e]);
                la[(size_t)(tok0 + t) * 1024 + c] = a; lu[(size_t)(tok0 + t) * 1024 + c] = u;
                av[tt][j] = a; uv[tt][j] = u;
            }
            asm volatile("" ::: "memory");
        }
        float P = 1.f, H = 0.f;
#pragma unroll
        for (int tt = 0; tt < 2; ++tt)
#pragma unroll
            for (int qq = 0; qq < 4; ++qq) {
                if (q == qq) {
#pragma unroll
                    for (int j = 0; j < 4; ++j) { H = av[tt][j] * H + uv[tt][j]; P *= av[tt][j]; }
                }
                P = __shfl(P, r + 16 * qq); H = __shfl(H, r + 16 * qq);
            }
        if (q == 0) { ((float*)(p.wsl + SL_AGP))[gt * 1024 + c] = P; ((float*)(p.wsl + SL_AGH))[gt * 1024 + c] = H; }
    }
}

__device__ __forceinline__ void fox_attn_unit(const Params& p, int bh, int qb, lds_t lds, int tid, int wave, int lane) {
    const float* proj = (const float*)(p.ws + WS_PROJ);
    const float* cb = (const float*)(p.wsl + SL_CBUF) + bh * SEQ;
    const int b = bh >> 3, h = bh & 7;
    LAS bf16_t* Ks = (LAS bf16_t*)(lds);
    LAS bf16_t* Vt = (LAS bf16_t*)(lds + 9216);
    LAS float* cks = (LAS float*)(lds + 18432);
    const int r = lane & 15, q = lane >> 4;
    const int q0 = qb * 128, qw0 = q0 + 16 * wave, nkv = 2 * (qb + 1);
    const float C2 = 0.125f * LOG2E;
    bf16x8 qf[2];
    {
        const bf16_t* qp = (const bf16_t*)(p.ws + WS_QKV) + (size_t)(b * SEQ + qw0 + r) * 512 + h * 64 + 8 * q;
#pragma unroll
        for (int ks = 0; ks < 2; ++ks) qf[ks] = *(const bf16x8*)(qp + 32 * ks);
    }
    const float cq = cb[qw0 + r];
    float m = -1e30f, lsum = 0.f;
    f32x4 o[4];
#pragma unroll
    for (int i = 0; i < 4; ++i) o[i] = (f32x4){0.f, 0.f, 0.f, 0.f};
    const int lrow = tid >> 3, lch = (tid & 7) * 8;
    const bf16_t* kbase = (const bf16_t*)(p.ws + WS_QKV) + ((size_t)NT + b * SEQ + lrow) * 512 + h * 64 + lch;
    const int vrow = tid & 63, vch = (tid >> 6) * 8;
    const bf16_t* vbase = (const bf16_t*)(p.ws + WS_QKV) + ((size_t)2 * NT + b * SEQ + vrow) * 512 + h * 64 + vch;
    bf16x8 kA = *(const bf16x8*)kbase, vA = *(const bf16x8*)vbase;
    float ckA = tid < 64 ? cb[tid] : 0.f;
    bf16x8 kB = *(const bf16x8*)(kbase + (size_t)64 * 512), vB = *(const bf16x8*)(vbase + (size_t)64 * 512);
    float ckB = tid < 64 ? cb[64 + tid] : 0.f;
    constexpr int FOXBUF = 18432 + 256;
#define FOX_WRITE(KK, VV, CK, bufi, jn) { \
        LAS bf16_t* KsW = (LAS bf16_t*)(lds + (bufi) * FOXBUF); LAS bf16_t* VtW = (LAS bf16_t*)(lds + (bufi) * FOXBUF + 9216); LAS float* cksW = (LAS float*)(lds + (bufi) * FOXBUF + 18432); \
        *(LAS bf16x8*)(KsW + lrow * 72 + lch) = KK; \
        _Pragma("unroll") for (int i = 0; i < 8; ++i) VtW[(vch + i) * 72 + vrow] = (bf16_t)VV[i]; \
        if (tid < 64) cksW[tid] = CK; \
        if ((jn) < nkv) { const size_t off = (size_t)(jn) * 64 * 512; \
            KK = *(const bf16x8*)(kbase + off); VV = *(const bf16x8*)(vbase + off); \
            if (tid < 64) CK = cb[(jn) * 64 + tid]; } }
    __syncthreads();
    FOX_WRITE(kA, vA, ckA, 0, 2)
    asm volatile("s_waitcnt lgkmcnt(0)\n\ts_barrier" ::: "memory");
    for (int j0 = 0; j0 < nkv; j0 += 2) {
        { const int j = j0;
          FOX_WRITE(kB, vB, ckB, 1, j + 3)
          LAS bf16_t* KsX = (LAS bf16_t*)(lds); LAS bf16_t* VtX = (LAS bf16_t*)(lds + 9216); LAS float* cksX = (LAS float*)(lds + 18432);
        if (64 * j <= qw0 + 15) {
            f32x4 s[4]; float mx = -INFINITY;
            bf16x8 kfr[4][2]; f32x4 ckr[4]; s16x4 vlo[4][2], vhi[4][2];
#pragma unroll
            for (int st = 0; st < 4; ++st) {
#pragma unroll
                for (int ks = 0; ks < 2; ++ks) kfr[st][ks] = *(LAS bf16x8*)(KsX + (16 * st + r) * 72 + 32 * ks + 8 * q);
                ckr[st] = *(LAS f32x4*)(cksX + 16 * st + 4 * q);
            }
#pragma unroll
            for (int ds = 0; ds < 4; ++ds)
#pragma unroll
                for (int ks = 0; ks < 2; ++ks) { vlo[ds][ks] = *(LAS s16x4*)(VtX + (16 * ds + r) * 72 + 32 * ks + 4 * q); vhi[ds][ks] = *(LAS s16x4*)(VtX + (16 * ds + r) * 72 + 32 * ks + 16 + 4 * q); }
#pragma unroll
            for (int st = 0; st < 4; ++st) {
                f32x4 acc = {0.f, 0.f, 0.f, 0.f};
#pragma unroll
                for (int ks = 0; ks < 2; ++ks) acc = mfma16(kfr[st][ks], qf[ks], acc);
                const f32x4 ck = ckr[st];
#pragma unroll
                for (int jj = 0; jj < 4; ++jj) {
                    const int kv = 64 * j + 16 * st + 4 * q + jj;
                    float sv = acc[jj] + (cq - ck[jj]);
                    if (64 * j + 63 > qw0) sv = (kv <= qw0 + r) ? sv : -INFINITY;
                    s[st][jj] = sv; mx = fmaxf(mx, sv);
                }
            }
            mx = fmaxf(mx, __shfl_xor(mx, 16)); mx = fmaxf(mx, __shfl_xor(mx, 32));
            const float mnew = fmaxf(m, mx);
            const float alpha = __builtin_amdgcn_exp2f(m - mnew);
            m = mnew;
            float ps = 0.f;
#pragma unroll
            for (int st = 0; st < 4; ++st)
#pragma unroll
                for (int jj = 0; jj < 4; ++jj) { const float e = __builtin_amdgcn_exp2f(s[st][jj] - mnew); s[st][jj] = e; ps += e; }
            lsum = lsum * alpha + ps;
#pragma unroll
            for (int i = 0; i < 4; ++i) o[i] = o[i] * alpha;
            bf16x8 pf[2];
            pf[0] = pack8(s[0], s[1]); pf[1] = pack8(s[2], s[3]);
#pragma unroll
            for (int ds = 0; ds < 4; ++ds)
#pragma unroll
                for (int ks = 0; ks < 2; ++ks) {
                    const s16x4 lo = vlo[ds][ks], hi = vhi[ds][ks];
                    const bf16x8 a = {lo[0], lo[1], lo[2], lo[3], hi[0], hi[1], hi[2], hi[3]};
                    o[ds] = mfma16(a, pf[ks], o[ds]);
                }
        }
          asm volatile("s_waitcnt lgkmcnt(0)\n\ts_barrier" ::: "memory");
        }
        { const int j = j0 + 1;
          if (j + 1 < nkv) FOX_WRITE(kA, vA, ckA, 0, j + 3)
          LAS bf16_t* KsX = (LAS bf16_t*)(lds + FOXBUF); LAS bf16_t* VtX = (LAS bf16_t*)(lds + FOXBUF + 9216); LAS float* cksX = (LAS float*)(lds + FOXBUF + 18432);
        if (64 * j <= qw0 + 15) {
            f32x4 s[4]; float mx = -INFINITY;
            bf16x8 kfr[4][2]; f32x4 ckr[4]; s16x4 vlo[4][2], vhi[4][2];
#pragma unroll
            for (int st = 0; st < 4; ++st) {
#pragma unroll
                for (int ks = 0; ks < 2; ++ks) kfr[st][ks] = *(LAS bf16x8*)(KsX + (16 * st + r) * 72 + 32 * ks + 8 * q);
                ckr[st] = *(LAS f32x4*)(cksX + 16 * st + 4 * q);
            }
#pragma unroll
            for (int ds = 0; ds < 4; ++ds)
#pragma unroll
                for (int ks = 0; ks < 2; ++ks) { vlo[ds][ks] = *(LAS s16x4*)(VtX + (16 * ds + r) * 72 + 32 * ks + 4 * q); vhi[ds][ks] = *(LAS s16x4*)(VtX + (16 * ds + r) * 72 + 32 * ks + 16 + 4 * q); }
#pragma unroll
            for (int st = 0; st < 4; ++st) {
                f32x4 acc = {0.f, 0.f, 0.f, 0.f};
#pragma unroll
                for (int ks = 0; ks < 2; ++ks) acc = mfma16(kfr[st][ks], qf[ks], acc);
                const f32x4 ck = ckr[st];
#pragma unroll
                for (int jj = 0; jj < 4; ++jj) {
                    const int kv = 64 * j + 16 * st + 4 * q + jj;
                    float sv = acc[jj] + (cq - ck[jj]);
                    if (64 * j + 63 > qw0) sv = (kv <= qw0 + r) ? sv : -INFINITY;
                    s[st][jj] = sv; mx = fmaxf(mx, sv);
                }
            }
            mx = fmaxf(mx, __shfl_xor(mx, 16)); mx = fmaxf(mx, __shfl_xor(mx, 32));
            const float mnew = fmaxf(m, mx);
            const float alpha = __builtin_amdgcn_exp2f(m - mnew);
            m = mnew;
            float ps = 0.f;
#pragma unroll
            for (int st = 0; st < 4; ++st)
#pragma unroll
                for (int jj = 0; jj < 4; ++jj) { const float e = __builtin_amdgcn_exp2f(s[st][jj] - mnew); s[st][jj] = e; ps += e; }
            lsum = lsum * alpha + ps;
#pragma unroll
            for (int i = 0; i < 4; ++i) o[i] = o[i] * alpha;
            bf16x8 pf[2];
            pf[0] = pack8(s[0], s[1]); pf[1] = pack8(s[2], s[3]);
#pragma unroll
            for (int ds = 0; ds < 4; ++ds)
#pragma unroll
                for (int ks = 0; ks < 2; ++ks) {
                    const s16x4 lo = vlo[ds][ks], hi = vhi[ds][ks];
                    const bf16x8 a = {lo[0], lo[1], lo[2], lo[3], hi[0], hi[1], hi[2], hi[3]};
                    o[ds] = mfma16(a, pf[ks], o[ds]);
                }
        }
          asm volatile("s_waitcnt lgkmcnt(0)\n\ts_barrier" ::: "memory");
        }
    }
#undef FOX_WRITE
    lsum += __shfl_xor(lsum, 16); lsum += __shfl_xor(lsum, 32);
    const float inv = 1.0f / lsum;
    bf16_t* op = (bf16_t*)(p.ws + WS_FOXO) + (size_t)(b * SEQ + qw0 + r) * 512 + h * 64 + 4 * q;
#pragma unroll
    for (int ds = 0; ds < 4; ++ds) { u32x2 w; w.x = pk2(o[ds][0] * inv, o[ds][1] * inv); w.y = pk2(o[ds][2] * inv, o[ds][3] * inv); *(u32x2*)(op + 16 * ds) = w; }
}

__device__ __forceinline__ void gla_scan_item(const Params& p, int item, int tid) {
    const int bh = item >> 4, e = (item & 15) * 512 + tid, d = e & 63;
    const float* ub = (const float*)(p.ws + WS_GU) + (size_t)bh * 64 * 8192 + e;
    const float* dec = (const float*)(p.wsl + SL_GDEC) + (size_t)bh * 64 * 64 + d;
    bf16_t* sp = (bf16_t*)(p.ws + WS_GS) + (size_t)bh * 64 * 8192 + e;
    float st = 0.f;
#pragma unroll
    for (int n0 = 0; n0 < 64; n0 += 32) {
        float u[32], dc[32];
#pragma unroll
        for (int n = 0; n < 32; ++n) { u[n] = ub[(size_t)(n0 + n) * 8192]; dc[n] = dec[(n0 + n) * 64]; }
#pragma unroll
        for (int n = 0; n < 32; ++n) { sp[(size_t)(n0 + n) * 8192] = f2bf(st); st = dc[n] * st + u[n]; }
    }
}

__device__ __forceinline__ void lru_tilescan_item(const Params& p, int item, int tid) {
    const int gid = item * 512 + tid, b = gid >> 10, c = gid & 1023;
    const float* P = (const float*)(p.wsl + SL_AGP) + (size_t)b * 64 * 1024 + c;
    const float* H = (const float*)(p.wsl + SL_AGH) + (size_t)b * 64 * 1024 + c;
    float* hi = (float*)(p.wsl + SL_HIN) + (size_t)b * 64 * 1024 + c;
    float h = 0.f;
#pragma unroll
    for (int t0 = 0; t0 < 64; t0 += 32) {
        float a[32], u[32];
#pragma unroll
        for (int t = 0; t < 32; ++t) { a[t] = P[(t0 + t) * 1024]; u[t] = H[(t0 + t) * 1024]; }
#pragma unroll
        for (int t = 0; t < 32; ++t) { hi[(t0 + t) * 1024] = h; h = a[t] * h + u[t]; }
    }
}

__device__ __forceinline__ void fox_norm_rows4(const Params& p, int l, int tok0, int stride, int lane) {
    u32x4 w[4];
#pragma unroll
    for (int k = 0; k < 4; ++k) w[k] = *(const u32x4*)((const bf16_t*)(p.ws + WS_FOXO) + (size_t)(tok0 + k * stride) * 512 + lane * 8);
    const float* g = p.in[4] + l * 512 + lane * 8;
    const f32x4 g0 = *(const f32x4*)g, g1 = *(const f32x4*)(g + 4);
#pragma unroll
    for (int k = 0; k < 4; ++k) {
        float v[8];
#pragma unroll
        for (int i = 0; i < 4; ++i) { v[2 * i] = bf2f(w[k][i] & 0xffffu); v[2 * i + 1] = bf2f(w[k][i] >> 16); }
        float s = 0.f;
#pragma unroll
        for (int i = 0; i < 8; ++i) s += v[i] * v[i];
        const float rstd = rsqrtf(wave_sum(s) * (1.0f / 512.0f) + EPS);
        u32x4 ow; ow.x = pk2(v[0] * rstd * g0[0], v[1] * rstd * g0[1]); ow.y = pk2(v[2] * rstd * g0[2], v[3] * rstd * g0[3]);
        ow.z = pk2(v[4] * rstd * g1[0], v[5] * rstd * g1[1]); ow.w = pk2(v[6] * rstd * g1[2], v[7] * rstd * g1[3]);
        *(u32x4*)((bf16_t*)(p.ws + WS_MIX) + (size_t)(tok0 + k * stride) * 2048 + lane * 8) = ow;
    }
}

__device__ __forceinline__ void gla_out_witem(const Params& p, int l, int item, int lane) {
    const float* proj = (const float*)(p.ws + WS_PROJ);
    const int ch = item >> 1, tt = item & 1;
    const int bh = ch >> 6, n = ch & 63, b = bh >> 2, h = bh & 3;
    const int t0 = b * SEQ + n * 32;
    const int r = lane & 15, q = lane >> 4;
    const bf16_t* ab = (const bf16_t*)(p.wsl + SL_GA) + (size_t)ch * 1024;
    const bf16_t* vt = (const bf16_t*)(p.ws + WS_GVT) + (size_t)ch * 4096;
    const bf16_t* qt = (const bf16_t*)(p.wsl + SL_GQT) + (size_t)t0 * 256 + h * 64;
    const bf16_t* sp = (const bf16_t*)(p.ws + WS_GS) + (size_t)ch * 8192;
    const bf16x8 aa = *(const bf16x8*)(ab + (16 * tt + r) * 32 + 8 * q);
    const bf16x8 aq0 = *(const bf16x8*)(qt + (size_t)(16 * tt + r) * 256 + 8 * q), aq1 = *(const bf16x8*)(qt + (size_t)(16 * tt + r) * 256 + 32 + 8 * q);
    f32x4 acc[8];
#pragma unroll
    for (int w = 0; w < 8; ++w) {
        const int v = 16 * w + r;
        const bf16x8 bv = *(const bf16x8*)(vt + v * 32 + 8 * q);
        const bf16x8 bs0 = *(const bf16x8*)(sp + v * 64 + 8 * q), bs1 = *(const bf16x8*)(sp + v * 64 + 32 + 8 * q);
        f32x4 c = mfma16(aa, bv, (f32x4){0.f, 0.f, 0.f, 0.f});
        c = mfma16(aq0, bs0, c); c = mfma16(aq1, bs1, c);
        acc[w] = c;
    }
    float tot[4] = {0.f, 0.f, 0.f, 0.f};
#pragma unroll
    for (int w = 0; w < 8; ++w)
#pragma unroll
        for (int j = 0; j < 4; ++j) {
            float s = acc[w][j] * acc[w][j];
            s += __shfl_xor(s, 1); s += __shfl_xor(s, 2); s += __shfl_xor(s, 4); s += __shfl_xor(s, 8);
            tot[j] += s;
        }
#pragma unroll
    for (int j = 0; j < 4; ++j) {
        const int t = 16 * tt + 4 * q + j;
        const float rstd = rsqrtf(tot[j] * (1.0f / 128.0f) + EPS);
        const float* ggp = proj + (size_t)(t0 + t) * NPROJ + PC_GG + h * 128 + r;
        bf16_t* mp = (bf16_t*)(p.ws + WS_MIX) + (size_t)(t0 + t) * 2048 + 512 + h * 128 + r;
#pragma unroll
        for (int w = 0; w < 8; ++w) {
            const float gn = p.in[7][l * 128 + 16 * w + r];
            const float gg = ggp[16 * w];
            const float y = acc[w][j] * rstd * gn * (gg * sigmoidf(gg));
            mp[16 * w] = f2bf(y);
        }
    }
}

__device__ __forceinline__ float gelu_tanh(float x) {
    const float u = 0.7978845608028654f * (x + 0.044715f * x * x * x);
    const float t = 1.0f - 2.0f * __builtin_amdgcn_rcpf(1.0f + __expf(2.0f * u));
    return 0.5f * x * (1.0f + t);
}

__device__ __forceinline__ void lru_out_item(const Params& p, int l, int gt, lds_t lds, int tid, int wave, int lane) {
    const float* proj = (const float*)(p.ws + WS_PROJ);
    const int tok0 = gt * 32, c = 2 * tid;
    LAS float* part = (LAS float*)(lds);
    LAS float* rs = (LAS float*)(lds + 65536);
    const f32x2* la = (const f32x2*)((const float*)(p.ws + WS_LA) + (size_t)tok0 * 1024 + c);
    const f32x2* lu = (const f32x2*)((const float*)(p.ws + WS_LU) + (size_t)tok0 * 1024 + c);
    const float* lgp = proj + (size_t)tok0 * NPROJ + PC_LG + c;
    f32x2 h = *(const f32x2*)((const float*)(p.wsl + SL_HIN) + (size_t)gt * 1024 + c);
    f32x2 y[32];
    {
        f32x2 av[32], uv[32];
#pragma unroll
        for (int t = 0; t < 32; ++t) { av[t] = la[t * 512]; uv[t] = lu[t * 512]; }
#pragma unroll
        for (int t = 0; t < 32; ++t) { h = av[t] * h + uv[t]; y[t] = h; }
    }
    {
        f32x2 gv[32];
#pragma unroll
        for (int t = 0; t < 32; ++t) gv[t] = *(const f32x2*)(lgp + (size_t)t * NPROJ);
#pragma unroll
        for (int t = 0; t < 32; ++t) {
            y[t][0] = y[t][0] * gelu_tanh(gv[t][0]); y[t][1] = y[t][1] * gelu_tanh(gv[t][1]);
            part[t * 512 + tid] = y[t][0] * y[t][0] + y[t][1] * y[t][1];
        }
    }
    __syncthreads();
    {
        const int t = tid >> 4, k0 = tid & 15;
        float s = 0.f;
#pragma unroll 8
        for (int k = 0; k < 32; ++k) s += part[t * 512 + k0 + 16 * k];
        s += __shfl_xor(s, 1); s += __shfl_xor(s, 2); s += __shfl_xor(s, 4); s += __shfl_xor(s, 8);
        if (k0 == 0) rs[t] = rsqrtf(s * (1.0f / 1024.0f) + EPS);
    }
    __syncthreads();
    const f32x2 g = *(const f32x2*)(p.in[15] + l * 1024 + c);
    bf16_t* mix = (bf16_t*)(p.ws + WS_MIX) + (size_t)tok0 * 2048 + 1024 + c;
#pragma unroll
    for (int t = 0; t < 32; ++t) { const float rr = rs[t]; *(unsigned*)(mix + (size_t)t * 2048) = pk2(y[t][0] * rr * g[0], y[t][1] * rr * g[1]); }
    __syncthreads();
}

#define XB_TMO      128
#define XB_XCNT(j)  (256  + 64 * (j))
#define XB_XSUB(j)  (1280 + 64 * (j))
#define XB_XGEN(j)  (2304 + 64 * (j))
#define XB_TOP      3328
#define XB_TOPGEN   3392
#define XCD_BAR_WORDS 3456
#define XB_SPIN_CAP (1u << 18)

__device__ __forceinline__ unsigned xb_ld(unsigned* p)              { return __hip_atomic_load(p, __ATOMIC_RELAXED, __HIP_MEMORY_SCOPE_AGENT); }
__device__ __forceinline__ unsigned xb_add(unsigned* p, unsigned v) { return __hip_atomic_fetch_add(p, v, __ATOMIC_RELAXED, __HIP_MEMORY_SCOPE_AGENT); }
__device__ __forceinline__ unsigned xb_xcc_id() { return (unsigned)__builtin_amdgcn_s_getreg((3 << 11) | 20) & 0xFu; }
#define XB_SPIN(cond, bar) do { unsigned _sp = 0; while (cond) { __builtin_amdgcn_s_sleep(1); \
    if ((++_sp & 255u) == 0u) { if (xb_ld(&(bar)[XB_TMO])) break; if (_sp > XB_SPIN_CAP) { atomicAdd(&(bar)[XB_TMO], 1u); break; } } } } while (0)

struct XcdBarrier {
    unsigned* bar; unsigned x;
    volatile LAS unsigned* st;
};

__device__ __forceinline__ XcdBarrier xcd_barrier_post(unsigned* bar, volatile LAS unsigned* st) {
    XcdBarrier b; b.bar = bar; b.x = xb_xcc_id(); b.st = st;
    if (threadIdx.x == 0) (void)xb_add(&bar[XB_XCNT(b.x)], 1u);
    return b;
}
__device__ __forceinline__ void xcd_barrier_complete(unsigned* bar, unsigned x, unsigned& nloc, unsigned& nx) {
    const unsigned G = gridDim.x * gridDim.y * gridDim.z;
    unsigned sum, cnt, mine, sp = 0u;
    for (;;) {
        sum = 0u; cnt = 0u; mine = 0u;
#pragma unroll
        for (unsigned j = 0; j < 16; ++j) { const unsigned c = xb_ld(&bar[XB_XCNT(j)]); sum += c; cnt += (c > 0u) ? 1u : 0u; mine = (j == x) ? c : mine; }
        if (sum == G) break;
        __builtin_amdgcn_s_sleep(1);
        if ((++sp & 255u) == 0u) { if (xb_ld(&bar[XB_TMO])) break; if (sp > XB_SPIN_CAP) { atomicAdd(&bar[XB_TMO], 1u); break; } }
    }
    nloc = mine > 0u ? mine : 1u; nx = cnt > 0u ? cnt : 1u;
}

__device__ __forceinline__ void xcd_barrier(const XcdBarrier& b) {
    asm volatile("s_waitcnt vmcnt(0)" ::: "memory");
    __syncthreads();
    if (threadIdx.x == 0) {
        unsigned* bar = b.bar;
        __builtin_amdgcn_s_waitcnt(0);
        unsigned nloc = b.st[0], nx = b.st[1];
        if (nloc == 0u) { xcd_barrier_complete(bar, b.x, nloc, nx); b.st[0] = nloc; b.st[1] = nx; }
        const unsigned old = xb_add(&bar[XB_XSUB(b.x)], 1u);
        const unsigned gen = old / nloc;
        if (old + 1u == (gen + 1u) * nloc) {
            __builtin_amdgcn_fence(__ATOMIC_RELEASE, "agent");
            asm volatile("s_waitcnt vmcnt(0)" ::: "memory");
            const unsigned og = xb_add(&bar[XB_TOP], 1u);
            const unsigned tg = og / nx;
            if (og + 1u == (tg + 1u) * nx) xb_add(&bar[XB_TOPGEN], 1u);
            else XB_SPIN(xb_ld(&bar[XB_TOPGEN]) == tg, bar);
            __builtin_amdgcn_fence(__ATOMIC_ACQUIRE, "agent");
            xb_add(&bar[XB_XGEN(b.x)], 1u);
            asm volatile("s_waitcnt vmcnt(0)" ::: "memory");
        } else {
            XB_SPIN(xb_ld(&bar[XB_XGEN(b.x)]) == gen, bar);
            __builtin_amdgcn_fence(__ATOMIC_ACQUIRE, "agent");
            asm volatile("s_waitcnt vmcnt(0)" ::: "memory");
        }
    }
    __syncthreads();
}

__global__ void __launch_bounds__(512, 2) hymba_fwd(Params p0) {
    extern __shared__ __attribute__((aligned(16))) unsigned char lds_raw[];
    cg::grid_group grid = cg::this_grid();
    const int G = gridDim.x, bid = blockIdx.x, ngw = G * 8;
    volatile LAS unsigned* bst = (volatile LAS unsigned*)((lds_t)lds_raw + (LDS_BYTES - 64));
    if (threadIdx.x < 16) bst[threadIdx.x] = 0u;
    __syncthreads();
    const XcdBarrier bar = xcd_barrier_post((unsigned*)(p0.ws + WS_CTL), bst);
#define PHASE_BEGIN \
    int tid = threadIdx.x; asm volatile("" : "+v"(tid)); \
    const int lane = tid & 63, wave = __builtin_amdgcn_readfirstlane(tid >> 6); \
    unsigned lo_ = 0; asm volatile("" : "+s"(lo_)); lds_t lds = (lds_t)lds_raw + lo_; \
    Params p = p0; asm volatile("" : "+s"(p.ws)); p.wsl = p.ws + WS_SMALL + (size_t)lcur * SMALL_BYTES; \
    GAS unsigned char* ws = p.ws; const int gw = bid * 8 + wave; (void)gw; (void)lane; (void)lds; (void)ws;

#pragma clang loop unroll(disable)
    for (int l = 0; l < DEPTH; ++l) {
        const int lcur = l;
        if (l == 0) {
            {
                PHASE_BEGIN
                phase_wconv(p, 0, 1, gw, ngw, lane);
                for (int m = gw; m < NT; m += ngw) prep_row(p.in[0] + (size_t)m * DM, (bf16_t*)(ws + WS_HB) + (size_t)m * DM, (float*)(ws + WS_SS1), m, lane, p.in[1]);
            }
            if (p0.ws == nullptr) grid.sync();
            xcd_barrier(bar);
        }
        {
            PHASE_BEGIN
            pg8::Gemm g{(const bf16_t*)(ws + WS_HB), (const bf16_t*)(ws + WS_WIN), NT, NPROJ, DM}; pg8::StaticOrder S; S.init(NT, NPROJ, G, bid);
            gate_wt_prep(p, l, bid * 512 + tid);
            pg8::rstd_table((LAS float*)(lds + 131072), (const float*)(ws + WS_SS1 + (size_t)l * MiB), S, tid);
            pg8::EpiStoreF32 E{(float*)(ws + WS_PROJ), NPROJ, (const LAS float*)(lds + 131072), 0, (bf16_t*)(ws + WS_QKV)};
            pg8::gemm_phase<pg8::EpiStoreF32, pg8::StaticOrder, true, true>(lds, g, S, E, tid);
            { const int nfull = (NT / 256) * (NPROJ / 256) % G; if (nfull > 0 && bid >= nfull) phase_wconv(p, l, 2 | 4, (bid - nfull) * 8 + wave, (G - nfull) * 8, lane); else if (nfull == 0) phase_wconv(p, l, 2 | 4, gw, ngw, lane); }
        }
        xcd_barrier(bar);
        {
            PHASE_BEGIN
            if (gw < 32) fox_cumsum(p, l, gw, lane);
            {
                lds_t wl = lds + wave * 18432;
                if (G == 256) {
                    if (wave < 4) { gla_prep_witem(p, l, bid * 4 + wave, wl, lane); lru_prep_witem(p, l, bid * 16 + wave, wl, lane); }
                    else for (int k = 0; k < 3; ++k) lru_prep_witem(p, l, bid * 16 + 4 + (wave - 4) * 3 + k, wl, lane);
                } else
                for (int it = gw; it < 1024 + 4096; it += ngw) {
                    if (it < 1024) gla_prep_witem(p, l, it, wl, lane);
                    else lru_prep_witem(p, l, it - 1024, wl, lane);
                }
            }
        }
        xcd_barrier(bar);
        {
            PHASE_BEGIN
            for (int it = bid; it < 256; it += G) {
                const int bh = it >> 3, s = it & 7;
                fox_attn_unit(p, bh, 15 - s, lds, tid, wave, lane);
                fox_attn_unit(p, bh, s, lds, tid, wave, lane);
            }
            for (int it = bid; it < 256; it += G) gla_scan_item(p, it, tid);
            for (int it = G - 1 - bid; it < 8; it += G) lru_tilescan_item(p, it, tid);
        }
        xcd_barrier(bar);
        {
            PHASE_BEGIN
            for (int it = bid; it < 256; it += G) lru_out_item(p, l, it, lds, tid, wave, lane);
            for (int it = gw; it < 2048; it += ngw) gla_out_witem(p, l, it, lane);
            if (NT % (4 * ngw) == 0) { for (int tok = gw; tok < NT; tok += 4 * ngw) fox_norm_rows4(p, l, tok, ngw, lane); }
            else for (int tok = gw; tok < NT; tok += ngw) fox_norm_rows4(p, l, tok, 0, lane);
        }
        xcd_barrier(bar);
        {
            PHASE_BEGIN
            const float* xin = (l == 0) ? p.in[0] : (const float*)(ws + WS_XW);
            pg8::Gemm g{(const bf16_t*)(ws + WS_MIX), (const bf16_t*)(ws + WS_WOUT), NT, DM, DM}; pg8::StaticOrder S; S.init(NT, DM, G, bid);
            pg8::EpiResid E{xin, (float*)(ws + WS_XW), (bf16_t*)(ws + WS_HB), (float*)(ws + WS_SS2 + (size_t)l * MiB), p.in[17] + l * DM, DM};
            pg8::gemm_phase<pg8::EpiResid, pg8::StaticOrder, true, true>(lds, g, S, E, tid);
        }
        xcd_barrier(bar);
        {
            PHASE_BEGIN
            pg8::Gemm g{(const bf16_t*)(ws + WS_HB), (const bf16_t*)(ws + WS_WGU), NT, 2 * FFH, DM}; pg8::StaticOrder S; S.init(NT, 2 * FFH, G, bid);
            pg8::rstd_table((LAS float*)(lds + 131072), (const float*)(ws + WS_SS2 + (size_t)l * MiB), S, tid);
            pg8::EpiSwiglu E{(bf16_t*)(ws + WS_PROJ), FFH, (const LAS float*)(lds + 131072), 0};
            pg8::gemm_phase<pg8::EpiSwiglu, pg8::StaticOrder, true, true>(lds, g, S, E, tid);
            { const int nfull = (NT / 256) * (2 * FFH / 256) % G; const int msk = 8 | (l + 1 < DEPTH ? 1 : 0); const int ln = (l + 1 < DEPTH) ? l + 1 : l;
              if (nfull > 0 && bid >= nfull) { phase_wconv(p, l, 8, (bid - nfull) * 8 + wave, (G - nfull) * 8, lane); if (msk & 1) phase_wconv(p, ln, 1, (bid - nfull) * 8 + wave, (G - nfull) * 8, lane); }
              else if (nfull == 0) { phase_wconv(p, l, 8, gw, ngw, lane); if (msk & 1) phase_wconv(p, ln, 1, gw, ngw, lane); } }
        }
        xcd_barrier(bar);
        {
            PHASE_BEGIN
            pg8::Gemm g{(const bf16_t*)(ws + WS_PROJ), (const bf16_t*)(ws + WS_WDN), NT, DM, FFH}; pg8::StaticOrder S; S.init(NT, DM, G, bid);
            pg8::EpiResid E{(const float*)(ws + WS_XW), (float*)(ws + WS_XW), (l < DEPTH - 1) ? (bf16_t*)(ws + WS_HB) : (bf16_t*)nullptr, (float*)(ws + WS_SS1 + (size_t)(l + 1) * MiB), p.in[1] + (l < DEPTH - 1 ? l + 1 : 0) * DM, DM};
            pg8::gemm_phase<pg8::EpiResid, pg8::StaticOrder, true, true>(lds, g, S, E, tid);
        }
        xcd_barrier(bar);
    }
    {
        const int lcur = 0;
        PHASE_BEGIN
        for (int m = gw; m < NT; m += ngw) { const float sv = wave_sum(lane < 32 ? ((const float*)(ws + WS_SS1 + (size_t)DEPTH * MiB))[((size_t)(lane >> 2) * 8192 + m) * 4 + (lane & 3)] : 0.f);
            final_row((const float*)(ws + WS_XW) + (size_t)m * DM, p.in[21], p.out + (size_t)m * DM, sv, lane); }
    }
}

extern "C" void kernel_launch(void* const* d_in, const int* in_sizes, int n_in, void* d_out, int out_size, void* d_ws, size_t ws_size, hipStream_t stream) {
    static int grid_blocks = 0;
    if (grid_blocks == 0) {
        if (n_in != 22 || ws_size < WS_END) { fprintf(stderr, "kernel_launch: unexpected n_in %d / ws_size %zu\n", n_in, ws_size); grid_blocks = -1; return; }
        int dev = 0, cus = 0, per_cu = 0;
        hipGetDevice(&dev);
        hipDeviceGetAttribute(&cus, hipDeviceAttributeMultiprocessorCount, dev);
        hipFuncSetAttribute((const void*)hymba_fwd, hipFuncAttributeMaxDynamicSharedMemorySize, LDS_BYTES);
        hipOccupancyMaxActiveBlocksPerMultiprocessor(&per_cu, (const void*)hymba_fwd, 512, LDS_BYTES);
        if (per_cu < 1) { fprintf(stderr, "kernel_launch: occupancy query says %d blocks per CU\n", per_cu); per_cu = 1; }
        (void)hipGetLastError();
        grid_blocks = cus * 1;
    }
    if (grid_blocks < 0) return;
    Params p{};
    for (int i = 0; i < 22; ++i) p.in[i] = (const float*)d_in[i];
    p.out = (float*)d_out; p.ws = (GAS unsigned char*)d_ws;
    if (hipMemsetAsync((unsigned char*)d_ws + WS_CTL, 0, CTL_BYTES, stream) != hipSuccess) { fprintf(stderr, "kernel_launch: memset failed\n"); return; }
    void* args[] = {&p};
    hipError_t e = hipLaunchCooperativeKernel((const void*)hymba_fwd, dim3(grid_blocks), dim3(512), args, LDS_BYTES, stream);
    if (e != hipSuccess) fprintf(stderr, "cooperative launch failed: %s (grid %d)\n", hipGetErrorString(e), grid_blocks);
}
```

```cpp
#include <hip/hip_runtime.h>
#include <hip/hip_cooperative_groups.h>
#include <cstdio>
#include <cstdint>
namespace cg = cooperative_groups;
namespace pg8 {
#define PG8_LAS __attribute__((address_space(3)))
typedef unsigned short bf16_t;
typedef short bf16x8 __attribute__((ext_vector_type(8)));
typedef float f32x4 __attribute__((ext_vector_type(4)));
typedef unsigned u32x4 __attribute__((ext_vector_type(4)));
constexpr int BM = 256, BK = 64, HALF = 128, HTB = HALF * BK * 2  , STAGE_BYTES = 8 * HTB, NXCD = 8, WGM = 8;

__host__ __device__ __forceinline__ int lds_byte(int r, int c) { const int st = (r >> 4) * 2 + (c >> 5), rr = r & 15, cc = c & 31, ob = rr * 64 + cc * 2; return st * 1024 + (ob ^ (((ob >> 9) & 1) << 5)); }
__host__ __device__ __forceinline__ void stage_rc(int b, int& R, int& C) { const int st = b / 1024, sb = b % 1024, swz = sb ^ (((sb >> 9) & 1) << 5); R = (st >> 1) * 16 + swz / 64; C = (st & 1) * 32 + (swz % 64) / 2; }
__host__ __device__ __forceinline__ int perm32(int rho) { const int n = rho >> 4, i = rho & 15; return 8 * (i >> 2) + 4 * n + (i & 3); }

struct Unit { int pm, pn; };
struct Gemm { const bf16_t* A; const bf16_t* Bt; int M, N, K; };

struct StaticOrder {
    int nM, nN, nwg, G, c;
    __host__ __device__ void init(int M, int N, int G_, int c_) { nM = M / BM; nN = N / BM; nwg = nM * nN; G = G_; c = c_; }
    __host__ __device__ bool next(int i, Unit& u) const {
        const long L = (long)i * G + c; if (L >= nwg) return false;
        int wgid = (int)L; { const int q = nwg / NXCD, r = nwg % NXCD, xcd = wgid % NXCD, off = wgid / NXCD; wgid = (xcd < r ? xcd * (q + 1) : r * (q + 1) + (xcd - r) * q) + off; }
        const int nig = WGM * nN, gid = wgid / nig, fm = gid * WGM, gsz = (nM - fm) < WGM ? (nM - fm) : WGM;
        u.pm = fm + ((wgid % nig) % gsz); u.pn = (wgid % nig) / gsz; return true;
    }
    __device__ __forceinline__ void a_ready(const Unit&) const {}
    __device__ __forceinline__ void done(const Unit&) const {}
};

typedef unsigned u32x2 __attribute__((ext_vector_type(2)));
__device__ __forceinline__ unsigned cvt_pk_bf16(float lo, float hi) { unsigned r; asm("v_cvt_pk_bf16_f32 %0, %1, %2" : "=v"(r) : "v"(lo), "v"(hi)); return r; }
__device__ __forceinline__ float ssp_sum(const float* p, int row) {
    float s = 0.f;
#pragma unroll
    for (int i = 0; i < 8; ++i) { const f32x4 v = *(const f32x4*)(p + ((size_t)i * 8192 + row) * 4); s += (v[0] + v[1]) + (v[2] + v[3]); }
    return s;
}
template <class Sched> __device__ __forceinline__ void rstd_table(PG8_LAS float* rtab, const float* ss, const Sched& S, int tid) {
    float v[4]; bool ok[4];
#pragma unroll
    for (int k = 0; k < 4; ++k) { const int i = 2 * k + (tid >> 8); Unit u; ok[k] = S.next(i, u); v[k] = ok[k] ? ssp_sum(ss, u.pm * BM + (tid & 255)) : 0.f; }
#pragma unroll
    for (int k = 0; k < 4; ++k) if (ok[k]) rtab[(2 * k + (tid >> 8)) * 256 + (tid & 255)] = rsqrtf(v[k] * (1.0f / 2048.0f) + 1e-6f);
    __syncthreads();
}
#define PG8_ROW_RSTD(rs, ss, row0) float rs[2][4]; { const int lane_ = (int)(threadIdx.x & 63u); \
    const float v0_ = rsqrtf(ssp_sum((ss), (row0) + (lane_ >> 4) * 16) * (1.0f / 2048.0f) + 1e-6f), v1_ = rsqrtf(ssp_sum((ss), (row0) + HALF + (lane_ >> 4) * 16) * (1.0f / 2048.0f) + 1e-6f); \
    _Pragma("unroll") for (int m_ = 0; m_ < 4; ++m_) { rs[0][m_] = __shfl(v0_, (lane_ & 15) + 16 * m_); rs[1][m_] = __shfl(v1_, (lane_ & 15) + 16 * m_); } }
struct EpiStoreF32 {
    static constexpr bool PERM = false, AFTER_DRAIN = false;
    float* O; int ldc; const PG8_LAS float* rtab; mutable int ui;
    bf16_t* qkv;
    __device__ __forceinline__ void operator()(const f32x4 (&acc)[2][2][4][2], const Unit& u, int wr, int wc, int fr, int fq) const {
        const int row0 = u.pm * BM + wr * 64 + fr, col0 = u.pn * BM + wc * 32 + 4 * fq;
        const PG8_LAS float* rt = rtab + ui * 256 + wr * 64 + fr; ++ui;
#pragma unroll
        for (int ai = 0; ai < 2; ++ai)
#pragma unroll
            for (int m = 0; m < 4; ++m) { const int row = row0 + ai * HALF + m * 16; float* rowp = O + (size_t)row * ldc + col0;
                const float rs = rt[ai * HALF + m * 16];
                if (u.pn < 6 || (u.pn >> 1) == 4) {
                    const float sc = (u.pn < 2) ? 0.125f * 1.4426950408889634f : 1.0f;
                    bf16_t* bp = qkv + ((size_t)(u.pn < 6 ? (u.pn >> 1) : 3) * 8192 + row) * 512 + (u.pn & 1) * 256 + wc * 32 + 4 * fq;
#pragma unroll
                    for (int bj = 0; bj < 2; ++bj)
#pragma unroll
                        for (int n = 0; n < 2; ++n) { f32x4 v = acc[ai][bj][m][n] * rs; if (u.pn < 2) v = v * sc;
                            u32x2 w; w.x = cvt_pk_bf16(v[0], v[1]); w.y = cvt_pk_bf16(v[2], v[3]); *(u32x2*)(bp + bj * HALF + n * 16) = w; }
                } else {
#pragma unroll
                for (int bj = 0; bj < 2; ++bj)
#pragma unroll
                    for (int n = 0; n < 2; ++n) *(f32x4*)(rowp + bj * HALF + n * 16) = acc[ai][bj][m][n] * rs; } }
    }
};
struct EpiResid {
    static constexpr bool PERM = false, AFTER_DRAIN = false;
    const float* base; float* out; bf16_t* xb; float* ss; const float* gain; int ldc;
    __device__ __forceinline__ void operator()(const f32x4 (&acc)[2][2][4][2], const Unit& u, int wr, int wc, int fr, int fq) const {
        const int row0 = u.pm * BM + wr * 64 + fr, col0 = u.pn * BM + wc * 32 + 4 * fq;
        f32x4 gv[2][2];
#pragma unroll
        for (int bj = 0; bj < 2; ++bj)
#pragma unroll
            for (int n = 0; n < 2; ++n) gv[bj][n] = *(const f32x4*)(gain + col0 + bj * HALF + n * 16);
#pragma unroll
        for (int ai = 0; ai < 2; ++ai) {
            f32x4 pre[4][2][2];
#pragma unroll
            for (int m = 0; m < 4; ++m)
#pragma unroll
                for (int bj = 0; bj < 2; ++bj)
#pragma unroll
                    for (int n = 0; n < 2; ++n) pre[m][bj][n] = *(const f32x4*)(base + (size_t)(row0 + ai * HALF + m * 16) * ldc + col0 + bj * HALF + n * 16);
#pragma unroll
            for (int m = 0; m < 4; ++m) { const int row = row0 + ai * HALF + m * 16; const size_t off = (size_t)row * ldc + col0; float s = 0.f;
#pragma unroll
                for (int bj = 0; bj < 2; ++bj)
#pragma unroll
                    for (int n = 0; n < 2; ++n) { const f32x4 b = pre[m][bj][n]; const f32x4 v = b + acc[ai][bj][m][n];
                        *(f32x4*)(out + off + bj * HALF + n * 16) = v; s += (v[0] * v[0] + v[1] * v[1]) + (v[2] * v[2] + v[3] * v[3]);
                        if (xb) { const f32x4 y = v * gv[bj][n]; u32x2 w; w.x = cvt_pk_bf16(y[0], y[1]); w.y = cvt_pk_bf16(y[2], y[3]); *(u32x2*)(xb + off + bj * HALF + n * 16) = w; } }
                s += __shfl_xor(s, 16); s += __shfl_xor(s, 32);
                if (fq == 0) ss[((size_t)u.pn * 8192 + row) * 4 + wc] = s; }
            asm volatile("" ::: "memory");
        }
    }
};
struct EpiSwiglu {
    static constexpr bool PERM = true, AFTER_DRAIN = false;
    bf16_t* O; int ldc; const PG8_LAS float* rtab; mutable int ui;
    __device__ __forceinline__ void operator()(const f32x4 (&acc)[2][2][4][2], const Unit& u, int wr, int wc, int fr, int fq) const {
        const int row0 = u.pm * BM + wr * 64 + fr, col0 = u.pn * HALF + wc * 32 + 8 * fq;
        const PG8_LAS float* rt = rtab + ui * 256 + wr * 64 + fr; ++ui;
#pragma unroll
        for (int ai = 0; ai < 2; ++ai)
#pragma unroll
            for (int m = 0; m < 4; ++m) {
                const float rs = rt[ai * HALF + m * 16];
                float h[8];
#pragma unroll
                for (int n = 0; n < 2; ++n)
#pragma unroll
                    for (int e = 0; e < 4; ++e) { const float g = acc[ai][0][m][n][e] * rs, up = acc[ai][1][m][n][e] * rs; h[n * 4 + e] = g * __builtin_amdgcn_rcpf(1.0f + __builtin_amdgcn_exp2f(g * -1.4426950408889634f)) * up; }
                u32x4 w; w.x = cvt_pk_bf16(h[0], h[1]); w.y = cvt_pk_bf16(h[2], h[3]); w.z = cvt_pk_bf16(h[4], h[5]); w.w = cvt_pk_bf16(h[6], h[7]);
                *(u32x4*)(O + (size_t)(row0 + ai * HALF + m * 16) * ldc + col0) = w; }
    }
};
template <class Epi, class Sched, bool ALIGN_EPI = false, bool SP2 = false>
__device__ __forceinline__ void gemm_phase(PG8_LAS unsigned char* lds, const Gemm g, const Sched& S, const Epi& E, const int tid) {
    const int wid = __builtin_amdgcn_readfirstlane(tid >> 6), lane = tid & 63, wr = wid >> 2, wc = wid & 3, fr = lane & 15, fq = lane >> 4;
    const int K = g.K, nt = K / BK;
    unsigned voffA[2], voffB[2];
#pragma unroll
    for (int i = 0; i < 2; ++i) { int R, C; stage_rc(tid * 16 + i * 8192, R, C); const int Rb = Epi::PERM ? ((R & ~31) + perm32(R & 31)) : R;
        voffA[i] = (unsigned)(R * K + C) * 2u; voffB[i] = (unsigned)(Rb * K + C) * 2u; }
    const size_t kstep = (size_t)(BK * 2);
    const size_t hstep = (size_t)HALF * K * 2;
    const size_t tstep = 2 * hstep;
    const unsigned ldsw = (unsigned)wid * 1024u;
    const int aoff = lds_byte(wr * 64 + fr, fq * 8), boff = lds_byte(wc * 32 + fr, fq * 8);
#define PG8_SA(b, h) (((b) * 2 + (h)) * HTB)
#define PG8_SB(b, h) ((4 + (b) * 2 + (h)) * HTB)
#define PG8_STAGE(bufoff, gbase, voff) do { _Pragma("unroll") for (int _i = 0; _i < 2; ++_i) \
        __builtin_amdgcn_global_load_lds((const unsigned*)((const char*)(gbase) + (voff)[_i]), (PG8_LAS unsigned*)(lds + (bufoff) + ldsw + _i * 8192), 16, 0, 0); } while (0)
#define PG8_LDA(dst, b, h) do { _Pragma("unroll") for (int m = 0; m < 4; ++m) _Pragma("unroll") for (int k = 0; k < 2; ++k) dst[m][k] = *(const PG8_LAS bf16x8*)(lds + PG8_SA(b, h) + aoff + m * 2048 + k * 1024); } while (0)
#define PG8_LDB(dst, b, h) do { _Pragma("unroll") for (int n = 0; n < 2; ++n) _Pragma("unroll") for (int k = 0; k < 2; ++k) dst[n][k] = *(const PG8_LAS bf16x8*)(lds + PG8_SB(b, h) + boff + n * 2048 + k * 1024); } while (0)
#define PG8_MMA(ai, bj, At, Bt) do { __builtin_amdgcn_s_setprio(1); _Pragma("unroll") for (int m = 0; m < 4; ++m) _Pragma("unroll") for (int n = 0; n < 2; ++n) _Pragma("unroll") for (int k = 0; k < 2; ++k) \
        acc[ai][bj][m][n] = __builtin_amdgcn_mfma_f32_16x16x32_bf16(Bt[n][k], At[m][k], acc[ai][bj][m][n], 0, 0, 0); __builtin_amdgcn_s_setprio(0); } while (0)
#define PG8_WAIT_V(n) asm volatile("s_waitcnt vmcnt(" #n ")" ::: "memory")
#define PG8_WAIT_L(n) asm volatile("s_waitcnt lgkmcnt(" #n ")" ::: "memory")
#define PG8_BAR __builtin_amdgcn_s_barrier()
#define PG8_SCHED __builtin_amdgcn_sched_barrier(0)
    Unit cur, nxt; int ui = 0;
    if (!S.next(0, cur)) return;
    f32x4 acc[2][2][4][2];
#pragma unroll
    for (int a = 0; a < 2; ++a)
#pragma unroll
        for (int b = 0; b < 2; ++b)
#pragma unroll
            for (int m = 0; m < 4; ++m)
#pragma unroll
                for (int n = 0; n < 2; ++n) acc[a][b][m][n] = (f32x4){0.f, 0.f, 0.f, 0.f};
    bf16x8 At[4][2], B0[2][2], B1[2][2];
    const char* cA = (const char*)g.A + (size_t)cur.pm * tstep; const char* cB = (const char*)g.Bt + (size_t)cur.pn * tstep;
    S.a_ready(cur);
    if constexpr (SP2) {
        PG8_STAGE(PG8_SB(0, 0), cB, voffB); PG8_STAGE(PG8_SB(0, 1), cB + hstep, voffB); PG8_STAGE(PG8_SA(0, 0), cA, voffA); PG8_STAGE(PG8_SA(0, 1), cA + hstep, voffA);
        if (wr == 1) PG8_BAR;
        PG8_WAIT_V(2); PG8_BAR;
        PG8_STAGE(PG8_SB(1, 0), cB + kstep, voffB); PG8_STAGE(PG8_SA(1, 0), cA + kstep, voffA); PG8_STAGE(PG8_SB(1, 1), cB + hstep + kstep, voffB);
        PG8_WAIT_V(6); PG8_BAR;
    } else {
        PG8_STAGE(PG8_SB(0, 0), cB, voffB); PG8_STAGE(PG8_SA(0, 0), cA, voffA); PG8_STAGE(PG8_SB(0, 1), cB + hstep, voffB); PG8_STAGE(PG8_SA(0, 1), cA + hstep, voffA);
        if (wr == 1) PG8_BAR;
        PG8_WAIT_V(4); PG8_BAR;
        PG8_STAGE(PG8_SB(1, 0), cB + kstep, voffB); PG8_STAGE(PG8_SA(1, 0), cA + kstep, voffA); PG8_STAGE(PG8_SB(1, 1), cB + hstep + kstep, voffB);
        PG8_WAIT_V(6); PG8_BAR;
    }
    for (;;) {
        const bool has_next = S.next(ui + 1, nxt);
        const char* nA = has_next ? (const char*)g.A + (size_t)nxt.pm * tstep : cA; const char* nB = has_next ? (const char*)g.Bt + (size_t)nxt.pn * tstep : cB;
        for (int t = 0; t < nt; t += 2) {
            const bool last = (t == nt - 2);
            const char* a1 = cA + (size_t)(t + 1) * kstep;
            const char* a2 = last ? nA : cA + (size_t)(t + 2) * kstep; const char* b2 = last ? nB : cB + (size_t)(t + 2) * kstep;
            const char* a3 = a2 + kstep; const char* b3 = b2 + kstep;
            if (last && has_next) S.a_ready(nxt);
            if constexpr (SP2) {
            PG8_LDB(B0, 0, 0); PG8_LDB(B1, 0, 1); PG8_SCHED; PG8_LDA(At, 0, 0); PG8_STAGE(PG8_SA(1, 1), a1 + hstep, voffA);
            PG8_WAIT_V(8); PG8_WAIT_L(0); PG8_BAR; PG8_MMA(0, 0, At, B0); PG8_MMA(0, 1, At, B1); PG8_BAR; PG8_SCHED;
            PG8_LDA(At, 0, 1); PG8_STAGE(PG8_SB(0, 0), b2, voffB); PG8_STAGE(PG8_SB(0, 1), b2 + hstep, voffB); PG8_STAGE(PG8_SA(0, 0), a2, voffA);
            PG8_WAIT_V(8); PG8_WAIT_L(0); PG8_BAR; PG8_MMA(1, 0, At, B0); PG8_MMA(1, 1, At, B1); PG8_BAR; PG8_SCHED;
            PG8_LDB(B0, 1, 0); PG8_LDB(B1, 1, 1); PG8_SCHED; PG8_LDA(At, 1, 0); PG8_STAGE(PG8_SA(0, 1), a2 + hstep, voffA);
            PG8_WAIT_V(8); PG8_WAIT_L(0); PG8_BAR; PG8_MMA(0, 0, At, B0); PG8_MMA(0, 1, At, B1); PG8_BAR; PG8_SCHED;
            PG8_LDA(At, 1, 1); PG8_STAGE(PG8_SB(1, 0), b3, voffB); PG8_STAGE(PG8_SB(1, 1), b3 + hstep, voffB); PG8_STAGE(PG8_SA(1, 0), a3, voffA);
            PG8_WAIT_V(8); PG8_WAIT_L(0); PG8_BAR; PG8_MMA(1, 0, At, B0); PG8_MMA(1, 1, At, B1); PG8_BAR; PG8_SCHED;
            } else {
            PG8_LDB(B0, 0, 0); PG8_SCHED; PG8_LDA(At, 0, 0); PG8_STAGE(PG8_SA(1, 1), a1 + hstep, voffA);
            PG8_WAIT_L(8); PG8_BAR; PG8_WAIT_L(0); PG8_MMA(0, 0, At, B0); PG8_BAR; PG8_SCHED;
            PG8_LDB(B1, 0, 1); PG8_STAGE(PG8_SB(0, 0), b2, voffB);
            PG8_BAR; PG8_WAIT_L(0); PG8_MMA(0, 1, At, B1); PG8_BAR;
            PG8_LDA(At, 0, 1); PG8_STAGE(PG8_SA(0, 0), a2, voffA);
            PG8_BAR; PG8_WAIT_L(0); PG8_MMA(1, 0, At, B0); PG8_BAR; PG8_SCHED;
            PG8_STAGE(PG8_SB(0, 1), b2 + hstep, voffB);
            PG8_WAIT_V(6); PG8_BAR; PG8_MMA(1, 1, At, B1); PG8_BAR;
            PG8_LDB(B0, 1, 0); PG8_SCHED; PG8_LDA(At, 1, 0); PG8_STAGE(PG8_SA(0, 1), a2 + hstep, voffA);
            PG8_WAIT_L(8); PG8_BAR; PG8_WAIT_L(0); PG8_MMA(0, 0, At, B0); PG8_BAR; PG8_SCHED;
            PG8_LDB(B1, 1, 1); PG8_STAGE(PG8_SB(1, 0), b3, voffB);
            PG8_BAR; PG8_WAIT_L(0); PG8_MMA(0, 1, At, B1); PG8_BAR;
            PG8_LDA(At, 1, 1); PG8_STAGE(PG8_SA(1, 0), a3, voffA);
            PG8_BAR; PG8_WAIT_L(0); PG8_MMA(1, 0, At, B0); PG8_BAR; PG8_SCHED;
            PG8_STAGE(PG8_SB(1, 1), b3 + hstep, voffB);
            PG8_WAIT_V(6); PG8_BAR; PG8_MMA(1, 1, At, B1); PG8_BAR;
            }
        }
        if constexpr (ALIGN_EPI) { if (wr == 0) PG8_BAR; }
        if constexpr (!Epi::AFTER_DRAIN) { E(acc, cur, wr, wc, fr, fq); S.done(cur); }
        if (!has_next) break;
#pragma unroll
        for (int a = 0; a < 2; ++a)
#pragma unroll
            for (int b = 0; b < 2; ++b)
#pragma unroll
                for (int m = 0; m < 4; ++m)
#pragma unroll
                    for (int n = 0; n < 2; ++n) acc[a][b][m][n] = (f32x4){0.f, 0.f, 0.f, 0.f};
        cur = nxt; cA = nA; cB = nB; ++ui;
        if constexpr (ALIGN_EPI) { if (wr == 1) PG8_BAR; }
    }
    PG8_WAIT_V(0);
    if constexpr (!ALIGN_EPI) { if (wr == 0) PG8_BAR; }
    PG8_BAR;
    if constexpr (Epi::AFTER_DRAIN) { E.fused(acc, cur, wr, wc, fr, fq, lds, wid, lane); S.done(cur); }
#undef PG8_SA
#undef PG8_SB
#undef PG8_STAGE
#undef PG8_LDA
#undef PG8_LDB
#undef PG8_MMA
#undef PG8_WAIT_V
#undef PG8_WAIT_L
#undef PG8_BAR
#undef PG8_SCHED
}
}

#define LAS __attribute__((address_space(3)))
typedef unsigned short bf16_t;
typedef short bf16x8 __attribute__((ext_vector_type(8)));
typedef short s16x4 __attribute__((ext_vector_type(4)));
typedef float f32x4 __attribute__((ext_vector_type(4)));
typedef float f32x2 __attribute__((ext_vector_type(2)));
typedef unsigned u32x4 __attribute__((ext_vector_type(4)));
typedef unsigned u32x2 __attribute__((ext_vector_type(2)));
typedef LAS unsigned char* lds_t;

constexpr int NT = 8192, DM = 2048, SEQ = 2048, NB = 4, DEPTH = 4;
constexpr int INW = 5144, NPROJ = 5376, FFH = 5632;
constexpr int PC_FQ = 0, PC_FK = 512, PC_FV = 1024, PC_GQ = 1536, PC_GK = 1792, PC_GV = 2048, PC_GG = 2560, PC_LG = 3072, PC_LX = 4096, PC_FF = 5120, PC_GR = 5128;
constexpr float EPS = 1e-6f;
constexpr float LOG2E = 1.4426950408889634f;
constexpr int LDS_BYTES = 147456;

constexpr size_t MiB = 1u << 20;
constexpr size_t WS_WIN = 0, WS_WOUT = 21 * MiB, WS_WGU = 29 * MiB, WS_WDN = 73 * MiB;
constexpr size_t WS_XW = 96 * MiB;
constexpr size_t WS_HB = 160 * MiB;
constexpr size_t WS_PROJ = 192 * MiB;
constexpr size_t WS_MIX = 360 * MiB;
constexpr size_t WS_FOXO = 392 * MiB;
constexpr size_t WS_CBUF = 400 * MiB;
constexpr size_t WS_GQT = 401 * MiB;
constexpr size_t WS_GA = 405 * MiB;
constexpr size_t WS_GVT = 407 * MiB;
constexpr size_t WS_GU = 415 * MiB;
constexpr size_t WS_GS = 447 * MiB;
constexpr size_t WS_GDEC = 463 * MiB;
constexpr size_t WS_LA = 464 * MiB;
constexpr size_t WS_LU = 496 * MiB;
constexpr size_t WS_AGP = 528 * MiB, WS_AGH = 529 * MiB, WS_HIN = 530 * MiB;
constexpr size_t WS_SS1 = 532 * MiB, WS_SS2 = 537 * MiB;
constexpr size_t WS_CTL = 531 * MiB, CTL_BYTES = 16384;
constexpr size_t WS_GWT = 541 * MiB;
constexpr size_t WS_SMALL = 542 * MiB, SMALL_BYTES = 10 * MiB;
constexpr size_t SL_CBUF = 0, SL_GDEC = 256 * 1024, SL_GWT = 512 * 1024, SL_AGP = 1 * MiB, SL_AGH = 2 * MiB, SL_HIN = 3 * MiB, SL_GQT = 4 * MiB, SL_GA = 8 * MiB;
constexpr size_t WS_QKV = 582 * MiB;
constexpr size_t WS_END = 614 * MiB;

#define GAS __attribute__((address_space(1)))
struct Params { const float* in[22]; float* out; GAS unsigned char* ws; GAS unsigned char* wsl; };

__device__ __forceinline__ unsigned pk2(float lo, float hi) { unsigned r; asm("v_cvt_pk_bf16_f32 %0, %1, %2" : "=v"(r) : "v"(lo), "v"(hi)); return r; }
__device__ __forceinline__ bf16_t f2bf(float f) { return (bf16_t)(pk2(f, 0.f) & 0xffffu); }
__device__ __forceinline__ float bf2f(unsigned b) { return __uint_as_float(b << 16); }
__device__ __forceinline__ float logsig(float x) { return fminf(x, 0.f) - __logf(1.0f + __expf(-fabsf(x))); }
__device__ __forceinline__ float sigmoidf(float x) { return __builtin_amdgcn_rcpf(1.0f + __expf(-x)); }
__device__ __forceinline__ float neg_expm1_small(float y) {
    const float pl = y * (1.0f + y * (0.5f + y * (0.16666667f + y * (0.041666668f + y * (0.0083333338f + y * (0.0013888889f + y * 0.00019841270f))))));
    return (y > -0.25f) ? -pl : (1.0f - __expf(y));
}
__device__ __forceinline__ f32x4 mfma16(bf16x8 a, bf16x8 b, f32x4 c) { return __builtin_amdgcn_mfma_f32_16x16x32_bf16(a, b, c, 0, 0, 0); }
__device__ __forceinline__ float wave_sum(float v) {
#pragma unroll
    for (int o = 1; o < 64; o <<= 1) v += __shfl_xor(v, o);
    return v;
}
__device__ __forceinline__ bf16x8 pack8(f32x4 a, f32x4 b) {
    u32x4 w; w.x = pk2(a[0], a[1]); w.y = pk2(a[2], a[3]); w.z = pk2(b[0], b[1]); w.w = pk2(b[2], b[3]);
    return __builtin_bit_cast(bf16x8, w);
}

template <int MODE>
__device__ __forceinline__ void wconv_item(const float* W0, const float* W1, int Nsrc, int K, bf16_t* Bt, int NG, int item, int lane, const float* gain) {
    const int kb = item / NG, nb = item - kb * NG;
    const int kg = lane >> 4, ng = lane & 15;
    const int np = nb * 64 + ng * 4, k = kb * 32 + kg * 8;
    const float* src = W0; int c = np;
    if (MODE == 0) { c = np < 1536 ? np : np < 3072 ? np + 8 : np < 5120 ? np + 24 : np < 5128 ? np - 5120 + 1536 : np < 5144 ? np - 5128 + 3080 : -1; }
    if (MODE == 2) { const int pn = np >> 8, j = np & 255; src = j < 128 ? W0 : W1; c = pn * 128 + (j & 127); }
    f32x4 v[8];
#pragma unroll
    for (int i = 0; i < 8; ++i) v[i] = (c >= 0) ? *(const f32x4*)(src + (size_t)(k + i) * Nsrc + c) : (f32x4){0.f, 0.f, 0.f, 0.f};
    if (gain) { const f32x4 g0 = *(const f32x4*)(gain + k), g1 = *(const f32x4*)(gain + k + 4);
#pragma unroll
        for (int i = 0; i < 4; ++i) { v[i] = v[i] * g0[i]; v[4 + i] = v[4 + i] * g1[i]; } }
#pragma unroll
    for (int j = 0; j < 4; ++j) {
        u32x4 o; o.x = pk2(v[0][j], v[1][j]); o.y = pk2(v[2][j], v[3][j]); o.z = pk2(v[4][j], v[5][j]); o.w = pk2(v[6][j], v[7][j]);
        *(u32x4*)(Bt + (size_t)(np + j) * K + k) = o;
    }
}

__device__ __forceinline__ void prep_row(const float* xrow, bf16_t* orow, float* ss, int row, int lane, const float* g) {
    const f32x4* xr = (const f32x4*)xrow + lane; const f32x4* gr = (const f32x4*)g + lane;
    f32x4 v[8]; float s = 0.f;
#pragma unroll
    for (int j = 0; j < 8; ++j) { v[j] = xr[64 * j]; s += (v[j][0] * v[j][0] + v[j][1] * v[j][1]) + (v[j][2] * v[j][2] + v[j][3] * v[j][3]); }
    s = wave_sum(s);
    if (lane < 32) ss[((size_t)(lane >> 2) * 8192 + row) * 4 + (lane & 3)] = (lane == 0) ? s : 0.f;
#pragma unroll
    for (int j = 0; j < 8; ++j) { const f32x4 y = v[j] * gr[64 * j]; u32x2 w; w.x = pk2(y[0], y[1]); w.y = pk2(y[2], y[3]); ((u32x2*)orow)[lane + 64 * j] = w; }
}
__device__ __forceinline__ void final_row(const float* xrow, const float* g, float* orow, float ss, int lane) {
    const f32x4* xr = (const f32x4*)xrow + lane; const f32x4* gr = (const f32x4*)g + lane;
    const float rstd = rsqrtf(ss * (1.0f / 2048.0f) + EPS);
#pragma unroll
    for (int j = 0; j < 8; ++j) ((f32x4*)orow)[lane + 64 * j] = xr[64 * j] * rstd * gr[64 * j];
}

__device__ __forceinline__ void phase_wconv(const Params& p, int l, int mask, int w, int nw, int lane) {
    GAS unsigned char* ws = p.ws;
    constexpr int I_IN = 64 * 84, I_OUT = 64 * 32, I_GU = 64 * 176, I_DN = 176 * 32;
    const float* w_in = p.in[2] + (size_t)l * DM * INW;
    const float* w_out = p.in[16] + (size_t)l * DM * DM;
    const float* w_gate = p.in[18] + (size_t)l * DM * FFH;
    const float* w_up = p.in[19] + (size_t)l * DM * FFH;
    const float* w_down = p.in[20] + (size_t)l * FFH * DM;
    if (mask & 1) for (int it = w; it < I_IN; it += nw) wconv_item<0>(w_in, w_in, INW, DM, (bf16_t*)(ws + WS_WIN), 84, it, lane, nullptr);
    if (mask & 2) for (int it = w; it < I_OUT; it += nw) wconv_item<1>(w_out, w_out, DM, DM, (bf16_t*)(ws + WS_WOUT), 32, it, lane, nullptr);
    if (mask & 4) for (int it = w; it < I_GU; it += nw) wconv_item<2>(w_gate, w_up, FFH, DM, (bf16_t*)(ws + WS_WGU), 176, it, lane, nullptr);
    if (mask & 8) for (int it = w; it < I_DN; it += nw) wconv_item<1>(w_down, w_down, DM, FFH, (bf16_t*)(ws + WS_WDN), 32, it, lane, nullptr);
}

__device__ __forceinline__ void fox_cumsum(const Params& p, int l, int seq, int lane) {
    const float* proj = (const float*)(p.ws + WS_PROJ);
    float* cbuf = (float*)(p.wsl + SL_CBUF);
    const int b = seq >> 3, h = seq & 7;
    const float bias = p.in[3][l * 8 + h];
    const float* src = proj + (size_t)(b * SEQ + lane * 32) * NPROJ + PC_FF + h;
    float ls[32];
#pragma unroll
    for (int i = 0; i < 32; ++i) ls[i] = src[(size_t)i * NPROJ];
    float s = 0.f;
#pragma unroll
    for (int i = 0; i < 32; ++i) { ls[i] = logsig(ls[i] + bias); s += ls[i]; }
    float incl = s;
#pragma unroll
    for (int o = 1; o < 64; o <<= 1) { const float t = __shfl_up(incl, o); if (lane >= o) incl += t; }
    float run = incl - s;
    float* dst = cbuf + seq * SEQ + lane * 32;
#pragma unroll
    for (int i = 0; i < 32; ++i) { run += ls[i]; dst[i] = run * LOG2E; }
}

__device__ __forceinline__ void gate_wt_prep(const Params& p, int l, int gid) {
    if (gid < 2 * 16 * 64 * 64) {
        const int d = gid & 63, e = (gid >> 6) & 63, n = (gid >> 12) & 15, g = gid >> 16;
        const float* w = (g == 0 ? p.in[10] : p.in[12]) + ((size_t)(l * 16 + n) * 64 + d) * 64 + e;
        ((bf16_t*)(p.wsl + SL_GWT))[gid] = f2bf(*w);
    }
}

__device__ __forceinline__ void gla_prep_witem(const Params& p, int l, int ch, lds_t wl_in, int lane_in) {
    int lane = lane_in; asm volatile("" : "+v"(lane));
    unsigned wlo_ = 0; asm volatile("" : "+s"(wlo_)); lds_t wl = wl_in + wlo_;
    const float* proj = (const float*)(p.ws + WS_PROJ);
    const int bh = ch >> 6, n = ch & 63, b = bh >> 2, h = bh & 3;
    const int t0 = b * SEQ + n * 32;
    LAS bf16_t* Qs = (LAS bf16_t*)(wl);
    LAS bf16_t* Ks = (LAS bf16_t*)(wl + 4608);
    LAS bf16_t* KstT = (LAS bf16_t*)(wl);
    LAS bf16_t* VT = (LAS bf16_t*)(wl + 5120);
    const int r = lane & 15, q = lane >> 4;
    float gqv[32], gkv[32];
#pragma unroll
    for (int t = 0; t < 32; ++t) { const float* prow = proj + (size_t)(t0 + t) * NPROJ; gqv[t] = prow[PC_GQ + h * 64 + lane]; gkv[t] = prow[PC_GK + h * 64 + lane]; }
    unsigned vw[2][16];
#pragma unroll
    for (int vv = 0; vv < 2; ++vv) {
        const bf16_t* vp = (const bf16_t*)(p.ws + WS_QKV) + ((size_t)3 * NT + t0) * 512 + h * 128 + lane + 64 * vv;
#pragma unroll
        for (int t = 0; t < 32; t += 2) vw[vv][t >> 1] = (unsigned)vp[(size_t)t * 512] | ((unsigned)vp[(size_t)(t + 1) * 512] << 16);
    }
    float bcum[32];
    {
        const float* w2 = p.in[5] + (size_t)l * 16 * 256 + h * 64 + lane;
        const float gb = p.in[6][l * 256 + h * 64 + lane];
        float w2r[16];
#pragma unroll
        for (int i = 0; i < 16; ++i) w2r[i] = w2[i * 256];
        LAS float* grs = (LAS float*)(wl);
        { const float* gsrc = proj + (size_t)(t0 + (lane >> 1)) * NPROJ + PC_GR + (lane & 1) * 8;
          const f32x4 g0 = *(const f32x4*)gsrc, g1 = *(const f32x4*)(gsrc + 4);
          *(LAS f32x4*)(grs + lane * 8) = g0; *(LAS f32x4*)(grs + lane * 8 + 4) = g1; }
        float run = 0.f;
#pragma unroll
        for (int t = 0; t < 32; ++t) {
            f32x4 gr4[4];
#pragma unroll
            for (int i = 0; i < 4; ++i) gr4[i] = *(LAS f32x4*)(grs + t * 16 + 4 * i);
            float z = gb;
#pragma unroll
            for (int i = 0; i < 16; ++i) z += gr4[i >> 2][i & 3] * w2r[i];
            run += logsig(z) * (1.0f / 16.0f);
            bcum[t] = run;
        }
        asm volatile("" ::: "memory");
    }
    const float bl = bcum[31];
    unsigned kstp[16];
    {
        bf16_t* qtg = (bf16_t*)(p.wsl + SL_GQT) + (size_t)t0 * 256 + h * 64 + lane;
        float ksprev = 0.f;
#pragma unroll
        for (int t = 0; t < 32; ++t) {
            const float gq = gqv[t], gk = gkv[t];
            const float bv = bcum[t];
            const float qt = gq * 0.125f * __expf(bv), kt = gk * __expf(-bv), ks = gk * __expf(bl - bv);
            const bf16_t qb16 = f2bf(qt);
            Qs[t * 72 + lane] = qb16; Ks[t * 72 + lane] = f2bf(kt);
            qtg[(size_t)t * 256] = qb16;
            if (t & 1) kstp[t >> 1] = pk2(ksprev, ks); else ksprev = ks;
        }
        ((float*)(p.wsl + SL_GDEC))[ch * 64 + lane] = __expf(bl);
    }
    {
        bf16_t* ab = (bf16_t*)(p.wsl + SL_GA) + (size_t)ch * 1024;
#pragma unroll
        for (int tt = 0; tt < 2; ++tt)
#pragma unroll
            for (int st = 0; st < 2; ++st) {
                f32x4 acc = {0.f, 0.f, 0.f, 0.f};
#pragma unroll
                for (int ks = 0; ks < 2; ++ks) {
                    const bf16x8 a = *(LAS bf16x8*)(Qs + (16 * tt + r) * 72 + 32 * ks + 8 * q);
                    const bf16x8 bb = *(LAS bf16x8*)(Ks + (16 * st + r) * 72 + 32 * ks + 8 * q);
                    acc = mfma16(a, bb, acc);
                }
#pragma unroll
                for (int j = 0; j < 4; ++j) { const int t = 16 * tt + 4 * q + j, s = 16 * st + r; ab[t * 32 + s] = f2bf(s <= t ? acc[j] : 0.f); }
            }
    }
#pragma unroll
    for (int i = 0; i < 4; ++i) { u32x4 w; w.x = kstp[4 * i]; w.y = kstp[4 * i + 1]; w.z = kstp[4 * i + 2]; w.w = kstp[4 * i + 3]; *(LAS u32x4*)(KstT + lane * 40 + 8 * i) = w; }
#pragma unroll
    for (int vv = 0; vv < 2; ++vv) {
        const int v = lane + 64 * vv;
        bf16_t* vg = (bf16_t*)(p.ws + WS_GVT) + (size_t)ch * 4096 + v * 32;
#pragma unroll
        for (int i = 0; i < 4; ++i) { u32x4 w; w.x = vw[vv][4 * i]; w.y = vw[vv][4 * i + 1]; w.z = vw[vv][4 * i + 2]; w.w = vw[vv][4 * i + 3]; *(LAS u32x4*)(VT + v * 40 + 8 * i) = w; *(u32x4*)(vg + 8 * i) = w; }
    }
    {
        float* ub = (float*)(p.ws + WS_GU) + (size_t)ch * 8192;
        bf16x8 kb[4];
#pragma unroll
        for (int dt = 0; dt < 4; ++dt) kb[dt] = *(LAS bf16x8*)(KstT + (16 * dt + r) * 40 + 8 * q);
#pragma unroll
        for (int w = 0; w < 8; ++w) {
            const bf16x8 a = *(LAS bf16x8*)(VT + (16 * w + r) * 40 + 8 * q);
#pragma unroll
            for (int dt = 0; dt < 4; ++dt) {
                const f32x4 acc = mfma16(a, kb[dt], (f32x4){0.f, 0.f, 0.f, 0.f});
#pragma unroll
                for (int j = 0; j < 4; ++j) ub[(16 * w + 4 * q + j) * 64 + 16 * dt + r] = acc[j];
            }
        }
    }
}

__device__ __forceinline__ void lru_prep_witem(const Params& p, int l, int item, lds_t wl_in, int lane_in) {
    int lane = lane_in; asm volatile("" : "+v"(lane));
    unsigned wlo_ = 0; asm volatile("" : "+s"(wlo_)); lds_t wl = wl_in + wlo_;
    const float* proj = (const float*)(p.ws + WS_PROJ);
    const int gt = item >> 4, n = item & 15, tok0 = gt * 32, b = tok0 >> 11, p0 = tok0 & 2047, c0 = n * 64;
    LAS bf16_t* Xs = (LAS bf16_t*)(wl);
    LAS float* Xf = (LAS float*)(wl + 4608);
    const int r = lane & 15, q = lane >> 4;
    {
        const int c = c0 + lane;
        const float* cw = p.in[8] + (size_t)l * 4 * 1024 + c;
        const float w0 = cw[0], w1 = cw[1024], w2 = cw[2048], w3 = cw[3072], cb = p.in[9][l * 1024 + c];
        const float* lxp = proj + (size_t)(b * SEQ) * NPROJ + PC_LX + c;
        float x0 = p0 >= 3 ? lxp[(size_t)(p0 - 3) * NPROJ] : 0.f, x1 = p0 >= 2 ? lxp[(size_t)(p0 - 2) * NPROJ] : 0.f, x2 = p0 >= 1 ? lxp[(size_t)(p0 - 1) * NPROJ] : 0.f;
        float xv[32];
#pragma unroll
        for (int i = 0; i < 32; ++i) xv[i] = lxp[(size_t)(p0 + i) * NPROJ];
#pragma unroll
        for (int i = 0; i < 32; ++i) {
            const float x3 = xv[i];
            const float y = cb + w0 * x0 + w1 * x1 + w2 * x2 + w3 * x3;
            Xf[i * 68 + lane] = y; Xs[i * 72 + lane] = f2bf(y);
            x0 = x1; x1 = x2; x2 = x3;
        }
    }
    const bf16_t* gwt = (const bf16_t*)(p.wsl + SL_GWT);
    bf16x8 af[2][2];
#pragma unroll
    for (int tt = 0; tt < 2; ++tt)
#pragma unroll
        for (int ks = 0; ks < 2; ++ks) af[tt][ks] = *(LAS bf16x8*)(Xs + (16 * tt + r) * 72 + 32 * ks + 8 * q);
    float* la = (float*)(p.ws + WS_LA); float* lu = (float*)(p.ws + WS_LU);
    bf16x8 bav[4][2], biv[4][2]; float bbav[4], bbiv[4], lamv[4];
#pragma unroll
    for (int et = 0; et < 4; ++et) {
#pragma unroll
        for (int ks = 0; ks < 2; ++ks) { bav[et][ks] = *(const bf16x8*)(gwt + ((size_t)(0 * 16 + n) * 64 + 16 * et + r) * 64 + 32 * ks + 8 * q); biv[et][ks] = *(const bf16x8*)(gwt + ((size_t)(1 * 16 + n) * 64 + 16 * et + r) * 64 + 32 * ks + 8 * q); }
        const int c = c0 + 16 * et + r;
        bbav[et] = p.in[11][l * 1024 + c]; bbiv[et] = p.in[13][l * 1024 + c]; lamv[et] = p.in[14][l * 1024 + c];
    }
#pragma unroll
    for (int et = 0; et < 4; ++et) {
        bf16x8 ba[2], bi[2];
#pragma unroll
        for (int ks = 0; ks < 2; ++ks) { ba[ks] = bav[et][ks]; bi[ks] = biv[et][ks]; }
        const int e = 16 * et + r, c = c0 + e;
        const float bba = bbav[et], bbi = bbiv[et], lls = logsig(lamv[et]);
        float av[2][4], uv[2][4];
#pragma unroll
        for (int tt = 0; tt < 2; ++tt) {
            f32x4 pa = {0.f, 0.f, 0.f, 0.f}, pi = {0.f, 0.f, 0.f, 0.f};
#pragma unroll
            for (int ks = 0; ks < 2; ++ks) { pa = mfma16(af[tt][ks], ba[ks], pa); pi = mfma16(af[tt][ks], bi[ks], pi); }
#pragma unroll
            for (int j = 0; j < 4; ++j) {
                const int t = 16 * tt + 4 * q + j;
                const float rg = sigmoidf(pa[j] + bba), ig = sigmoidf(pi[j] + bbi);
                const float loga = 8.0f * rg * lls;
                const float a = __expf(loga);
                const float u = __builtin_amdgcn_sqrtf(fmaxf(neg_expm1_small(2.0f * loga), 0.f)) * (ig * Xf[t * 68 + e]);
                la[(size_t)(tok0 + t) * 1024 + c] = a; lu[(size_t)(tok0 + t) * 1024 + c] = u;
                av[tt][j] = a; uv[tt][j] = u;
            }
            asm volatile("" ::: "memory");
        }
        float P = 1.f, H = 0.f;
#pragma unroll
        for (int tt = 0; tt < 2; ++tt)
#pragma unroll
            for (int qq = 0; qq < 4; ++qq) {
                if (q == qq) {
#pragma unroll
                    for (int j = 0; j < 4; ++j) { H = av[tt][j] * H + uv[tt][j]; P *= av[tt][j]; }
                }
                P = __shfl(P, r + 16 * qq); H = __shfl(H, r + 16 * qq);
            }
        if (q == 0) { ((float*)(p.wsl + SL_AGP))[gt * 1024 + c] = P; ((float*)(p.wsl + SL_AGH))[gt * 1024 + c] = H; }
    }
}

__device__ __forceinline__ void fox_attn_unit(const Params& p, int bh, int qb, lds_t lds, int tid, int wave, int lane) {
    const float* proj = (const float*)(p.ws + WS_PROJ);
    const float* cb = (const float*)(p.wsl + SL_CBUF) + bh * SEQ;
    const int b = bh >> 3, h = bh & 7;
    LAS bf16_t* Ks = (LAS bf16_t*)(lds);
    LAS bf16_t* Vt = (LAS bf16_t*)(lds + 9216);
    LAS float* cks = (LAS float*)(lds + 18432);
    const int r = lane & 15, q = lane >> 4;
    const int q0 = qb * 128, qw0 = q0 + 16 * wave, nkv = 2 * (qb + 1);
    const float C2 = 0.125f * LOG2E;
    bf16x8 qf[2];
    {
        const bf16_t* qp = (const bf16_t*)(p.ws + WS_QKV) + (size_t)(b * SEQ + qw0 + r) * 512 + h * 64 + 8 * q;
#pragma unroll
        for (int ks = 0; ks < 2; ++ks) qf[ks] = *(const bf16x8*)(qp + 32 * ks);
    }
    const float cq = cb[qw0 + r];
    float m = -1e30f, lsum = 0.f;
    f32x4 o[4];
#pragma unroll
    for (int i = 0; i < 4; ++i) o[i] = (f32x4){0.f, 0.f, 0.f, 0.f};
    const int lrow = tid >> 3, lch = (tid & 7) * 8;
    const bf16_t* kbase = (const bf16_t*)(p.ws + WS_QKV) + ((size_t)NT + b * SEQ + lrow) * 512 + h * 64 + lch;
    const int vrow = tid & 63, vch = (tid >> 6) * 8;
    const bf16_t* vbase = (const bf16_t*)(p.ws + WS_QKV) + ((size_t)2 * NT + b * SEQ + vrow) * 512 + h * 64 + vch;
    bf16x8 kA = *(const bf16x8*)kbase, vA = *(const bf16x8*)vbase;
    float ckA = tid < 64 ? cb[tid] : 0.f;
    bf16x8 kB = *(const bf16x8*)(kbase + (size_t)64 * 512), vB = *(const bf16x8*)(vbase + (size_t)64 * 512);
    float ckB = tid < 64 ? cb[64 + tid] : 0.f;
    constexpr int FOXBUF = 18432 + 256;
#define FOX_WRITE(KK, VV, CK, bufi, jn) { \
        LAS bf16_t* KsW = (LAS bf16_t*)(lds + (bufi) * FOXBUF); LAS bf16_t* VtW = (LAS bf16_t*)(lds + (bufi) * FOXBUF + 9216); LAS float* cksW = (LAS float*)(lds + (bufi) * FOXBUF + 18432); \
        *(LAS bf16x8*)(KsW + lrow * 72 + lch) = KK; \
        _Pragma("unroll") for (int i = 0; i < 8; ++i) VtW[(vch + i) * 72 + vrow] = (bf16_t)VV[i]; \
        if (tid < 64) cksW[tid] = CK; \
        if ((jn) < nkv) { const size_t off = (size_t)(jn) * 64 * 512; \
            KK = *(const bf16x8*)(kbase + off); VV = *(const bf16x8*)(vbase + off); \
            if (tid < 64) CK = cb[(jn) * 64 + tid]; } }
    __syncthreads();
    FOX_WRITE(kA, vA, ckA, 0, 2)
    asm volatile("s_waitcnt lgkmcnt(0)\n\ts_barrier" ::: "memory");
    for (int j0 = 0; j0 < nkv; j0 += 2) {
        { const int j = j0;
          FOX_WRITE(kB, vB, ckB, 1, j + 3)
          LAS bf16_t* KsX = (LAS bf16_t*)(lds); LAS bf16_t* VtX = (LAS bf16_t*)(lds + 9216); LAS float* cksX = (LAS float*)(lds + 18432);
        if (64 * j <= qw0 + 15) {
            f32x4 s[4]; float mx = -INFINITY;
            bf16x8 kfr[4][2]; f32x4 ckr[4]; s16x4 vlo[4][2], vhi[4][2];
#pragma unroll
            for (int st = 0; st < 4; ++st) {
#pragma unroll
                for (int ks = 0; ks < 2; ++ks) kfr[st][ks] = *(LAS bf16x8*)(KsX + (16 * st + r) * 72 + 32 * ks + 8 * q);
                ckr[st] = *(LAS f32x4*)(cksX + 16 * st + 4 * q);
            }
#pragma unroll
            for (int ds = 0; ds < 4; ++ds)
#pragma unroll
                for (int ks = 0; ks < 2; ++ks) { vlo[ds][ks] = *(LAS s16x4*)(VtX + (16 * ds + r) * 72 + 32 * ks + 4 * q); vhi[ds][ks] = *(LAS s16x4*)(VtX + (16 * ds + r) * 72 + 32 * ks + 16 + 4 * q); }
#pragma unroll
            for (int st = 0; st < 4; ++st) {
                f32x4 acc = {0.f, 0.f, 0.f, 0.f};
#pragma unroll
                for (int ks = 0; ks < 2; ++ks) acc = mfma16(kfr[st][ks], qf[ks], acc);
                const f32x4 ck = ckr[st];
#pragma unroll
                for (int jj = 0; jj < 4; ++jj) {
                    const int kv = 64 * j + 16 * st + 4 * q + jj;
                    float sv = acc[jj] + (cq - ck[jj]);
                    if (64 * j + 63 > qw0) sv = (kv <= qw0 + r) ? sv : -INFINITY;
                    s[st][jj] = sv; mx = fmaxf(mx, sv);
                }
            }
            mx = fmaxf(mx, __shfl_xor(mx, 16)); mx = fmaxf(mx, __shfl_xor(mx, 32));
            const float mnew = fmaxf(m, mx);
            const float alpha = __builtin_amdgcn_exp2f(m - mnew);
            m = mnew;
            float ps = 0.f;
#pragma unroll
            for (int st = 0; st < 4; ++st)
#pragma unroll
                for (int jj = 0; jj < 4; ++jj) { const float e = __builtin_amdgcn_exp2f(s[st][jj] - mnew); s[st][jj] = e; ps += e; }
            lsum = lsum * alpha + ps;
#pragma unroll
            for (int i = 0; i < 4; ++i) o[i] = o[i] * alpha;
            bf16x8 pf[2];
            pf[0] = pack8(s[0], s[1]); pf[1] = pack8(s[2], s[3]);
#pragma unroll
            for (int ds = 0; ds < 4; ++ds)
#pragma unroll
                for (int ks = 0; ks < 2; ++ks) {
                    const s16x4 lo = vlo[ds][ks], hi = vhi[ds][ks];
                    const bf16x8 a = {lo[0], lo[1], lo[2], lo[3], hi[0], hi[1], hi[2], hi[3]};
                    o[ds] = mfma16(a, pf[ks], o[ds]);
                }
        }
          asm volatile("s_waitcnt lgkmcnt(0)\n\ts_barrier" ::: "memory");
        }
        { const int j = j0 + 1;
          if (j + 1 < nkv) FOX_WRITE(kA, vA, ckA, 0, j + 3)
          LAS bf16_t* KsX = (LAS bf16_t*)(lds + FOXBUF); LAS bf16_t* VtX = (LAS bf16_t*)(lds + FOXBUF + 9216); LAS float* cksX = (LAS float*)(lds + FOXBUF + 18432);
        if (64 * j <= qw0 + 15) {
            f32x4 s[4]; float mx = -INFINITY;
            bf16x8 kfr[4][2]; f32x4 ckr[4]; s16x4 vlo[4][2], vhi[4][2];
#pragma unroll
            for (int st = 0; st < 4; ++st) {
#pragma unroll
                for (int ks = 0; ks < 2; ++ks) kfr[st][ks] = *(LAS bf16x8*)(KsX + (16 * st + r) * 72 + 32 * ks + 8 * q);
                ckr[st] = *(LAS f32x4*)(cksX + 16 * st + 4 * q);
            }
#pragma unroll
            for (int ds = 0; ds < 4; ++ds)
#pragma unroll
                for (int ks = 0; ks < 2; ++ks) { vlo[ds][ks] = *(LAS s16x4*)(VtX + (16 * ds + r) * 72 + 32 * ks + 4 * q); vhi[ds][ks] = *(LAS s16x4*)(VtX + (16 * ds + r) * 72 + 32 * ks + 16 + 4 * q); }
#pragma unroll
            for (int st = 0; st < 4; ++st) {
                f32x4 acc = {0.f, 0.f, 0.f, 0.f};
#pragma unroll
                for (int ks = 0; ks < 2; ++ks) acc = mfma16(kfr[st][ks], qf[ks], acc);
                const f32x4 ck = ckr[st];
#pragma unroll
                for (int jj = 0; jj < 4; ++jj) {
                    const int kv = 64 * j + 16 * st + 4 * q + jj;
                    float sv = acc[jj] + (cq - ck[jj]);
                    if (64 * j + 63 > qw0) sv = (kv <= qw0 + r) ? sv : -INFINITY;
                    s[st][jj] = sv; mx = fmaxf(mx, sv);
                }
            }
            mx = fmaxf(mx, __shfl_xor(mx, 16)); mx = fmaxf(mx, __shfl_xor(mx, 32));
            const float mnew = fmaxf(m, mx);
            const float alpha = __builtin_amdgcn_exp2f(m - mnew);
            m = mnew;
            float ps = 0.f;
#pragma unroll
            for (int st = 0; st < 4; ++st)
#pragma unroll
                for (int jj = 0; jj < 4; ++jj) { const float e = __builtin_amdgcn_exp2f(s[st][jj] - mnew); s[st][jj] = e; ps += e; }
            lsum = lsum * alpha + ps;
#pragma unroll
            for (int i = 0; i < 4; ++i) o[i] = o[i] * alpha;
            bf16x8 pf[2];
            pf[0] = pack8(s[0], s[1]); pf[1] = pack8(s[2], s[3]);
#pragma unroll
            for (int ds = 0; ds < 4; ++ds)
#pragma unroll
                for (int ks = 0; ks < 2; ++ks) {
                    const s16x4 lo = vlo[ds][ks], hi = vhi[ds][ks];
                    const bf16x8 a = {lo[0], lo[1], lo[2], lo[3], hi[0], hi[1], hi[2], hi[3]};
                    o[ds] = mfma16(a, pf[ks], o[ds]);
                }
        }
          asm volatile("s_waitcnt lgkmcnt(0)\n\ts_barrier" ::: "memory");
        }
    }
#undef FOX_WRITE
    lsum += __shfl_xor(lsum, 16); lsum += __shfl_xor(lsum, 32);
    const float inv = 1.0f / lsum;
    bf16_t* op = (bf16_t*)(p.ws + WS_FOXO) + (size_t)(b * SEQ + qw0 + r) * 512 + h * 64 + 4 * q;
#pragma unroll
    for (int ds = 0; ds < 4; ++ds) { u32x2 w; w.x = pk2(o[ds][0] * inv, o[ds][1] * inv); w.y = pk2(o[ds][2] * inv, o[ds][3] * inv); *(u32x2*)(op + 16 * ds) = w; }
}

__device__ __forceinline__ void gla_scan_item(const Params& p, int item, int tid) {
    const int bh = item >> 4, e = (item & 15) * 512 + tid, d = e & 63;
    const float* ub = (const float*)(p.ws + WS_GU) + (size_t)bh * 64 * 8192 + e;
    const float* dec = (const float*)(p.wsl + SL_GDEC) + (size_t)bh * 64 * 64 + d;
    bf16_t* sp = (bf16_t*)(p.ws + WS_GS) + (size_t)bh * 64 * 8192 + e;
    float st = 0.f;
#pragma unroll
    for (int n0 = 0; n0 < 64; n0 += 64) {
        float u[64], dc[64];
#pragma unroll
        for (int n = 0; n < 64; ++n) { u[n] = ub[(size_t)(n0 + n) * 8192]; dc[n] = dec[(n0 + n) * 64]; }
#pragma unroll
        for (int n = 0; n < 64; ++n) { sp[(size_t)(n0 + n) * 8192] = f2bf(st); st = dc[n] * st + u[n]; }
    }
}

__device__ __forceinline__ void lru_tilescan_item(const Params& p, int item, int tid) {
    const int gid = item * 512 + tid, b = gid >> 10, c = gid & 1023;
    const float* P = (const float*)(p.wsl + SL_AGP) + (size_t)b * 64 * 1024 + c;
    const float* H = (const float*)(p.wsl + SL_AGH) + (size_t)b * 64 * 1024 + c;
    float* hi = (float*)(p.wsl + SL_HIN) + (size_t)b * 64 * 1024 + c;
    float h = 0.f;
#pragma unroll
    for (int t0 = 0; t0 < 64; t0 += 64) {
        float a[64], u[64];
#pragma unroll
        for (int t = 0; t < 64; ++t) { a[t] = P[(t0 + t) * 1024]; u[t] = H[(t0 + t) * 1024]; }
#pragma unroll
        for (int t = 0; t < 64; ++t) { hi[(t0 + t) * 1024] = h; h = a[t] * h + u[t]; }
    }
}

__device__ __forceinline__ void fox_norm_rows4(const Params& p, int l, int tok0, int stride, int lane) {
    u32x4 w[4];
#pragma unroll
    for (int k = 0; k < 4; ++k) w[k] = *(const u32x4*)((const bf16_t*)(p.ws + WS_FOXO) + (size_t)(tok0 + k * stride) * 512 + lane * 8);
    const float* g = p.in[4] + l * 512 + lane * 8;
    const f32x4 g0 = *(const f32x4*)g, g1 = *(const f32x4*)(g + 4);
#pragma unroll
    for (int k = 0; k < 4; ++k) {
        float v[8];
#pragma unroll
        for (int i = 0; i < 4; ++i) { v[2 * i] = bf2f(w[k][i] & 0xffffu); v[2 * i + 1] = bf2f(w[k][i] >> 16); }
        float s = 0.f;
#pragma unroll
        for (int i = 0; i < 8; ++i) s += v[i] * v[i];
        const float rstd = rsqrtf(wave_sum(s) * (1.0f / 512.0f) + EPS);
        u32x4 ow; ow.x = pk2(v[0] * rstd * g0[0], v[1] * rstd * g0[1]); ow.y = pk2(v[2] * rstd * g0[2], v[3] * rstd * g0[3]);
        ow.z = pk2(v[4] * rstd * g1[0], v[5] * rstd * g1[1]); ow.w = pk2(v[6] * rstd * g1[2], v[7] * rstd * g1[3]);
        *(u32x4*)((bf16_t*)(p.ws + WS_MIX) + (size_t)(tok0 + k * stride) * 2048 + lane * 8) = ow;
    }
}

__device__ __forceinline__ void gla_out_witem(const Params& p, int l, int item, int lane) {
    const float* proj = (const float*)(p.ws + WS_PROJ);
    const int ch = item >> 1, tt = item & 1;
    const int bh = ch >> 6, n = ch & 63, b = bh >> 2, h = bh & 3;
    const int t0 = b * SEQ + n * 32;
    const int r = lane & 15, q = lane >> 4;
    const bf16_t* ab = (const bf16_t*)(p.wsl + SL_GA) + (size_t)ch * 1024;
    const bf16_t* vt = (const bf16_t*)(p.ws + WS_GVT) + (size_t)ch * 4096;
    const bf16_t* qt = (const bf16_t*)(p.wsl + SL_GQT) + (size_t)t0 * 256 + h * 64;
    const bf16_t* sp = (const bf16_t*)(p.ws + WS_GS) + (size_t)ch * 8192;
    const bf16x8 aa = *(const bf16x8*)(ab + (16 * tt + r) * 32 + 8 * q);
    const bf16x8 aq0 = *(const bf16x8*)(qt + (size_t)(16 * tt + r) * 256 + 8 * q), aq1 = *(const bf16x8*)(qt + (size_t)(16 * tt + r) * 256 + 32 + 8 * q);
    f32x4 acc[8];
#pragma unroll
    for (int w = 0; w < 8; ++w) {
        const int v = 16 * w + r;
        const bf16x8 bv = *(const bf16x8*)(vt + v * 32 + 8 * q);
        const bf16x8 bs0 = *(const bf16x8*)(sp + v * 64 + 8 * q), bs1 = *(const bf16x8*)(sp + v * 64 + 32 + 8 * q);
        f32x4 c = mfma16(aa, bv, (f32x4){0.f, 0.f, 0.f, 0.f});
        c = mfma16(aq0, bs0, c); c = mfma16(aq1, bs1, c);
        acc[w] = c;
    }
    float tot[4] = {0.f, 0.f, 0.f, 0.f};
#pragma unroll
    for (int w = 0; w < 8; ++w)
#pragma unroll
        for (int j = 0; j < 4; ++j) {
            float s = acc[w][j] * acc[w][j];
            s += __shfl_xor(s, 1); s += __shfl_xor(s, 2); s += __shfl_xor(s, 4); s += __shfl_xor(s, 8);
            tot[j] += s;
        }
#pragma unroll
    for (int j = 0; j < 4; ++j) {
        const int t = 16 * tt + 4 * q + j;
        const float rstd = rsqrtf(tot[j] * (1.0f / 128.0f) + EPS);
        const float* ggp = proj + (size_t)(t0 + t) * NPROJ + PC_GG + h * 128 + r;
        bf16_t* mp = (bf16_t*)(p.ws + WS_MIX) + (size_t)(t0 + t) * 2048 + 512 + h * 128 + r;
#pragma unroll
        for (int w = 0; w < 8; ++w) {
            const float gn = p.in[7][l * 128 + 16 * w + r];
            const float gg = ggp[16 * w];
            const float y = acc[w][j] * rstd * gn * (gg * sigmoidf(gg));
            mp[16 * w] = f2bf(y);
        }
    }
}

__device__ __forceinline__ float gelu_tanh(float x) {
    const float u = 0.7978845608028654f * (x + 0.044715f * x * x * x);
    const float t = 1.0f - 2.0f * __builtin_amdgcn_rcpf(1.0f + __expf(2.0f * u));
    return 0.5f * x * (1.0f + t);
}

__device__ __forceinline__ void lru_out_item(const Params& p, int l, int gt, lds_t lds, int tid, int wave, int lane) {
    const float* proj = (const float*)(p.ws + WS_PROJ);
    const int tok0 = gt * 32, c = 2 * tid;
    LAS float* part = (LAS float*)(lds);
    LAS float* rs = (LAS float*)(lds + 65536);
    const f32x2* la = (const f32x2*)((const float*)(p.ws + WS_LA) + (size_t)tok0 * 1024 + c);
    const f32x2* lu = (const f32x2*)((const float*)(p.ws + WS_LU) + (size_t)tok0 * 1024 + c);
    const float* lgp = proj + (size_t)tok0 * NPROJ + PC_LG + c;
    f32x2 h = *(const f32x2*)((const float*)(p.wsl + SL_HIN) + (size_t)gt * 1024 + c);
    f32x2 y[32];
    {
        f32x2 av[32], uv[32];
#pragma unroll
        for (int t = 0; t < 32; ++t) y[t] = *(const f32x2*)(lgp + (size_t)t * NPROJ);
#pragma unroll
        for (int t = 0; t < 32; ++t) { av[t] = la[t * 512]; uv[t] = lu[t * 512]; }
#pragma unroll
        for (int t = 0; t < 32; ++t) { y[t][0] = gelu_tanh(y[t][0]); y[t][1] = gelu_tanh(y[t][1]); }
#pragma unroll
        for (int t = 0; t < 32; ++t) {
            h = av[t] * h + uv[t];
            y[t][0] = h[0] * y[t][0]; y[t][1] = h[1] * y[t][1];
            part[t * 512 + tid] = y[t][0] * y[t][0] + y[t][1] * y[t][1];
        }
    }
    __syncthreads();
    {
        const int t = tid >> 4, k0 = tid & 15;
        float s = 0.f;
#pragma unroll 8
        for (int k = 0; k < 32; ++k) s += part[t * 512 + k0 + 16 * k];
        s += __shfl_xor(s, 1); s += __shfl_xor(s, 2); s += __shfl_xor(s, 4); s += __shfl_xor(s, 8);
        if (k0 == 0) rs[t] = rsqrtf(s * (1.0f / 1024.0f) + EPS);
    }
    __syncthreads();
    const f32x2 g = *(const f32x2*)(p.in[15] + l * 1024 + c);
    bf16_t* mix = (bf16_t*)(p.ws + WS_MIX) + (size_t)tok0 * 2048 + 1024 + c;
#pragma unroll
    for (int t = 0; t < 32; ++t) { const float rr = rs[t]; *(unsigned*)(mix + (size_t)t * 2048) = pk2(y[t][0] * rr * g[0], y[t][1] * rr * g[1]); }
    __syncthreads();
}

#define XB_TMO      128
#define XB_XCNT(j)  (256  + 64 * (j))
#define XB_XSUB(j)  (1280 + 64 * (j))
#define XB_XGEN(j)  (2304 + 64 * (j))
#define XB_TOP      3328
#define XB_TOPGEN   3392
#define XCD_BAR_WORDS 3456
#define XB_SPIN_CAP (1u << 18)

__device__ __forceinline__ unsigned xb_ld(unsigned* p)              { return __hip_atomic_load(p, __ATOMIC_RELAXED, __HIP_MEMORY_SCOPE_AGENT); }
__device__ __forceinline__ unsigned xb_add(unsigned* p, unsigned v) { return __hip_atomic_fetch_add(p, v, __ATOMIC_RELAXED, __HIP_MEMORY_SCOPE_AGENT); }
__device__ __forceinline__ unsigned xb_xcc_id() { return (unsigned)__builtin_amdgcn_s_getreg((3 << 11) | 20) & 0xFu; }
#define XB_SPIN(cond, bar) do { unsigned _sp = 0; while (cond) { __builtin_amdgcn_s_sleep(1); \
    if ((++_sp & 255u) == 0u) { if (xb_ld(&(bar)[XB_TMO])) break; if (_sp > XB_SPIN_CAP) { atomicAdd(&(bar)[XB_TMO], 1u); break; } } } } while (0)

struct XcdBarrier {
    unsigned* bar; unsigned x;
    volatile LAS unsigned* st;
};

__device__ __forceinline__ XcdBarrier xcd_barrier_post(unsigned* bar, volatile LAS unsigned* st) {
    XcdBarrier b; b.bar = bar; b.x = xb_xcc_id(); b.st = st;
    if (threadIdx.x == 0) (void)xb_add(&bar[XB_XCNT(b.x)], 1u);
    return b;
}
__device__ __forceinline__ void xcd_barrier_complete(unsigned* bar, unsigned x, unsigned& nloc, unsigned& nx) {
    const unsigned G = gridDim.x * gridDim.y * gridDim.z;
    unsigned sum, cnt, mine, sp = 0u;
    for (;;) {
        sum = 0u; cnt = 0u; mine = 0u;
#pragma unroll
        for (unsigned j = 0; j < 16; ++j) { const unsigned c = xb_ld(&bar[XB_XCNT(j)]); sum += c; cnt += (c > 0u) ? 1u : 0u; mine = (j == x) ? c : mine; }
        if (sum == G) break;
        __builtin_amdgcn_s_sleep(1);
        if ((++sp & 255u) == 0u) { if (xb_ld(&bar[XB_TMO])) break; if (sp > XB_SPIN_CAP) { atomicAdd(&bar[XB_TMO], 1u); break; } }
    }
    nloc = mine > 0u ? mine : 1u; nx = cnt > 0u ? cnt : 1u;
}

__device__ __forceinline__ void xcd_barrier(const XcdBarrier& b) {
    asm volatile("s_waitcnt vmcnt(0)" ::: "memory");
    __syncthreads();
    if (threadIdx.x == 0) {
        unsigned* bar = b.bar;
        __builtin_amdgcn_s_waitcnt(0);
        unsigned nloc = b.st[0], nx = b.st[1];
        if (nloc == 0u) { xcd_barrier_complete(bar, b.x, nloc, nx); b.st[0] = nloc; b.st[1] = nx; }
        const unsigned old = xb_add(&bar[XB_XSUB(b.x)], 1u);
        const unsigned gen = old / nloc;
        if (old + 1u == (gen + 1u) * nloc) {
            __builtin_amdgcn_fence(__ATOMIC_RELEASE, "agent");
            asm volatile("s_waitcnt vmcnt(0)" ::: "memory");
            const unsigned og = xb_add(&bar[XB_TOP], 1u);
            const unsigned tg = og / nx;
            if (og + 1u == (tg + 1u) * nx) xb_add(&bar[XB_TOPGEN], 1u);
            else XB_SPIN(xb_ld(&bar[XB_TOPGEN]) == tg, bar);
            __builtin_amdgcn_fence(__ATOMIC_ACQUIRE, "agent");
            xb_add(&bar[XB_XGEN(b.x)], 1u);
            asm volatile("s_waitcnt vmcnt(0)" ::: "memory");
        } else {
            XB_SPIN(xb_ld(&bar[XB_XGEN(b.x)]) == gen, bar);
            __builtin_amdgcn_fence(__ATOMIC_ACQUIRE, "agent");
            asm volatile("s_waitcnt vmcnt(0)" ::: "memory");
        }
    }
    __syncthreads();
}

__global__ void __launch_bounds__(512, 2) hymba_fwd(Params p0) {
    extern __shared__ __attribute__((aligned(16))) unsigned char lds_raw[];
    cg::grid_group grid = cg::this_grid();
    const int G = gridDim.x, bid = blockIdx.x, ngw = G * 8;
    volatile LAS unsigned* bst = (volatile LAS unsigned*)((lds_t)lds_raw + (LDS_BYTES - 64));
    if (threadIdx.x < 16) bst[threadIdx.x] = 0u;
    __syncthreads();
    const XcdBarrier bar = xcd_barrier_post((unsigned*)(p0.ws + WS_CTL), bst);
#define PHASE_BEGIN \
    int tid = threadIdx.x; asm volatile("" : "+v"(tid)); \
    const int lane = tid & 63, wave = __builtin_amdgcn_readfirstlane(tid >> 6); \
    unsigned lo_ = 0; asm volatile("" : "+s"(lo_)); lds_t lds = (lds_t)lds_raw + lo_; \
    Params p = p0; asm volatile("" : "+s"(p.ws)); p.wsl = p.ws + WS_SMALL + (size_t)lcur * SMALL_BYTES; \
    GAS unsigned char* ws = p.ws; const int gw = bid * 8 + wave; (void)gw; (void)lane; (void)lds; (void)ws;

#pragma clang loop unroll(disable)
    for (int l = 0; l < DEPTH; ++l) {
        const int lcur = l;
        if (l == 0) {
            {
                PHASE_BEGIN
                phase_wconv(p, 0, 1, gw, ngw, lane);
                for (int m = gw; m < NT; m += ngw) prep_row(p.in[0] + (size_t)m * DM, (bf16_t*)(ws + WS_HB) + (size_t)m * DM, (float*)(ws + WS_SS1), m, lane, p.in[1]);
            }
            if (p0.ws == nullptr) grid.sync();
            xcd_barrier(bar);
        }
        {
            PHASE_BEGIN
            pg8::Gemm g{(const bf16_t*)(ws + WS_HB), (const bf16_t*)(ws + WS_WIN), NT, NPROJ, DM}; pg8::StaticOrder S; S.init(NT, NPROJ, G, bid);
            gate_wt_prep(p, l, bid * 512 + tid);
            pg8::rstd_table((LAS float*)(lds + 131072), (const float*)(ws + WS_SS1 + (size_t)l * MiB), S, tid);
            pg8::EpiStoreF32 E{(float*)(ws + WS_PROJ), NPROJ, (const LAS float*)(lds + 131072), 0, (bf16_t*)(ws + WS_QKV)};
            pg8::gemm_phase<pg8::EpiStoreF32, pg8::StaticOrder, true, true>(lds, g, S, E, tid);
            { const int nfull = (NT / 256) * (NPROJ / 256) % G; if (nfull > 0 && bid >= nfull) phase_wconv(p, l, 2 | 4, (bid - nfull) * 8 + wave, (G - nfull) * 8, lane); else if (nfull == 0) phase_wconv(p, l, 2 | 4, gw, ngw, lane); }
        }
        xcd_barrier(bar);
        {
            PHASE_BEGIN
            if (gw < 32) fox_cumsum(p, l, gw, lane);
            {
                lds_t wl = lds + wave * 18432;
                if (G == 256) {
                    if (wave < 4) { gla_prep_witem(p, l, bid * 4 + wave, wl, lane); lru_prep_witem(p, l, bid * 16 + wave, wl, lane); }
                    else for (int k = 0; k < 3; ++k) lru_prep_witem(p, l, bid * 16 + 4 + (wave - 4) * 3 + k, wl, lane);
                } else
                for (int it = gw; it < 1024 + 4096; it += ngw) {
                    if (it < 1024) gla_prep_witem(p, l, it, wl, lane);
                    else lru_prep_witem(p, l, it - 1024, wl, lane);
                }
            }
        }
        xcd_barrier(bar);
        {
            PHASE_BEGIN
            for (int it = bid; it < 256; it += G) {
                const int bh = it >> 3, s = it & 7;
                fox_attn_unit(p, bh, 15 - s, lds, tid, wave, lane);
                fox_attn_unit(p, bh, s, lds, tid, wave, lane);
            }
            for (int it = bid; it < 256; it += G) gla_scan_item(p, it, tid);
            for (int it = G - 1 - bid; it < 8; it += G) lru_tilescan_item(p, it, tid);
        }
        xcd_barrier(bar);
        {
            PHASE_BEGIN
            for (int it = bid; it < 256; it += G) lru_out_item(p, l, it, lds, tid, wave, lane);
            for (int it = gw; it < 2048; it += ngw) gla_out_witem(p, l, it, lane);
            if (NT % (4 * ngw) == 0) { for (int tok = gw; tok < NT; tok += 4 * ngw) fox_norm_rows4(p, l, tok, ngw, lane); }
            else for (int tok = gw; tok < NT; tok += ngw) fox_norm_rows4(p, l, tok, 0, lane);
        }
        xcd_barrier(bar);
        {
            PHASE_BEGIN
            const float* xin = (l == 0) ? p.in[0] : (const float*)(ws + WS_XW);
            pg8::Gemm g{(const bf16_t*)(ws + WS_MIX), (const bf16_t*)(ws + WS_WOUT), NT, DM, DM}; pg8::StaticOrder S; S.init(NT, DM, G, bid);
            pg8::EpiResid E{xin, (float*)(ws + WS_XW), (bf16_t*)(ws + WS_HB), (float*)(ws + WS_SS2 + (size_t)l * MiB), p.in[17] + l * DM, DM};
            pg8::gemm_phase<pg8::EpiResid, pg8::StaticOrder, true, true>(lds, g, S, E, tid);
        }
        xcd_barrier(bar);
        {
            PHASE_BEGIN
            pg8::Gemm g{(const bf16_t*)(ws + WS_HB), (const bf16_t*)(ws + WS_WGU), NT, 2 * FFH, DM}; pg8::StaticOrder S; S.init(NT, 2 * FFH, G, bid);
            pg8::rstd_table((LAS float*)(lds + 131072), (const float*)(ws + WS_SS2 + (size_t)l * MiB), S, tid);
            pg8::EpiSwiglu E{(bf16_t*)(ws + WS_PROJ), FFH, (const LAS float*)(lds + 131072), 0};
            pg8::gemm_phase<pg8::EpiSwiglu, pg8::StaticOrder, true, true>(lds, g, S, E, tid);
            { const int nfull = (NT / 256) * (2 * FFH / 256) % G; const int msk = 8 | (l + 1 < DEPTH ? 1 : 0); const int ln = (l + 1 < DEPTH) ? l + 1 : l;
              if (nfull > 0 && bid >= nfull) { phase_wconv(p, l, 8, (bid - nfull) * 8 + wave, (G - nfull) * 8, lane); if (msk & 1) phase_wconv(p, ln, 1, (bid - nfull) * 8 + wave, (G - nfull) * 8, lane); }
              else if (nfull == 0) { phase_wconv(p, l, 8, gw, ngw, lane); if (msk & 1) phase_wconv(p, ln, 1, gw, ngw, lane); } }
        }
        xcd_barrier(bar);
        {
            PHASE_BEGIN
            pg8::Gemm g{(const bf16_t*)(ws + WS_PROJ), (const bf16_t*)(ws + WS_WDN), NT, DM, FFH}; pg8::StaticOrder S; S.init(NT, DM, G, bid);
            pg8::EpiResid E{(const float*)(ws + WS_XW), (float*)(ws + WS_XW), (l < DEPTH - 1) ? (bf16_t*)(ws + WS_HB) : (bf16_t*)nullptr, (float*)(ws + WS_SS1 + (size_t)(l + 1) * MiB), p.in[1] + (l < DEPTH - 1 ? l + 1 : 0) * DM, DM};
            pg8::gemm_phase<pg8::EpiResid, pg8::StaticOrder, true, true>(lds, g, S, E, tid);
        }
        xcd_barrier(bar);
    }
    {
        const int lcur = 0;
        PHASE_BEGIN
        for (int m = gw; m < NT; m += ngw) { const float sv = wave_sum(lane < 32 ? ((const float*)(ws + WS_SS1 + (size_t)DEPTH * MiB))[((size_t)(lane >> 2) * 8192 + m) * 4 + (lane & 3)] : 0.f);
            final_row((const float*)(ws + WS_XW) + (size_t)m * DM, p.in[21], p.out + (size_t)m * DM, sv, lane); }
    }
}

extern "C" void kernel_launch(void* const* d_in, const int* in_sizes, int n_in, void* d_out, int out_size, void* d_ws, size_t ws_size, hipStream_t stream) {
    static int grid_blocks = 0;
    if (grid_blocks == 0) {
        if (n_in != 22 || ws_size < WS_END) { fprintf(stderr, "kernel_launch: unexpected n_in %d / ws_size %zu\n", n_in, ws_size); grid_blocks = -1; return; }
        int dev = 0, cus = 0, per_cu = 0;
        hipGetDevice(&dev);
        hipDeviceGetAttribute(&cus, hipDeviceAttributeMultiprocessorCount, dev);
        hipFuncSetAttribute((const void*)hymba_fwd, hipFuncAttributeMaxDynamicSharedMemorySize, LDS_BYTES);
        hipOccupancyMaxActiveBlocksPerMultiprocessor(&per_cu, (const void*)hymba_fwd, 512, LDS_BYTES);
        if (per_cu < 1) { fprintf(stderr, "kernel_launch: occupancy query says %d blocks per CU\n", per_cu); per_cu = 1; }
        (void)hipGetLastError();
        grid_blocks = cus * 1;
    }
    if (grid_blocks < 0) return;
    Params p{};
    for (int i = 0; i < 22; ++i) p.in[i] = (const float*)d_in[i];
    p.out = (float*)d_out; p.ws = (GAS unsigned char*)d_ws;
    if (hipMemsetAsync((unsigned char*)d_ws + WS_CTL, 0, CTL_BYTES, stream) != hipSuccess) { fprintf(stderr, "kernel_launch: memset failed\n"); return; }
    void* args[] = {&p};
    hipError_t e = hipLaunchCooperativeKernel((const void*)hymba_fwd, dim3(grid_blocks), dim3(512), args, LDS_BYTES, stream);
    if (e != hipSuccess) fprintf(stderr, "cooperative launch failed: %s (grid %d)\n", hipGetErrorString(e), grid_blocks);
}
```

```cpp
#include <hip/hip_runtime.h>
#include <hip/hip_cooperative_groups.h>
#include <cstdio>
#include <cstdint>
namespace cg = cooperative_groups;
namespace pg8 {
#define PG8_LAS __attribute__((address_space(3)))
typedef unsigned short bf16_t;
typedef short bf16x8 __attribute__((ext_vector_type(8)));
typedef float f32x4 __attribute__((ext_vector_type(4)));
typedef unsigned u32x4 __attribute__((ext_vector_type(4)));
constexpr int BM = 256, BK = 64, HALF = 128, HTB = HALF * BK * 2  , STAGE_BYTES = 8 * HTB, NXCD = 8, WGM = 8;

__host__ __device__ __forceinline__ int lds_byte(int r, int c) { const int st = (r >> 4) * 2 + (c >> 5), rr = r & 15, cc = c & 31, ob = rr * 64 + cc * 2; return st * 1024 + (ob ^ (((ob >> 9) & 1) << 5)); }
__host__ __device__ __forceinline__ void stage_rc(int b, int& R, int& C) { const int st = b / 1024, sb = b % 1024, swz = sb ^ (((sb >> 9) & 1) << 5); R = (st >> 1) * 16 + swz / 64; C = (st & 1) * 32 + (swz % 64) / 2; }
__host__ __device__ __forceinline__ int perm32(int rho) { const int n = rho >> 4, i = rho & 15; return 8 * (i >> 2) + 4 * n + (i & 3); }

struct Unit { int pm, pn; };
struct Gemm { const bf16_t* A; const bf16_t* Bt; int M, N, K; };

struct StaticOrder {
    int nM, nN, nwg, G, c;
    __host__ __device__ void init(int M, int N, int G_, int c_) { nM = M / BM; nN = N / BM; nwg = nM * nN; G = G_; c = c_; }
    __host__ __device__ bool next(int i, Unit& u) const {
        const long L = (long)i * G + c; if (L >= nwg) return false;
        int wgid = (int)L; { const int q = nwg / NXCD, r = nwg % NXCD, xcd = wgid % NXCD, off = wgid / NXCD; wgid = (xcd < r ? xcd * (q + 1) : r * (q + 1) + (xcd - r) * q) + off; }
        const int nig = WGM * nN, gid = wgid / nig, fm = gid * WGM, gsz = (nM - fm) < WGM ? (nM - fm) : WGM;
        u.pm = fm + ((wgid % nig) % gsz); u.pn = (wgid % nig) / gsz; return true;
    }
    __device__ __forceinline__ void a_ready(const Unit&) const {}
    __device__ __forceinline__ void done(const Unit&) const {}
};

typedef unsigned u32x2 __attribute__((ext_vector_type(2)));
__device__ __forceinline__ unsigned cvt_pk_bf16(float lo, float hi) { unsigned r; asm("v_cvt_pk_bf16_f32 %0, %1, %2" : "=v"(r) : "v"(lo), "v"(hi)); return r; }
__device__ __forceinline__ float ssp_sum(const float* p, int row) {
    float s = 0.f;
#pragma unroll
    for (int i = 0; i < 8; ++i) { const f32x4 v = *(const f32x4*)(p + ((size_t)i * 8192 + row) * 4); s += (v[0] + v[1]) + (v[2] + v[3]); }
    return s;
}
template <class Sched> __device__ __forceinline__ void rstd_table(PG8_LAS float* rtab, const float* ss, const Sched& S, int tid) {
    float v[4]; bool ok[4];
#pragma unroll
    for (int k = 0; k < 4; ++k) { const int i = 2 * k + (tid >> 8); Unit u; ok[k] = S.next(i, u); v[k] = ok[k] ? ssp_sum(ss, u.pm * BM + (tid & 255)) : 0.f; }
#pragma unroll
    for (int k = 0; k < 4; ++k) if (ok[k]) rtab[(2 * k + (tid >> 8)) * 256 + (tid & 255)] = rsqrtf(v[k] * (1.0f / 2048.0f) + 1e-6f);
    __syncthreads();
}
#define PG8_ROW_RSTD(rs, ss, row0) float rs[2][4]; { const int lane_ = (int)(threadIdx.x & 63u); \
    const float v0_ = rsqrtf(ssp_sum((ss), (row0) + (lane_ >> 4) * 16) * (1.0f / 2048.0f) + 1e-6f), v1_ = rsqrtf(ssp_sum((ss), (row0) + HALF + (lane_ >> 4) * 16) * (1.0f / 2048.0f) + 1e-6f); \
    _Pragma("unroll") for (int m_ = 0; m_ < 4; ++m_) { rs[0][m_] = __shfl(v0_, (lane_ & 15) + 16 * m_); rs[1][m_] = __shfl(v1_, (lane_ & 15) + 16 * m_); } }
struct EpiStoreF32 {
    static constexpr bool PERM = false, AFTER_DRAIN = false;
    float* O; int ldc; const PG8_LAS float* rtab; mutable int ui;
    bf16_t* qkv;
    __device__ __forceinline__ void operator()(const f32x4 (&acc)[2][2][4][2], const Unit& u, int wr, int wc, int fr, int fq) const {
        const int row0 = u.pm * BM + wr * 64 + fr, col0 = u.pn * BM + wc * 32 + 4 * fq;
        const PG8_LAS float* rt = rtab + ui * 256 + wr * 64 + fr; ++ui;
#pragma unroll
        for (int ai = 0; ai < 2; ++ai)
#pragma unroll
            for (int m = 0; m < 4; ++m) { const int row = row0 + ai * HALF + m * 16; float* rowp = O + (size_t)row * ldc + col0;
                const float rs = rt[ai * HALF + m * 16];
                if (u.pn < 6 || (u.pn >> 1) == 4) {
                    const float sc = (u.pn < 2) ? 0.125f * 1.4426950408889634f : 1.0f;
                    bf16_t* bp = qkv + ((size_t)(u.pn < 6 ? (u.pn >> 1) : 3) * 8192 + row) * 512 + (u.pn & 1) * 256 + wc * 32 + 4 * fq;
#pragma unroll
                    for (int bj = 0; bj < 2; ++bj)
#pragma unroll
                        for (int n = 0; n < 2; ++n) { f32x4 v = acc[ai][bj][m][n] * rs; if (u.pn < 2) v = v * sc;
                            u32x2 w; w.x = cvt_pk_bf16(v[0], v[1]); w.y = cvt_pk_bf16(v[2], v[3]); *(u32x2*)(bp + bj * HALF + n * 16) = w; }
                } else {
#pragma unroll
                for (int bj = 0; bj < 2; ++bj)
#pragma unroll
                    for (int n = 0; n < 2; ++n) *(f32x4*)(rowp + bj * HALF + n * 16) = acc[ai][bj][m][n] * rs; } }
    }
};
struct EpiResid {
    static constexpr bool PERM = false, AFTER_DRAIN = false;
    const float* base; float* out; bf16_t* xb; float* ss; const float* gain; int ldc;
    __device__ __forceinline__ void operator()(const f32x4 (&acc)[2][2][4][2], const Unit& u, int wr, int wc, int fr, int fq) const {
        const int row0 = u.pm * BM + wr * 64 + fr, col0 = u.pn * BM + wc * 32 + 4 * fq;
        f32x4 gv[2][2];
#pragma unroll
        for (int bj = 0; bj < 2; ++bj)
#pragma unroll
            for (int n = 0; n < 2; ++n) gv[bj][n] = *(const f32x4*)(gain + col0 + bj * HALF + n * 16);
#pragma unroll
        for (int ai = 0; ai < 2; ++ai) {
            f32x4 pre[4][2][2];
#pragma unroll
            for (int m = 0; m < 4; ++m)
#pragma unroll
                for (int bj = 0; bj < 2; ++bj)
#pragma unroll
                    for (int n = 0; n < 2; ++n) pre[m][bj][n] = *(const f32x4*)(base + (size_t)(row0 + ai * HALF + m * 16) * ldc + col0 + bj * HALF + n * 16);
#pragma unroll
            for (int m = 0; m < 4; ++m) { const int row = row0 + ai * HALF + m * 16; const size_t off = (size_t)row * ldc + col0; float s = 0.f;
#pragma unroll
                for (int bj = 0; bj < 2; ++bj)
#pragma unroll
                    for (int n = 0; n < 2; ++n) { const f32x4 b = pre[m][bj][n]; const f32x4 v = b + acc[ai][bj][m][n];
                        *(f32x4*)(out + off + bj * HALF + n * 16) = v; s += (v[0] * v[0] + v[1] * v[1]) + (v[2] * v[2] + v[3] * v[3]);
                        if (xb) { const f32x4 y = v * gv[bj][n]; u32x2 w; w.x = cvt_pk_bf16(y[0], y[1]); w.y = cvt_pk_bf16(y[2], y[3]); *(u32x2*)(xb + off + bj * HALF + n * 16) = w; } }
                s += __shfl_xor(s, 16); s += __shfl_xor(s, 32);
                if (fq == 0) ss[((size_t)u.pn * 8192 + row) * 4 + wc] = s; }
            asm volatile("" ::: "memory");
        }
    }
};
struct EpiSwiglu {
    static constexpr bool PERM = true, AFTER_DRAIN = false;
    bf16_t* O; int ldc; const PG8_LAS float* rtab; mutable int ui;
    __device__ __forceinline__ void operator()(const f32x4 (&acc)[2][2][4][2], const Unit& u, int wr, int wc, int fr, int fq) const {
        const int row0 = u.pm * BM + wr * 64 + fr, col0 = u.pn * HALF + wc * 32 + 8 * fq;
        const PG8_LAS float* rt = rtab + ui * 256 + wr * 64 + fr; ++ui;
#pragma unroll
        for (int ai = 0; ai < 2; ++ai)
#pragma unroll
            for (int m = 0; m < 4; ++m) {
                const float rs = rt[ai * HALF + m * 16];
                float h[8];
#pragma unroll
                for (int n = 0; n < 2; ++n)
#pragma unroll
                    for (int e = 0; e < 4; ++e) { const float g = acc[ai][0][m][n][e] * rs, up = acc[ai][1][m][n][e] * rs; h[n * 4 + e] = g * __builtin_amdgcn_rcpf(1.0f + __builtin_amdgcn_exp2f(g * -1.4426950408889634f)) * up; }
                u32x4 w; w.x = cvt_pk_bf16(h[0], h[1]); w.y = cvt_pk_bf16(h[2], h[3]); w.z = cvt_pk_bf16(h[4], h[5]); w.w = cvt_pk_bf16(h[6], h[7]);
                *(u32x4*)(O + (size_t)(row0 + ai * HALF + m * 16) * ldc + col0) = w; }
    }
};
template <class Epi, class Sched, bool ALIGN_EPI = false, bool SP2 = false>
__device__ __forceinline__ void gemm_phase(PG8_LAS unsigned char* lds, const Gemm g, const Sched& S, const Epi& E, const int tid) {
    const int wid = __builtin_amdgcn_readfirstlane(tid >> 6), lane = tid & 63, wr = wid >> 2, wc = wid & 3, fr = lane & 15, fq = lane >> 4;
    const int K = g.K, nt = K / BK;
    unsigned voffA[2], voffB[2];
#pragma unroll
    for (int i = 0; i < 2; ++i) { int R, C; stage_rc(tid * 16 + i * 8192, R, C); const int Rb = Epi::PERM ? ((R & ~31) + perm32(R & 31)) : R;
        voffA[i] = (unsigned)(R * K + C) * 2u; voffB[i] = (unsigned)(Rb * K + C) * 2u; }
    const size_t kstep = (size_t)(BK * 2);
    const size_t hstep = (size_t)HALF * K * 2;
    const size_t tstep = 2 * hstep;
    const unsigned ldsw = (unsigned)wid * 1024u;
    const int aoff = lds_byte(wr * 64 + fr, fq * 8), boff = lds_byte(wc * 32 + fr, fq * 8);
#define PG8_SA(b, h) (((b) * 2 + (h)) * HTB)
#define PG8_SB(b, h) ((4 + (b) * 2 + (h)) * HTB)
#define PG8_STAGE(bufoff, gbase, voff) do { _Pragma("unroll") for (int _i = 0; _i < 2; ++_i) \
        __builtin_amdgcn_global_load_lds((const unsigned*)((const char*)(gbase) + (voff)[_i]), (PG8_LAS unsigned*)(lds + (bufoff) + ldsw + _i * 8192), 16, 0, 0); } while (0)
#define PG8_LDA(dst, b, h) do { _Pragma("unroll") for (int m = 0; m < 4; ++m) _Pragma("unroll") for (int k = 0; k < 2; ++k) dst[m][k] = *(const PG8_LAS bf16x8*)(lds + PG8_SA(b, h) + aoff + m * 2048 + k * 1024); } while (0)
#define PG8_LDB(dst, b, h) do { _Pragma("unroll") for (int n = 0; n < 2; ++n) _Pragma("unroll") for (int k = 0; k < 2; ++k) dst[n][k] = *(const PG8_LAS bf16x8*)(lds + PG8_SB(b, h) + boff + n * 2048 + k * 1024); } while (0)
#define PG8_MMA(ai, bj, At, Bt) do { __builtin_amdgcn_s_setprio(1); _Pragma("unroll") for (int m = 0; m < 4; ++m) _Pragma("unroll") for (int n = 0; n < 2; ++n) _Pragma("unroll") for (int k = 0; k < 2; ++k) \
        acc[ai][bj][m][n] = __builtin_amdgcn_mfma_f32_16x16x32_bf16(Bt[n][k], At[m][k], acc[ai][bj][m][n], 0, 0, 0); __builtin_amdgcn_s_setprio(0); } while (0)
#define PG8_WAIT_V(n) asm volatile("s_waitcnt vmcnt(" #n ")" ::: "memory")
#define PG8_WAIT_L(n) asm volatile("s_waitcnt lgkmcnt(" #n ")" ::: "memory")
#define PG8_BAR __builtin_amdgcn_s_barrier()
#define PG8_SCHED __builtin_amdgcn_sched_barrier(0)
    Unit cur, nxt; int ui = 0;
    if (!S.next(0, cur)) return;
    f32x4 acc[2][2][4][2];
#pragma unroll
    for (int a = 0; a < 2; ++a)
#pragma unroll
        for (int b = 0; b < 2; ++b)
#pragma unroll
            for (int m = 0; m < 4; ++m)
#pragma unroll
                for (int n = 0; n < 2; ++n) acc[a][b][m][n] = (f32x4){0.f, 0.f, 0.f, 0.f};
    bf16x8 At[4][2], B0[2][2], B1[2][2];
    const char* cA = (const char*)g.A + (size_t)cur.pm * tstep; const char* cB = (const char*)g.Bt + (size_t)cur.pn * tstep;
    S.a_ready(cur);
    if constexpr (SP2) {
        PG8_STAGE(PG8_SB(0, 0), cB, voffB); PG8_STAGE(PG8_SB(0, 1), cB + hstep, voffB); PG8_STAGE(PG8_SA(0, 0), cA, voffA); PG8_STAGE(PG8_SA(0, 1), cA + hstep, voffA);
        if (wr == 1) PG8_BAR;
        PG8_WAIT_V(2); PG8_BAR;
        PG8_STAGE(PG8_SB(1, 0), cB + kstep, voffB); PG8_STAGE(PG8_SA(1, 0), cA + kstep, voffA); PG8_STAGE(PG8_SB(1, 1), cB + hstep + kstep, voffB);
        PG8_WAIT_V(6); PG8_BAR;
    } else {
        PG8_STAGE(PG8_SB(0, 0), cB, voffB); PG8_STAGE(PG8_SA(0, 0), cA, voffA); PG8_STAGE(PG8_SB(0, 1), cB + hstep, voffB); PG8_STAGE(PG8_SA(0, 1), cA + hstep, voffA);
        if (wr == 1) PG8_BAR;
        PG8_WAIT_V(4); PG8_BAR;
        PG8_STAGE(PG8_SB(1, 0), cB + kstep, voffB); PG8_STAGE(PG8_SA(1, 0), cA + kstep, voffA); PG8_STAGE(PG8_SB(1, 1), cB + hstep + kstep, voffB);
        PG8_WAIT_V(6); PG8_BAR;
    }
    for (;;) {
        const bool has_next = S.next(ui + 1, nxt);
        const char* nA = has_next ? (const char*)g.A + (size_t)nxt.pm * tstep : cA; const char* nB = has_next ? (const char*)g.Bt + (size_t)nxt.pn * tstep : cB;
        for (int t = 0; t < nt; t += 2) {
            const bool last = (t == nt - 2);
            const char* a1 = cA + (size_t)(t + 1) * kstep;
            const char* a2 = last ? nA : cA + (size_t)(t + 2) * kstep; const char* b2 = last ? nB : cB + (size_t)(t + 2) * kstep;
            const char* a3 = a2 + kstep; const char* b3 = b2 + kstep;
            if (last && has_next) S.a_ready(nxt);
            if constexpr (SP2) {
            PG8_LDB(B0, 0, 0); PG8_LDB(B1, 0, 1); PG8_SCHED; PG8_LDA(At, 0, 0); PG8_STAGE(PG8_SA(1, 1), a1 + hstep, voffA);
            PG8_WAIT_V(8); PG8_WAIT_L(0); PG8_BAR; PG8_MMA(0, 0, At, B0); PG8_MMA(0, 1, At, B1); PG8_BAR; PG8_SCHED;
            PG8_LDA(At, 0, 1); PG8_STAGE(PG8_SB(0, 0), b2, voffB); PG8_STAGE(PG8_SB(0, 1), b2 + hstep, voffB); PG8_STAGE(PG8_SA(0, 0), a2, voffA);
            PG8_WAIT_V(8); PG8_WAIT_L(0); PG8_BAR; PG8_MMA(1, 0, At, B0); PG8_MMA(1, 1, At, B1); PG8_BAR; PG8_SCHED;
            PG8_LDB(B0, 1, 0); PG8_LDB(B1, 1, 1); PG8_SCHED; PG8_LDA(At, 1, 0); PG8_STAGE(PG8_SA(0, 1), a2 + hstep, voffA);
            PG8_WAIT_V(8); PG8_WAIT_L(0); PG8_BAR; PG8_MMA(0, 0, At, B0); PG8_MMA(0, 1, At, B1); PG8_BAR; PG8_SCHED;
            PG8_LDA(At, 1, 1); PG8_STAGE(PG8_SB(1, 0), b3, voffB); PG8_STAGE(PG8_SB(1, 1), b3 + hstep, voffB); PG8_STAGE(PG8_SA(1, 0), a3, voffA);
            PG8_WAIT_V(8); PG8_WAIT_L(0); PG8_BAR; PG8_MMA(1, 0, At, B0); PG8_MMA(1, 1, At, B1); PG8_BAR; PG8_SCHED;
            } else {
            PG8_LDB(B0, 0, 0); PG8_SCHED; PG8_LDA(At, 0, 0); PG8_STAGE(PG8_SA(1, 1), a1 + hstep, voffA);
            PG8_WAIT_L(8); PG8_BAR; PG8_WAIT_L(0); PG8_MMA(0, 0, At, B0); PG8_BAR; PG8_SCHED;
            PG8_LDB(B1, 0, 1); PG8_STAGE(PG8_SB(0, 0), b2, voffB);
            PG8_BAR; PG8_WAIT_L(0); PG8_MMA(0, 1, At, B1); PG8_BAR;
            PG8_LDA(At, 0, 1); PG8_STAGE(PG8_SA(0, 0), a2, voffA);
            PG8_BAR; PG8_WAIT_L(0); PG8_MMA(1, 0, At, B0); PG8_BAR; PG8_SCHED;
            PG8_STAGE(PG8_SB(0, 1), b2 + hstep, voffB);
            PG8_WAIT_V(6); PG8_BAR; PG8_MMA(1, 1, At, B1); PG8_BAR;
            PG8_LDB(B0, 1, 0); PG8_SCHED; PG8_LDA(At, 1, 0); PG8_STAGE(PG8_SA(0, 1), a2 + hstep, voffA);
            PG8_WAIT_L(8); PG8_BAR; PG8_WAIT_L(0); PG8_MMA(0, 0, At, B0); PG8_BAR; PG8_SCHED;
            PG8_LDB(B1, 1, 1); PG8_STAGE(PG8_SB(1, 0), b3, voffB);
            PG8_BAR; PG8_WAIT_L(0); PG8_MMA(0, 1, At, B1); PG8_BAR;
            PG8_LDA(At, 1, 1); PG8_STAGE(PG8_SA(1, 0), a3, voffA);
            PG8_BAR; PG8_WAIT_L(0); PG8_MMA(1, 0, At, B0); PG8_BAR; PG8_SCHED;
            PG8_STAGE(PG8_SB(1, 1), b3 + hstep, voffB);
            PG8_WAIT_V(6); PG8_BAR; PG8_MMA(1, 1, At, B1); PG8_BAR;
            }
        }
        if constexpr (ALIGN_EPI) { if (wr == 0) PG8_BAR; }
        if constexpr (!Epi::AFTER_DRAIN) { E(acc, cur, wr, wc, fr, fq); S.done(cur); }
        if (!has_next) break;
#pragma unroll
        for (int a = 0; a < 2; ++a)
#pragma unroll
            for (int b = 0; b < 2; ++b)
#pragma unroll
                for (int m = 0; m < 4; ++m)
#pragma unroll
                    for (int n = 0; n < 2; ++n) acc[a][b][m][n] = (f32x4){0.f, 0.f, 0.f, 0.f};
        cur = nxt; cA = nA; cB = nB; ++ui;
        if constexpr (ALIGN_EPI) { if (wr == 1) PG8_BAR; }
    }
    PG8_WAIT_V(0);
    if constexpr (!ALIGN_EPI) { if (wr == 0) PG8_BAR; }
    PG8_BAR;
    if constexpr (Epi::AFTER_DRAIN) { E.fused(acc, cur, wr, wc, fr, fq, lds, wid, lane); S.done(cur); }
#undef PG8_SA
#undef PG8_SB
#undef PG8_STAGE
#undef PG8_LDA
#undef PG8_LDB
#undef PG8_MMA
#undef PG8_WAIT_V
#undef PG8_WAIT_L
#undef PG8_BAR
#undef PG8_SCHED
}
}

#define LAS __attribute__((address_space(3)))
typedef unsigned short bf16_t;
typedef short bf16x8 __attribute__((ext_vector_type(8)));
typedef short s16x4 __attribute__((ext_vector_type(4)));
typedef float f32x4 __attribute__((ext_vector_type(4)));
typedef float f32x2 __attribute__((ext_vector_type(2)));
typedef unsigned u32x4 __attribute__((ext_vector_type(4)));
typedef unsigned u32x2 __attribute__((ext_vector_type(2)));
typedef LAS unsigned char* lds_t;

constexpr int NT = 8192, DM = 2048, SEQ = 2048, NB = 4, DEPTH = 4;
constexpr int INW = 5144, NPROJ = 5376, FFH = 5632;
constexpr int PC_FQ = 0, PC_FK = 512, PC_FV = 1024, PC_GQ = 1536, PC_GK = 1792, PC_GV = 2048, PC_GG = 2560, PC_LG = 3072, PC_LX = 4096, PC_FF = 5120, PC_GR = 5128;
constexpr float EPS = 1e-6f;
constexpr float LOG2E = 1.4426950408889634f;
constexpr int LDS_BYTES = 147456;

constexpr size_t MiB = 1u << 20;
constexpr size_t WS_WIN = 0, WS_WOUT = 21 * MiB, WS_WGU = 29 * MiB, WS_WDN = 73 * MiB;
constexpr size_t WS_XW = 96 * MiB;
constexpr size_t WS_HB = 160 * MiB;
constexpr size_t WS_PROJ = 192 * MiB;
constexpr size_t WS_MIX = 360 * MiB;
constexpr size_t WS_FOXO = 392 * MiB;
constexpr size_t WS_CBUF = 400 * MiB;
constexpr size_t WS_GQT = 401 * MiB;
constexpr size_t WS_GA = 405 * MiB;
constexpr size_t WS_GVT = 407 * MiB;
constexpr size_t WS_GU = 415 * MiB;
constexpr size_t WS_GS = 447 * MiB;
constexpr size_t WS_GDEC = 463 * MiB;
constexpr size_t WS_LA = 464 * MiB;
constexpr size_t WS_LU = 496 * MiB;
constexpr size_t WS_AGP = 528 * MiB, WS_AGH = 529 * MiB, WS_HIN = 530 * MiB;
constexpr size_t WS_SS1 = 532 * MiB, WS_SS2 = 537 * MiB;
constexpr size_t WS_CTL = 531 * MiB, CTL_BYTES = 16384;
constexpr size_t WS_GWT = 541 * MiB;
constexpr size_t WS_SMALL = 542 * MiB, SMALL_BYTES = 10 * MiB;
constexpr size_t SL_CBUF = 0, SL_GDEC = 256 * 1024, SL_GWT = 512 * 1024, SL_AGP = 1 * MiB, SL_AGH = 2 * MiB, SL_HIN = 3 * MiB, SL_GQT = 4 * MiB, SL_GA = 8 * MiB;
constexpr size_t WS_QKV = 582 * MiB;
constexpr size_t WS_END = 614 * MiB;

#define GAS __attribute__((address_space(1)))
struct Params { const float* in[22]; float* out; GAS unsigned char* ws; GAS unsigned char* wsl; };

__device__ __forceinline__ unsigned pk2(float lo, float hi) { unsigned r; asm("v_cvt_pk_bf16_f32 %0, %1, %2" : "=v"(r) : "v"(lo), "v"(hi)); return r; }
__device__ __forceinline__ bf16_t f2bf(float f) { return (bf16_t)(pk2(f, 0.f) & 0xffffu); }
__device__ __forceinline__ float bf2f(unsigned b) { return __uint_as_float(b << 16); }
__device__ __forceinline__ float logsig(float x) { return fminf(x, 0.f) - __logf(1.0f + __expf(-fabsf(x))); }
__device__ __forceinline__ float sigmoidf(float x) { return __builtin_amdgcn_rcpf(1.0f + __expf(-x)); }
__device__ __forceinline__ float neg_expm1_small(float y) {
    const float pl = y * (1.0f + y * (0.5f + y * (0.16666667f + y * (0.041666668f + y * (0.0083333338f + y * (0.0013888889f + y * 0.00019841270f))))));
    return (y > -0.25f) ? -pl : (1.0f - __expf(y));
}
__device__ __forceinline__ f32x4 mfma16(bf16x8 a, bf16x8 b, f32x4 c) { return __builtin_amdgcn_mfma_f32_16x16x32_bf16(a, b, c, 0, 0, 0); }
__device__ __forceinline__ float wave_sum(float v) {
#pragma unroll
    for (int o = 1; o < 64; o <<= 1) v += __shfl_xor(v, o);
    return v;
}
__device__ __forceinline__ bf16x8 pack8(f32x4 a, f32x4 b) {
    u32x4 w; w.x = pk2(a[0], a[1]); w.y = pk2(a[2], a[3]); w.z = pk2(b[0], b[1]); w.w = pk2(b[2], b[3]);
    return __builtin_bit_cast(bf16x8, w);
}

template <int MODE>
__device__ __forceinline__ void wconv_item(const float* W0, const float* W1, int Nsrc, int K, bf16_t* Bt, int NG, int item, int lane, const float* gain) {
    const int kb = item / NG, nb = item - kb * NG;
    const int kg = lane >> 4, ng = lane & 15;
    const int np = nb * 64 + ng * 4, k = kb * 32 + kg * 8;
    const float* src = W0; int c = np;
    if (MODE == 0) { c = np < 1536 ? np : np < 3072 ? np + 8 : np < 5120 ? np + 24 : np < 5128 ? np - 5120 + 1536 : np < 5144 ? np - 5128 + 3080 : -1; }
    if (MODE == 2) { const int pn = np >> 8, j = np & 255; src = j < 128 ? W0 : W1; c = pn * 128 + (j & 127); }
    f32x4 v[8];
#pragma unroll
    for (int i = 0; i < 8; ++i) v[i] = (c >= 0) ? *(const f32x4*)(src + (size_t)(k + i) * Nsrc + c) : (f32x4){0.f, 0.f, 0.f, 0.f};
    if (gain) { const f32x4 g0 = *(const f32x4*)(gain + k), g1 = *(const f32x4*)(gain + k + 4);
#pragma unroll
        for (int i = 0; i < 4; ++i) { v[i] = v[i] * g0[i]; v[4 + i] = v[4 + i] * g1[i]; } }
#pragma unroll
    for (int j = 0; j < 4; ++j) {
        u32x4 o; o.x = pk2(v[0][j], v[1][j]); o.y = pk2(v[2][j], v[3][j]); o.z = pk2(v[4][j], v[5][j]); o.w = pk2(v[6][j], v[7][j]);
        *(u32x4*)(Bt + (size_t)(np + j) * K + k) = o;
    }
}

__device__ __forceinline__ void prep_row(const float* xrow, bf16_t* orow, float* ss, int row, int lane, const float* g) {
    const f32x4* xr = (const f32x4*)xrow + lane; const f32x4* gr = (const f32x4*)g + lane;
    f32x4 v[8]; float s = 0.f;
#pragma unroll
    for (int j = 0; j < 8; ++j) { v[j] = xr[64 * j]; s += (v[j][0] * v[j][0] + v[j][1] * v[j][1]) + (v[j][2] * v[j][2] + v[j][3] * v[j][3]); }
    s = wave_sum(s);
    if (lane < 32) ss[((size_t)(lane >> 2) * 8192 + row) * 4 + (lane & 3)] = (lane == 0) ? s : 0.f;
#pragma unroll
    for (int j = 0; j < 8; ++j) { const f32x4 y = v[j] * gr[64 * j]; u32x2 w; w.x = pk2(y[0], y[1]); w.y = pk2(y[2], y[3]); ((u32x2*)orow)[lane + 64 * j] = w; }
}
__device__ __forceinline__ void final_row(const float* xrow, const float* g, float* orow, float ss, int lane) {
    const f32x4* xr = (const f32x4*)xrow + lane; const f32x4* gr = (const f32x4*)g + lane;
    const float rstd = rsqrtf(ss * (1.0f / 2048.0f) + EPS);
#pragma unroll
    for (int j = 0; j < 8; ++j) ((f32x4*)orow)[lane + 64 * j] = xr[64 * j] * rstd * gr[64 * j];
}

__device__ __forceinline__ void phase_wconv(const Params& p, int l, int mask, int w, int nw, int lane) {
    GAS unsigned char* ws = p.ws;
    constexpr int I_IN = 64 * 84, I_OUT = 64 * 32, I_GU = 64 * 176, I_DN = 176 * 32;
    const float* w_in = p.in[2] + (size_t)l * DM * INW;
    const float* w_out = p.in[16] + (size_t)l * DM * DM;
    const float* w_gate = p.in[18] + (size_t)l * DM * FFH;
    const float* w_up = p.in[19] + (size_t)l * DM * FFH;
    const float* w_down = p.in[20] + (size_t)l * FFH * DM;
    if (mask & 1) for (int it = w; it < I_IN; it += nw) wconv_item<0>(w_in, w_in, INW, DM, (bf16_t*)(ws + WS_WIN), 84, it, lane, nullptr);
    if (mask & 2) for (int it = w; it < I_OUT; it += nw) wconv_item<1>(w_out, w_out, DM, DM, (bf16_t*)(ws + WS_WOUT), 32, it, lane, nullptr);
    if (mask & 4) for (int it = w; it < I_GU; it += nw) wconv_item<2>(w_gate, w_up, FFH, DM, (bf16_t*)(ws + WS_WGU), 176, it, lane, nullptr);
    if (mask & 8) for (int it = w; it < I_DN; it += nw) wconv_item<1>(w_down, w_down, DM, FFH, (bf16_t*)(ws + WS_WDN), 32, it, lane, nullptr);
}

__device__ __forceinline__ void fox_cumsum(const Params& p, int l, int seq, int lane) {
    const float* proj = (const float*)(p.ws + WS_PROJ);
    float* cbuf = (float*)(p.wsl + SL_CBUF);
    const int b = seq >> 3, h = seq & 7;
    const float bias = p.in[3][l * 8 + h];
    const float* src = proj + (size_t)(b * SEQ + lane * 32) * NPROJ + PC_FF + h;
    float ls[32];
#pragma unroll
    for (int i = 0; i < 32; ++i) ls[i] = src[(size_t)i * NPROJ];
    float s = 0.f;
#pragma unroll
    for (int i = 0; i < 32; ++i) { ls[i] = logsig(ls[i] + bias); s += ls[i]; }
    float incl = s;
#pragma unroll
    for (int o = 1; o < 64; o <<= 1) { const float t = __shfl_up(incl, o); if (lane >= o) incl += t; }
    float run = incl - s;
    float* dst = cbuf + seq * SEQ + lane * 32;
#pragma unroll
    for (int i = 0; i < 32; ++i) { run += ls[i]; dst[i] = run * LOG2E; }
}

__device__ __forceinline__ void gate_wt_prep(const Params& p, int l, int gid) {
    if (gid < 2 * 16 * 64 * 64) {
        const int d = gid & 63, e = (gid >> 6) & 63, n = (gid >> 12) & 15, g = gid >> 16;
        const float* w = (g == 0 ? p.in[10] : p.in[12]) + ((size_t)(l * 16 + n) * 64 + d) * 64 + e;
        ((bf16_t*)(p.wsl + SL_GWT))[gid] = f2bf(*w);
    }
}

__device__ __forceinline__ void gla_prep_witem(const Params& p, int l, int ch, lds_t wl_in, int lane_in) {
    int lane = lane_in; asm volatile("" : "+v"(lane));
    unsigned wlo_ = 0; asm volatile("" : "+s"(wlo_)); lds_t wl = wl_in + wlo_;
    const float* proj = (const float*)(p.ws + WS_PROJ);
    const int bh = ch >> 6, n = ch & 63, b = bh >> 2, h = bh & 3;
    const int t0 = b * SEQ + n * 32;
    LAS bf16_t* Qs = (LAS bf16_t*)(wl);
    LAS bf16_t* Ks = (LAS bf16_t*)(wl + 4608);
    LAS bf16_t* KstT = (LAS bf16_t*)(wl);
    LAS bf16_t* VT = (LAS bf16_t*)(wl + 5120);
    const int r = lane & 15, q = lane >> 4;
    float gqv[32], gkv[32];
#pragma unroll
    for (int t = 0; t < 32; ++t) { const float* prow = proj + (size_t)(t0 + t) * NPROJ; gqv[t] = prow[PC_GQ + h * 64 + lane]; gkv[t] = prow[PC_GK + h * 64 + lane]; }
    unsigned vw[2][16];
#pragma unroll
    for (int vv = 0; vv < 2; ++vv) {
        const bf16_t* vp = (const bf16_t*)(p.ws + WS_QKV) + ((size_t)3 * NT + t0) * 512 + h * 128 + lane + 64 * vv;
#pragma unroll
        for (int t = 0; t < 32; t += 2) vw[vv][t >> 1] = (unsigned)vp[(size_t)t * 512] | ((unsigned)vp[(size_t)(t + 1) * 512] << 16);
    }
    float bcum[32];
    {
        const float* w2 = p.in[5] + (size_t)l * 16 * 256 + h * 64 + lane;
        const float gb = p.in[6][l * 256 + h * 64 + lane];
        float w2r[16];
#pragma unroll
        for (int i = 0; i < 16; ++i) w2r[i] = w2[i * 256];
        LAS float* grs = (LAS float*)(wl);
        { const float* gsrc = proj + (size_t)(t0 + (lane >> 1)) * NPROJ + PC_GR + (lane & 1) * 8;
          const f32x4 g0 = *(const f32x4*)gsrc, g1 = *(const f32x4*)(gsrc + 4);
          *(LAS f32x4*)(grs + lane * 8) = g0; *(LAS f32x4*)(grs + lane * 8 + 4) = g1; }
        float run = 0.f;
#pragma unroll
        for (int t = 0; t < 32; ++t) {
            f32x4 gr4[4];
#pragma unroll
            for (int i = 0; i < 4; ++i) gr4[i] = *(LAS f32x4*)(grs + t * 16 + 4 * i);
            float z = gb;
#pragma unroll
            for (int i = 0; i < 16; ++i) z += gr4[i >> 2][i & 3] * w2r[i];
            run += logsig(z) * (1.0f / 16.0f);
            bcum[t] = run;
        }
        asm volatile("" ::: "memory");
    }
    const float bl = bcum[31];
    unsigned kstp[16];
    {
        bf16_t* qtg = (bf16_t*)(p.wsl + SL_GQT) + (size_t)t0 * 256 + h * 64 + lane;
        float ksprev = 0.f;
#pragma unroll
        for (int t = 0; t < 32; ++t) {
            const float gq = gqv[t], gk = gkv[t];
            const float bv = bcum[t];
            const float qt = gq * 0.125f * __expf(bv), kt = gk * __expf(-bv), ks = gk * __expf(bl - bv);
            const bf16_t qb16 = f2bf(qt);
            Qs[t * 72 + lane] = qb16; Ks[t * 72 + lane] = f2bf(kt);
            qtg[(size_t)t * 256] = qb16;
            if (t & 1) kstp[t >> 1] = pk2(ksprev, ks); else ksprev = ks;
        }
        ((float*)(p.wsl + SL_GDEC))[ch * 64 + lane] = __expf(bl);
    }
    {
        bf16_t* ab = (bf16_t*)(p.wsl + SL_GA) + (size_t)ch * 1024;
#pragma unroll
        for (int tt = 0; tt < 2; ++tt)
#pragma unroll
            for (int st = 0; st < 2; ++st) {
                f32x4 acc = {0.f, 0.f, 0.f, 0.f};
#pragma unroll
                for (int ks = 0; ks < 2; ++ks) {
                    const bf16x8 a = *(LAS bf16x8*)(Qs + (16 * tt + r) * 72 + 32 * ks + 8 * q);
                    const bf16x8 bb = *(LAS bf16x8*)(Ks + (16 * st + r) * 72 + 32 * ks + 8 * q);
                    acc = mfma16(a, bb, acc);
                }
#pragma unroll
                for (int j = 0; j < 4; ++j) { const int t = 16 * tt + 4 * q + j, s = 16 * st + r; ab[t * 32 + s] = f2bf(s <= t ? acc[j] : 0.f); }
            }
    }
#pragma unroll
    for (int i = 0; i < 4; ++i) { u32x4 w; w.x = kstp[4 * i]; w.y = kstp[4 * i + 1]; w.z = kstp[4 * i + 2]; w.w = kstp[4 * i + 3]; *(LAS u32x4*)(KstT + lane * 40 + 8 * i) = w; }
#pragma unroll
    for (int vv = 0; vv < 2; ++vv) {
        const int v = lane + 64 * vv;
        bf16_t* vg = (bf16_t*)(p.ws + WS_GVT) + (size_t)ch * 4096 + v * 32;
#pragma unroll
        for (int i = 0; i < 4; ++i) { u32x4 w; w.x = vw[vv][4 * i]; w.y = vw[vv][4 * i + 1]; w.z = vw[vv][4 * i + 2]; w.w = vw[vv][4 * i + 3]; *(LAS u32x4*)(VT + v * 40 + 8 * i) = w; *(u32x4*)(vg + 8 * i) = w; }
    }
    {
        float* ub = (float*)(p.ws + WS_GU) + (size_t)ch * 8192;
        bf16x8 kb[4];
#pragma unroll
        for (int dt = 0; dt < 4; ++dt) kb[dt] = *(LAS bf16x8*)(KstT + (16 * dt + r) * 40 + 8 * q);
#pragma unroll
        for (int w = 0; w < 8; ++w) {
            const bf16x8 a = *(LAS bf16x8*)(VT + (16 * w + r) * 40 + 8 * q);
#pragma unroll
            for (int dt = 0; dt < 4; ++dt) {
                const f32x4 acc = mfma16(a, kb[dt], (f32x4){0.f, 0.f, 0.f, 0.f});
#pragma unroll
                for (int j = 0; j < 4; ++j) ub[(16 * w + 4 * q + j) * 64 + 16 * dt + r] = acc[j];
            }
        }
    }
}

__device__ __forceinline__ void lru_prep_witem(const Params& p, int l, int item, lds_t wl_in, int lane_in) {
    int lane = lane_in; asm volatile("" : "+v"(lane));
    unsigned wlo_ = 0; asm volatile("" : "+s"(wlo_)); lds_t wl = wl_in + wlo_;
    const float* proj = (const float*)(p.ws + WS_PROJ);
    const int gt = item >> 4, n = item & 15, tok0 = gt * 32, b = tok0 >> 11, p0 = tok0 & 2047, c0 = n * 64;
    LAS bf16_t* Xs = (LAS bf16_t*)(wl);
    LAS float* Xf = (LAS float*)(wl + 4608);
    const int r = lane & 15, q = lane >> 4;
    {
        const int c = c0 + lane;
        const float* cw = p.in[8] + (size_t)l * 4 * 1024 + c;
        const float w0 = cw[0], w1 = cw[1024], w2 = cw[2048], w3 = cw[3072], cb = p.in[9][l * 1024 + c];
        const float* lxp = proj + (size_t)(b * SEQ) * NPROJ + PC_LX + c;
        float x0 = p0 >= 3 ? lxp[(size_t)(p0 - 3) * NPROJ] : 0.f, x1 = p0 >= 2 ? lxp[(size_t)(p0 - 2) * NPROJ] : 0.f, x2 = p0 >= 1 ? lxp[(size_t)(p0 - 1) * NPROJ] : 0.f;
        float xv[32];
#pragma unroll
        for (int i = 0; i < 32; ++i) xv[i] = lxp[(size_t)(p0 + i) * NPROJ];
#pragma unroll
        for (int i = 0; i < 32; ++i) {
            const float x3 = xv[i];
            const float y = cb + w0 * x0 + w1 * x1 + w2 * x2 + w3 * x3;
            Xf[i * 68 + lane] = y; Xs[i * 72 + lane] = f2bf(y);
            x0 = x1; x1 = x2; x2 = x3;
        }
    }
    const bf16_t* gwt = (const bf16_t*)(p.wsl + SL_GWT);
    bf16x8 af[2][2];
#pragma unroll
    for (int tt = 0; tt < 2; ++tt)
#pragma unroll
        for (int ks = 0; ks < 2; ++ks) af[tt][ks] = *(LAS bf16x8*)(Xs + (16 * tt + r) * 72 + 32 * ks + 8 * q);
    float* la = (float*)(p.ws + WS_LA); float* lu = (float*)(p.ws + WS_LU);
    bf16x8 bav[4][2], biv[4][2]; float bbav[4], bbiv[4], lamv[4];
#pragma unroll
    for (int et = 0; et < 4; ++et) {
#pragma unroll
        for (int ks = 0; ks < 2; ++ks) { bav[et][ks] = *(const bf16x8*)(gwt + ((size_t)(0 * 16 + n) * 64 + 16 * et + r) * 64 + 32 * ks + 8 * q); biv[et][ks] = *(const bf16x8*)(gwt + ((size_t)(1 * 16 + n) * 64 + 16 * et + r) * 64 + 32 * ks + 8 * q); }
        const int c = c0 + 16 * et + r;
        bbav[et] = p.in[11][l * 1024 + c]; bbiv[et] = p.in[13][l * 1024 + c]; lamv[et] = p.in[14][l * 1024 + c];
    }
#pragma unroll
    for (int et = 0; et < 4; ++et) {
        bf16x8 ba[2], bi[2];
#pragma unroll
        for (int ks = 0; ks < 2; ++ks) { ba[ks] = bav[et][ks]; bi[ks] = biv[et][ks]; }
        const int e = 16 * et + r, c = c0 + e;
        const float bba = bbav[et], bbi = bbiv[et], lls = logsig(lamv[et]);
        float av[2][4], uv[2][4];
#pragma unroll
        for (int tt = 0; tt < 2; ++tt) {
            f32x4 pa = {0.f, 0.f, 0.f, 0.f}, pi = {0.f, 0.f, 0.f, 0.f};
#pragma unroll
            for (int ks = 0; ks < 2; ++ks) { pa = mfma16(af[tt][ks], ba[ks], pa); pi = mfma16(af[tt][ks], bi[ks], pi); }
#pragma unroll
            for (int j = 0; j < 4; ++j) {
                const int t = 16 * tt + 4 * q + j;
                const float rg = sigmoidf(pa[j] + bba), ig = sigmoidf(pi[j] + bbi);
                const float loga = 8.0f * rg * lls;
                const float a = __expf(loga);
                const float u = __builtin_amdgcn_sqrtf(fmaxf(neg_expm1_small(2.0f * loga), 0.f)) * (ig * Xf[t * 68 + e]);
                la[(size_t)(tok0 + t) * 1024 + c] = a; lu[(size_t)(tok0 + t) * 1024 + c] = u;
                av[tt][j] = a; uv[tt][j] = u;
            }
            asm volatile("" ::: "memory");
        }
        float P = 1.f, H = 0.f;
#pragma unroll
        for (int tt = 0; tt < 2; ++tt)
#pragma unroll
            for (int qq = 0; qq < 4; ++qq) {
                if (q == qq) {
#pragma unroll
                    for (int j = 0; j < 4; ++j) { H = av[tt][j] * H + uv[tt][j]; P *= av[tt][j]; }
                }
                P = __shfl(P, r + 16 * qq); H = __shfl(H, r + 16 * qq);
            }
        if (q == 0) { ((float*)(p.wsl + SL_AGP))[gt * 1024 + c] = P; ((float*)(p.wsl + SL_AGH))[gt * 1024 + c] = H; }
    }
}

__device__ __forceinline__ void fox_attn_unit(const Params& p, int bh, int qb, lds_t lds, int tid, int wave, int lane) {
    const float* proj = (const float*)(p.ws + WS_PROJ);
    const float* cb = (const float*)(p.wsl + SL_CBUF) + bh * SEQ;
    const int b = bh >> 3, h = bh & 7;
    LAS bf16_t* Ks = (LAS bf16_t*)(lds);
    LAS bf16_t* Vt = (LAS bf16_t*)(lds + 9216);
    LAS float* cks = (LAS float*)(lds + 18432);
    const int r = lane & 15, q = lane >> 4;
    const int q0 = qb * 128, qw0 = q0 + 16 * wave, nkv = 2 * (qb + 1);
    const float C2 = 0.125f * LOG2E;
    bf16x8 qf[2];
    {
        const bf16_t* qp = (const bf16_t*)(p.ws + WS_QKV) + (size_t)(b * SEQ + qw0 + r) * 512 + h * 64 + 8 * q;
#pragma unroll
        for (int ks = 0; ks < 2; ++ks) qf[ks] = *(const bf16x8*)(qp + 32 * ks);
    }
    const float cq = cb[qw0 + r];
    float m = -1e30f, lsum = 0.f;
    f32x4 o[4];
#pragma unroll
    for (int i = 0; i < 4; ++i) o[i] = (f32x4){0.f, 0.f, 0.f, 0.f};
    const int lrow = tid >> 3, lch = (tid & 7) * 8;
    const bf16_t* kbase = (const bf16_t*)(p.ws + WS_QKV) + ((size_t)NT + b * SEQ + lrow) * 512 + h * 64 + lch;
    const int vrow = tid & 63, vch = (tid >> 6) * 8;
    const bf16_t* vbase = (const bf16_t*)(p.ws + WS_QKV) + ((size_t)2 * NT + b * SEQ + vrow) * 512 + h * 64 + vch;
    bf16x8 kA = *(const bf16x8*)kbase, vA = *(const bf16x8*)vbase;
    float ckA = tid < 64 ? cb[tid] : 0.f;
    bf16x8 kB = *(const bf16x8*)(kbase + (size_t)64 * 512), vB = *(const bf16x8*)(vbase + (size_t)64 * 512);
    float ckB = tid < 64 ? cb[64 + tid] : 0.f;
    constexpr int FOXBUF = 18432 + 256;
#define FOX_WRITE(KK, VV, CK, bufi, jn) { \
        LAS bf16_t* KsW = (LAS bf16_t*)(lds + (bufi) * FOXBUF); LAS bf16_t* VtW = (LAS bf16_t*)(lds + (bufi) * FOXBUF + 9216); LAS float* cksW = (LAS float*)(lds + (bufi) * FOXBUF + 18432); \
        *(LAS bf16x8*)(KsW + lrow * 72 + lch) = KK; \
        _Pragma("unroll") for (int i = 0; i < 8; ++i) VtW[(vch + i) * 72 + vrow] = (bf16_t)VV[i]; \
        if (tid < 64) cksW[tid] = CK; \
        if ((jn) < nkv) { const size_t off = (size_t)(jn) * 64 * 512; \
            KK = *(const bf16x8*)(kbase + off); VV = *(const bf16x8*)(vbase + off); \
            if (tid < 64) CK = cb[(jn) * 64 + tid]; } }
    __syncthreads();
    FOX_WRITE(kA, vA, ckA, 0, 2)
    asm volatile("s_waitcnt lgkmcnt(0)\n\ts_barrier" ::: "memory");
    for (int j0 = 0; j0 < nkv; j0 += 2) {
        { const int j = j0;
          FOX_WRITE(kB, vB, ckB, 1, j + 3)
          LAS bf16_t* KsX = (LAS bf16_t*)(lds); LAS bf16_t* VtX = (LAS bf16_t*)(lds + 9216); LAS float* cksX = (LAS float*)(lds + 18432);
        if (64 * j <= qw0 + 15) {
            f32x4 s[4]; float mx = -INFINITY;
            bf16x8 kfr[4][2]; f32x4 ckr[4]; s16x4 vlo[4][2], vhi[4][2];
#pragma unroll
            for (int st = 0; st < 4; ++st) {
#pragma unroll
                for (int ks = 0; ks < 2; ++ks) kfr[st][ks] = *(LAS bf16x8*)(KsX + (16 * st + r) * 72 + 32 * ks + 8 * q);
                ckr[st] = *(LAS f32x4*)(cksX + 16 * st + 4 * q);
            }
#pragma unroll
            for (int ds = 0; ds < 4; ++ds)
#pragma unroll
                for (int ks = 0; ks < 2; ++ks) { vlo[ds][ks] = *(LAS s16x4*)(VtX + (16 * ds + r) * 72 + 32 * ks + 4 * q); vhi[ds][ks] = *(LAS s16x4*)(VtX + (16 * ds + r) * 72 + 32 * ks + 16 + 4 * q); }
#pragma unroll
            for (int st = 0; st < 4; ++st) {
                f32x4 acc = {0.f, 0.f, 0.f, 0.f};
#pragma unroll
                for (int ks = 0; ks < 2; ++ks) acc = mfma16(kfr[st][ks], qf[ks], acc);
                const f32x4 ck = ckr[st];
#pragma unroll
                for (int jj = 0; jj < 4; ++jj) {
                    const int kv = 64 * j + 16 * st + 4 * q + jj;
                    float sv = acc[jj] + (cq - ck[jj]);
                    if (64 * j + 63 > qw0) sv = (kv <= qw0 + r) ? sv : -INFINITY;
                    s[st][jj] = sv; mx = fmaxf(mx, sv);
                }
            }
            mx = fmaxf(mx, __shfl_xor(mx, 16)); mx = fmaxf(mx, __shfl_xor(mx, 32));
            const float mnew = fmaxf(m, mx);
            const float alpha = __builtin_amdgcn_exp2f(m - mnew);
            m = mnew;
            float ps = 0.f;
#pragma unroll
            for (int st = 0; st < 4; ++st)
#pragma unroll
                for (int jj = 0; jj < 4; ++jj) { const float e = __builtin_amdgcn_exp2f(s[st][jj] - mnew); s[st][jj] = e; ps += e; }
            lsum = lsum * alpha + ps;
#pragma unroll
            for (int i = 0; i < 4; ++i) o[i] = o[i] * alpha;
            bf16x8 pf[2];
            pf[0] = pack8(s[0], s[1]); pf[1] = pack8(s[2], s[3]);
#pragma unroll
            for (int ds = 0; ds < 4; ++ds)
#pragma unroll
                for (int ks = 0; ks < 2; ++ks) {
                    const s16x4 lo = vlo[ds][ks], hi = vhi[ds][ks];
                    const bf16x8 a = {lo[0], lo[1], lo[2], lo[3], hi[0], hi[1], hi[2], hi[3]};
                    o[ds] = mfma16(a, pf[ks], o[ds]);
                }
        }
          asm volatile("s_waitcnt lgkmcnt(0)\n\ts_barrier" ::: "memory");
        }
        { const int j = j0 + 1;
          if (j + 1 < nkv) FOX_WRITE(kA, vA, ckA, 0, j + 3)
          LAS bf16_t* KsX = (LAS bf16_t*)(lds + FOXBUF); LAS bf16_t* VtX = (LAS bf16_t*)(lds + FOXBUF + 9216); LAS float* cksX = (LAS float*)(lds + FOXBUF + 18432);
        if (64 * j <= qw0 + 15) {
            f32x4 s[4]; float mx = -INFINITY;
            bf16x8 kfr[4][2]; f32x4 ckr[4]; s16x4 vlo[4][2], vhi[4][2];
#pragma unroll
            for (int st = 0; st < 4; ++st) {
#pragma unroll
                for (int ks = 0; ks < 2; ++ks) kfr[st][ks] = *(LAS bf16x8*)(KsX + (16 * st + r) * 72 + 32 * ks + 8 * q);
                ckr[st] = *(LAS f32x4*)(cksX + 16 * st + 4 * q);
            }
#pragma unroll
            for (int ds = 0; ds < 4; ++ds)
#pragma unroll
                for (int ks = 0; ks < 2; ++ks) { vlo[ds][ks] = *(LAS s16x4*)(VtX + (16 * ds + r) * 72 + 32 * ks + 4 * q); vhi[ds][ks] = *(LAS s16x4*)(VtX + (16 * ds + r) * 72 + 32 * ks + 16 + 4 * q); }
#pragma unroll
            for (int st = 0; st < 4; ++st) {
                f32x4 acc = {0.f, 0.f, 0.f, 0.f};
#pragma unroll
                for (int ks = 0; ks < 2; ++ks) acc = mfma16(kfr[st][ks], qf[ks], acc);
                const f32x4 ck = ckr[st];
#pragma unroll
                for (int jj = 0; jj < 4; ++jj) {
                    const int kv = 64 * j + 16 * st + 4 * q + jj;
                    float sv = acc[jj] + (cq - ck[jj]);
                    if (64 * j + 63 > qw0) sv = (kv <= qw0 + r) ? sv : -INFINITY;
                    s[st][jj] = sv; mx = fmaxf(mx, sv);
                }
            }
            mx = fmaxf(mx, __shfl_xor(mx, 16)); mx = fmaxf(mx, __shfl_xor(mx, 32));
            const float mnew = fmaxf(m, mx);
            const float alpha = __builtin_amdgcn_exp2f(m - mnew);
            m = mnew;
            float ps = 0.f;
#pragma unroll
            for (int st = 0; st < 4; ++st)
#pragma unroll
                for (int jj = 0; jj < 4; ++jj) { const float e = __builtin_amdgcn_exp2f(s[st][jj] - mnew); s[st][jj] = e; ps += e; }
            lsum = lsum * alpha + ps;
#pragma unroll
            for (int i = 0; i < 4; ++i) o[i] = o[i] * alpha;
            bf16x8 pf[2];
            pf[0] = pack8(s[0], s[1]); pf[1] = pack8(s[2], s[3]);
#pragma unroll
            for (int ds = 0; ds < 4; ++ds)
#pragma unroll
                for (int ks = 0; ks < 2; ++ks) {
                    const s16x4 lo = vlo[ds][ks], hi = vhi[ds][ks];
                    const bf16x8 a = {lo[0], lo[1], lo[2], lo[3], hi[0], hi[1], hi[2], hi[3]};
                    o[ds] = mfma16(a, pf[ks], o[ds]);
                }
        }
          asm volatile("s_waitcnt lgkmcnt(0)\n\ts_barrier" ::: "memory");
        }
    }
#undef FOX_WRITE
    lsum += __shfl_xor(lsum, 16); lsum += __shfl_xor(lsum, 32);
    const float inv = 1.0f / lsum;
    bf16_t* op = (bf16_t*)(p.ws + WS_FOXO) + (size_t)(b * SEQ + qw0 + r) * 512 + h * 64 + 4 * q;
#pragma unroll
    for (int ds = 0; ds < 4; ++ds) { u32x2 w; w.x = pk2(o[ds][0] * inv, o[ds][1] * inv); w.y = pk2(o[ds][2] * inv, o[ds][3] * inv); *(u32x2*)(op + 16 * ds) = w; }
}

__device__ __forceinline__ void gla_scan_item(const Params& p, int item, int tid) {
    const int bh = item >> 4, e = (item & 15) * 512 + tid, d = e & 63;
    const float* ub = (const float*)(p.ws + WS_GU) + (size_t)bh * 64 * 8192 + e;
    const float* dec = (const float*)(p.wsl + SL_GDEC) + (size_t)bh * 64 * 64 + d;
    bf16_t* sp = (bf16_t*)(p.ws + WS_GS) + (size_t)bh * 64 * 8192 + e;
    float st = 0.f;
#pragma unroll
    for (int n0 = 0; n0 < 64; n0 += 64) {
        float u[64], dc[64];
#pragma unroll
        for (int n = 0; n < 64; ++n) { u[n] = ub[(size_t)(n0 + n) * 8192]; dc[n] = dec[(n0 + n) * 64]; }
#pragma unroll
        for (int n = 0; n < 64; ++n) { sp[(size_t)(n0 + n) * 8192] = f2bf(st); st = dc[n] * st + u[n]; }
    }
}

__device__ __forceinline__ void lru_tilescan_item(const Params& p, int item, int tid) {
    const int gid = item * 512 + tid, b = gid >> 10, c = gid & 1023;
    const float* P = (const float*)(p.wsl + SL_AGP) + (size_t)b * 64 * 1024 + c;
    const float* H = (const float*)(p.wsl + SL_AGH) + (size_t)b * 64 * 1024 + c;
    float* hi = (float*)(p.wsl + SL_HIN) + (size_t)b * 64 * 1024 + c;
    float h = 0.f;
#pragma unroll
    for (int t0 = 0; t0 < 64; t0 += 64) {
        float a[64], u[64];
#pragma unroll
        for (int t = 0; t < 64; ++t) { a[t] = P[(t0 + t) * 1024]; u[t] = H[(t0 + t) * 1024]; }
#pragma unroll
        for (int t = 0; t < 64; ++t) { hi[(t0 + t) * 1024] = h; h = a[t] * h + u[t]; }
    }
}

__device__ __forceinline__ void fox_norm_rows4(const Params& p, int l, int tok0, int stride, int lane) {
    u32x4 w[4];
#pragma unroll
    for (int k = 0; k < 4; ++k) w[k] = *(const u32x4*)((const bf16_t*)(p.ws + WS_FOXO) + (size_t)(tok0 + k * stride) * 512 + lane * 8);
    const float* g = p.in[4] + l * 512 + lane * 8;
    const f32x4 g0 = *(const f32x4*)g, g1 = *(const f32x4*)(g + 4);
#pragma unroll
    for (int k = 0; k < 4; ++k) {
        float v[8];
#pragma unroll
        for (int i = 0; i < 4; ++i) { v[2 * i] = bf2f(w[k][i] & 0xffffu); v[2 * i + 1] = bf2f(w[k][i] >> 16); }
        float s = 0.f;
#pragma unroll
        for (int i = 0; i < 8; ++i) s += v[i] * v[i];
        const float rstd = rsqrtf(wave_sum(s) * (1.0f / 512.0f) + EPS);
        u32x4 ow; ow.x = pk2(v[0] * rstd * g0[0], v[1] * rstd * g0[1]); ow.y = pk2(v[2] * rstd * g0[2], v[3] * rstd * g0[3]);
        ow.z = pk2(v[4] * rstd * g1[0], v[5] * rstd * g1[1]); ow.w = pk2(v[6] * rstd * g1[2], v[7] * rstd * g1[3]);
        *(u32x4*)((bf16_t*)(p.ws + WS_MIX) + (size_t)(tok0 + k * stride) * 2048 + lane * 8) = ow;
    }
}

__device__ __forceinline__ void gla_out_witem(const Params& p, int l, int item, int lane) {
    const float* proj = (const float*)(p.ws + WS_PROJ);
    const int ch = item >> 1, tt = item & 1;
    const int bh = ch >> 6, n = ch & 63, b = bh >> 2, h = bh & 3;
    const int t0 = b * SEQ + n * 32;
    const int r = lane & 15, q = lane >> 4;
    const bf16_t* ab = (const bf16_t*)(p.wsl + SL_GA) + (size_t)ch * 1024;
    const bf16_t* vt = (const bf16_t*)(p.ws + WS_GVT) + (size_t)ch * 4096;
    const bf16_t* qt = (const bf16_t*)(p.wsl + SL_GQT) + (size_t)t0 * 256 + h * 64;
    const bf16_t* sp = (const bf16_t*)(p.ws + WS_GS) + (size_t)ch * 8192;
    const bf16x8 aa = *(const bf16x8*)(ab + (16 * tt + r) * 32 + 8 * q);
    const bf16x8 aq0 = *(const bf16x8*)(qt + (size_t)(16 * tt + r) * 256 + 8 * q), aq1 = *(const bf16x8*)(qt + (size_t)(16 * tt + r) * 256 + 32 + 8 * q);
    f32x4 acc[8];
#pragma unroll
    for (int w = 0; w < 8; ++w) {
        const int v = 16 * w + r;
        const bf16x8 bv = *(const bf16x8*)(vt + v * 32 + 8 * q);
        const bf16x8 bs0 = *(const bf16x8*)(sp + v * 64 + 8 * q), bs1 = *(const bf16x8*)(sp + v * 64 + 32 + 8 * q);
        f32x4 c = mfma16(aa, bv, (f32x4){0.f, 0.f, 0.f, 0.f});
        c = mfma16(aq0, bs0, c); c = mfma16(aq1, bs1, c);
        acc[w] = c;
    }
    float tot[4] = {0.f, 0.f, 0.f, 0.f};
#pragma unroll
    for (int w = 0; w < 8; ++w)
#pragma unroll
        for (int j = 0; j < 4; ++j) {
            float s = acc[w][j] * acc[w][j];
            s += __shfl_xor(s, 1); s += __shfl_xor(s, 2); s += __shfl_xor(s, 4); s += __shfl_xor(s, 8);
            tot[j] += s;
        }
#pragma unroll
    for (int j = 0; j < 4; ++j) {
        const int t = 16 * tt + 4 * q + j;
        const float rstd = rsqrtf(tot[j] * (1.0f / 128.0f) + EPS);
        const float* ggp = proj + (size_t)(t0 + t) * NPROJ + PC_GG + h * 128 + r;
        bf16_t* mp = (bf16_t*)(p.ws + WS_MIX) + (size_t)(t0 + t) * 2048 + 512 + h * 128 + r;
#pragma unroll
        for (int w = 0; w < 8; ++w) {
            const float gn = p.in[7][l * 128 + 16 * w + r];
            const float gg = ggp[16 * w];
            const float y = acc[w][j] * rstd * gn * (gg * sigmoidf(gg));
            mp[16 * w] = f2bf(y);
        }
    }
}

__device__ __forceinline__ float gelu_tanh(float x) {
    const float u = 0.7978845608028654f * (x + 0.044715f * x * x * x);
    const float t = 1.0f - 2.0f * __builtin_amdgcn_rcpf(1.0f + __expf(2.0f * u));
    return 0.5f * x * (1.0f + t);
}

__device__ __forceinline__ void lru_out_item(const Params& p, int l, int gt, lds_t lds, int tid, int wave, int lane) {
    const float* proj = (const float*)(p.ws + WS_PROJ);
    const int tok0 = gt * 32, c = 2 * tid;
    LAS float* part = (LAS float*)(lds);
    LAS float* rs = (LAS float*)(lds + 65536);
    const f32x2* la = (const f32x2*)((const float*)(p.ws + WS_LA) + (size_t)tok0 * 1024 + c);
    const f32x2* lu = (const f32x2*)((const float*)(p.ws + WS_LU) + (size_t)tok0 * 1024 + c);
    const float* lgp = proj + (size_t)tok0 * NPROJ + PC_LG + c;
    f32x2 h = *(const f32x2*)((const float*)(p.wsl + SL_HIN) + (size_t)gt * 1024 + c);
    f32x2 y[32];
    {
        f32x2 av[32], uv[32];
#pragma unroll
        for (int t = 0; t < 32; ++t) y[t] = *(const f32x2*)(lgp + (size_t)t * NPROJ);
#pragma unroll
        for (int t = 0; t < 32; ++t) { av[t] = la[t * 512]; uv[t] = lu[t * 512]; }
#pragma unroll
        for (int t = 0; t < 32; ++t) { y[t][0] = gelu_tanh(y[t][0]); y[t][1] = gelu_tanh(y[t][1]); }
#pragma unroll
        for (int t = 0; t < 32; ++t) {
            h = av[t] * h + uv[t];
            y[t][0] = h[0] * y[t][0]; y[t][1] = h[1] * y[t][1];
            part[t * 512 + tid] = y[t][0] * y[t][0] + y[t][1] * y[t][1];
        }
    }
    __syncthreads();
    {
        const int t = tid >> 4, k0 = tid & 15;
        float s = 0.f;
#pragma unroll 8
        for (int k = 0; k < 32; ++k) s += part[t * 512 + k0 + 16 * k];
        s += __shfl_xor(s, 1); s += __shfl_xor(s, 2); s += __shfl_xor(s, 4); s += __shfl_xor(s, 8);
        if (k0 == 0) rs[t] = rsqrtf(s * (1.0f / 1024.0f) + EPS);
    }
    __syncthreads();
    const f32x2 g = *(const f32x2*)(p.in[15] + l * 1024 + c);
    bf16_t* mix = (bf16_t*)(p.ws + WS_MIX) + (size_t)tok0 * 2048 + 1024 + c;
#pragma unroll
    for (int t = 0; t < 32; ++t) { const float rr = rs[t]; *(unsigned*)(mix + (size_t)t * 2048) = pk2(y[t][0] * rr * g[0], y[t][1] * rr * g[1]); }
    __syncthreads();
}

#define XB_TMO      128
#define XB_XCNT(j)  (256  + 64 * (j))
#define XB_XSUB(j)  (1280 + 64 * (j))
#define XB_XGEN(j)  (2304 + 64 * (j))
#define XB_TOP      3328
#define XB_TOPGEN   3392
#define XCD_BAR_WORDS 3456
#define XB_SPIN_CAP (1u << 18)

__device__ __forceinline__ unsigned xb_ld(unsigned* p)              { return __hip_atomic_load(p, __ATOMIC_RELAXED, __HIP_MEMORY_SCOPE_AGENT); }
__device__ __forceinline__ unsigned xb_add(unsigned* p, unsigned v) { return __hip_atomic_fetch_add(p, v, __ATOMIC_RELAXED, __HIP_MEMORY_SCOPE_AGENT); }
__device__ __forceinline__ unsigned xb_xcc_id() { return (unsigned)__builtin_amdgcn_s_getreg((3 << 11) | 20) & 0xFu; }
#define XB_SPIN(cond, bar) do { unsigned _sp = 0; while (cond) { __builtin_amdgcn_s_sleep(1); \
    if ((++_sp & 255u) == 0u) { if (xb_ld(&(bar)[XB_TMO])) break; if (_sp > XB_SPIN_CAP) { atomicAdd(&(bar)[XB_TMO], 1u); break; } } } } while (0)

struct XcdBarrier {
    unsigned* bar; unsigned x;
    volatile LAS unsigned* st;
};

__device__ __forceinline__ XcdBarrier xcd_barrier_post(unsigned* bar, volatile LAS unsigned* st) {
    XcdBarrier b; b.bar = bar; b.x = xb_xcc_id(); b.st = st;
    if (threadIdx.x == 0) (void)xb_add(&bar[XB_XCNT(b.x)], 1u);
    return b;
}
__device__ __forceinline__ void xcd_barrier_complete(unsigned* bar, unsigned x, unsigned& nloc, unsigned& nx) {
    const unsigned G = gridDim.x * gridDim.y * gridDim.z;
    unsigned sum, cnt, mine, sp = 0u;
    for (;;) {
        sum = 0u; cnt = 0u; mine = 0u;
#pragma unroll
        for (unsigned j = 0; j < 16; ++j) { const unsigned c = xb_ld(&bar[XB_XCNT(j)]); sum += c; cnt += (c > 0u) ? 1u : 0u; mine = (j == x) ? c : mine; }
        if (sum == G) break;
        __builtin_amdgcn_s_sleep(1);
        if ((++sp & 255u) == 0u) { if (xb_ld(&bar[XB_TMO])) break; if (sp > XB_SPIN_CAP) { atomicAdd(&bar[XB_TMO], 1u); break; } }
    }
    nloc = mine > 0u ? mine : 1u; nx = cnt > 0u ? cnt : 1u;
}

__device__ __forceinline__ void xcd_barrier(const XcdBarrier& b) {
    asm volatile("s_waitcnt vmcnt(0)" ::: "memory");
    __syncthreads();
    if (threadIdx.x == 0) {
        unsigned* bar = b.bar;
        __builtin_amdgcn_s_waitcnt(0);
        unsigned nloc = b.st[0], nx = b.st[1];
        if (nloc == 0u) { xcd_barrier_complete(bar, b.x, nloc, nx); b.st[0] = nloc; b.st[1] = nx; }
        const unsigned old = xb_add(&bar[XB_XSUB(b.x)], 1u);
        const unsigned gen = old / nloc;
        if (old + 1u == (gen + 1u) * nloc) {
            __builtin_amdgcn_fence(__ATOMIC_RELEASE, "agent");
            asm volatile("s_waitcnt vmcnt(0)" ::: "memory");
            const unsigned og = xb_add(&bar[XB_TOP], 1u);
            const unsigned tg = og / nx;
            if (og + 1u == (tg + 1u) * nx) xb_add(&bar[XB_TOPGEN], 1u);
            else XB_SPIN(xb_ld(&bar[XB_TOPGEN]) == tg, bar);
            __builtin_amdgcn_fence(__ATOMIC_ACQUIRE, "agent");
            xb_add(&bar[XB_XGEN(b.x)], 1u);
            asm volatile("s_waitcnt vmcnt(0)" ::: "memory");
        } else {
            XB_SPIN(xb_ld(&bar[XB_XGEN(b.x)]) == gen, bar);
            __builtin_amdgcn_fence(__ATOMIC_ACQUIRE, "agent");
            asm volatile("s_waitcnt vmcnt(0)" ::: "memory");
        }
    }
    __syncthreads();
}

__global__ void __launch_bounds__(512, 2) hymba_fwd(Params p0) {
    extern __shared__ __attribute__((aligned(16))) unsigned char lds_raw[];
    cg::grid_group grid = cg::this_grid();
    const int G = gridDim.x, bid = blockIdx.x, ngw = G * 8;
    volatile LAS unsigned* bst = (volatile LAS unsigned*)((lds_t)lds_raw + (LDS_BYTES - 64));
    if (threadIdx.x < 16) bst[threadIdx.x] = 0u;
    __syncthreads();
    const XcdBarrier bar = xcd_barrier_post((unsigned*)(p0.ws + WS_CTL), bst);
#define PHASE_BEGIN \
    int tid = threadIdx.x; asm volatile("" : "+v"(tid)); \
    const int lane = tid & 63, wave = __builtin_amdgcn_readfirstlane(tid >> 6); \
    unsigned lo_ = 0; asm volatile("" : "+s"(lo_)); lds_t lds = (lds_t)lds_raw + lo_; \
    Params p = p0; asm volatile("" : "+s"(p.ws)); p.wsl = p.ws + WS_SMALL + (size_t)lcur * SMALL_BYTES; \
    GAS unsigned char* ws = p.ws; const int gw = bid * 8 + wave; (void)gw; (void)lane; (void)lds; (void)ws;

#pragma clang loop unroll(disable)
    for (int l = 0; l < DEPTH; ++l) {
        const int lcur = l;
        if (l == 0) {
            {
                PHASE_BEGIN
                phase_wconv(p, 0, 1, gw, ngw, lane);
                for (int m = gw; m < NT; m += ngw) prep_row(p.in[0] + (size_t)m * DM, (bf16_t*)(ws + WS_HB) + (size_t)m * DM, (float*)(ws + WS_SS1), m, lane, p.in[1]);
            }
            if (p0.ws == nullptr) grid.sync();
            xcd_barrier(bar);
        }
        {
            PHASE_BEGIN
            pg8::Gemm g{(const bf16_t*)(ws + WS_HB), (const bf16_t*)(ws + WS_WIN), NT, NPROJ, DM}; pg8::StaticOrder S; S.init(NT, NPROJ, G, bid);
            gate_wt_prep(p, l, bid * 512 + tid);
            pg8::rstd_table((LAS float*)(lds + 131072), (const float*)(ws + WS_SS1 + (size_t)l * MiB), S, tid);
            pg8::EpiStoreF32 E{(float*)(ws + WS_PROJ), NPROJ, (const LAS float*)(lds + 131072), 0, (bf16_t*)(ws + WS_QKV)};
            pg8::gemm_phase<pg8::EpiStoreF32, pg8::StaticOrder, true, true>(lds, g, S, E, tid);
            { const int nfull = (NT / 256) * (NPROJ / 256) % G; if (nfull > 0 && bid >= nfull) phase_wconv(p, l, 2 | 4, (bid - nfull) * 8 + wave, (G - nfull) * 8, lane); else if (nfull == 0) phase_wconv(p, l, 2 | 4, gw, ngw, lane); }
        }
        xcd_barrier(bar);
        {
            PHASE_BEGIN
            if (gw < 32) fox_cumsum(p, l, gw, lane);
            {
                lds_t wl = lds + wave * 18432;
                if (G == 256) {
                    if (wave < 4) { gla_prep_witem(p, l, bid * 4 + wave, wl, lane); lru_prep_witem(p, l, bid * 16 + wave, wl, lane); }
                    else for (int k = 0; k < 3; ++k) lru_prep_witem(p, l, bid * 16 + 4 + (wave - 4) * 3 + k, wl, lane);
                } else
                for (int it = gw; it < 1024 + 4096; it += ngw) {
                    if (it < 1024) gla_prep_witem(p, l, it, wl, lane);
                    else lru_prep_witem(p, l, it - 1024, wl, lane);
                }
            }
        }
        xcd_barrier(bar);
        {
            PHASE_BEGIN
            for (int it = bid; it < 256; it += G) {
                const int bh = it >> 3, s = it & 7;
                fox_attn_unit(p, bh, 15 - s, lds, tid, wave, lane);
                fox_attn_unit(p, bh, s, lds, tid, wave, lane);
            }
            for (int it = bid; it < 256; it += G) gla_scan_item(p, it, tid);
            for (int it = G - 1 - bid; it < 8; it += G) lru_tilescan_item(p, it, tid);
        }
        xcd_barrier(bar);
        {
            PHASE_BEGIN
            for (int it = bid; it < 256; it += G) lru_out_item(p, l, it, lds, tid, wave, lane);
            for (int it = gw; it < 2048; it += ngw) gla_out_witem(p, l, it, lane);
            if (NT % (4 * ngw) == 0) { for (int tok = gw; tok < NT; tok += 4 * ngw) fox_norm_rows4(p, l, tok, ngw, lane); }
            else for (int tok = gw; tok < NT; tok += ngw) fox_norm_rows4(p, l, tok, 0, lane);
        }
        xcd_barrier(bar);
        {
            PHASE_BEGIN
            const float* xin = (l == 0) ? p.in[0] : (const float*)(ws + WS_XW);
            pg8::Gemm g{(const bf16_t*)(ws + WS_MIX), (const bf16_t*)(ws + WS_WOUT), NT, DM, DM}; pg8::StaticOrder S; S.init(NT, DM, G, bid);
            pg8::EpiResid E{xin, (float*)(ws + WS_XW), (bf16_t*)(ws + WS_HB), (float*)(ws + WS_SS2 + (size_t)l * MiB), p.in[17] + l * DM, DM};
            pg8::gemm_phase<pg8::EpiResid, pg8::StaticOrder, true, true>(lds, g, S, E, tid);
        }
        xcd_barrier(bar);
        {
            PHASE_BEGIN
            pg8::Gemm g{(const bf16_t*)(ws + WS_HB), (const bf16_t*)(ws + WS_WGU), NT, 2 * FFH, DM}; pg8::StaticOrder S; S.init(NT, 2 * FFH, G, bid);
            pg8::rstd_table((LAS float*)(lds + 131072), (const float*)(ws + WS_SS2 + (size_t)l * MiB), S, tid);
            pg8::EpiSwiglu E{(bf16_t*)(ws + WS_PROJ), FFH, (const LAS float*)(lds + 131072), 0};
            pg8::gemm_phase<pg8::EpiSwiglu, pg8::StaticOrder, true, true>(lds, g, S, E, tid);
            { const int nfull = (NT / 256) * (2 * FFH / 256) % G; const int msk = 8 | (l + 1 < DEPTH ? 1 : 0); const int ln = (l + 1 < DEPTH) ? l + 1 : l;
              if (nfull > 0 && bid >= nfull) { phase_wconv(p, l, 8, (bid - nfull) * 8 + wave, (G - nfull) * 8, lane); if (msk & 1) phase_wconv(p, ln, 1, (bid - nfull) * 8 + wave, (G - nfull) * 8, lane); }
              else if (nfull == 0) { phase_wconv(p, l, 8, gw, ngw, lane); if (msk & 1) phase_wconv(p, ln, 1, gw, ngw, lane); } }
        }
        xcd_barrier(bar);
        {
            PHASE_BEGIN
            pg8::Gemm g{(const bf16_t*)(ws + WS_PROJ), (const bf16_t*)(ws + WS_WDN), NT, DM, FFH}; pg8::StaticOrder S; S.init(NT, DM, G, bid);
            pg8::EpiResid E{(const float*)(ws + WS_XW), (float*)(ws + WS_XW), (l < DEPTH - 1) ? (bf16_t*)(ws + WS_HB) : (bf16_t*)nullptr, (float*)(ws + WS_SS1 + (size_t)(l + 1) * MiB), p.in[1] + (l < DEPTH - 1 ? l + 1 : 0) * DM, DM};
            pg8::gemm_phase<pg8::EpiResid, pg8::StaticOrder, true, true>(lds, g, S, E, tid);
        }
        xcd_barrier(bar);
    }
    {
        const int lcur = 0;
        PHASE_BEGIN
        if (NT % (4 * ngw) == 0) {
            const f32x4* gr = (const f32x4*)p.in[21] + lane;
            const float* ssb = (const float*)(ws + WS_SS1 + (size_t)DEPTH * MiB);
            for (int m0 = gw; m0 < NT; m0 += 4 * ngw) {
                f32x4 xv[4][8]; float pv[4];
#pragma unroll
                for (int k = 0; k < 4; ++k) {
                    const int m = m0 + k * ngw;
                    pv[k] = lane < 32 ? ssb[((size_t)(lane >> 2) * 8192 + m) * 4 + (lane & 3)] : 0.f;
                    const f32x4* xr = (const f32x4*)((const float*)(ws + WS_XW) + (size_t)m * DM) + lane;
#pragma unroll
                    for (int j = 0; j < 8; ++j) xv[k][j] = xr[64 * j];
                }
                f32x4 gv[8];
#pragma unroll
                for (int j = 0; j < 8; ++j) gv[j] = gr[64 * j];
#pragma unroll
                for (int k = 0; k < 4; ++k) {
                    const int m = m0 + k * ngw;
                    const float rstd = rsqrtf(wave_sum(pv[k]) * (1.0f / 2048.0f) + EPS);
                    f32x4* orow = (f32x4*)(p.out + (size_t)m * DM) + lane;
#pragma unroll
                    for (int j = 0; j < 8; ++j) orow[64 * j] = xv[k][j] * rstd * gv[j];
                }
            }
        } else
        for (int m = gw; m < NT; m += ngw) { const float sv = wave_sum(lane < 32 ? ((const float*)(ws + WS_SS1 + (size_t)DEPTH * MiB))[((size_t)(lane >> 2) * 8192 + m) * 4 + (lane & 3)] : 0.f);
            final_row((const float*)(ws + WS_XW) + (size_t)m * DM, p.in[21], p.out + (size_t)m * DM, sv, lane); }
    }
}

extern "C" void kernel_launch(void* const* d_in, const int* in_sizes, int n_in, void* d_out, int out_size, void* d_ws, size_t ws_size, hipStream_t stream) {
    static int grid_blocks = 0;
    if (grid_blocks == 0) {
        if (n_in != 22 || ws_size < WS_END) { fprintf(stderr, "kernel_launch: unexpected n_in %d / ws_size %zu\n", n_in, ws_size); grid_blocks = -1; return; }
        int dev = 0, cus = 0, per_cu = 0;
        hipGetDevice(&dev);
        hipDeviceGetAttribute(&cus, hipDeviceAttributeMultiprocessorCount, dev);
        hipFuncSetAttribute((const void*)hymba_fwd, hipFuncAttributeMaxDynamicSharedMemorySize, LDS_BYTES);
        hipOccupancyMaxActiveBlocksPerMultiprocessor(&per_cu, (const void*)hymba_fwd, 512, LDS_BYTES);
        if (per_cu < 1) { fprintf(stderr, "kernel_launch: occupancy query says %d blocks per CU\n", per_cu); per_cu = 1; }
        (void)hipGetLastError();
        grid_blocks = cus * 1;
    }
    if (grid_blocks < 0) return;
    Params p{};
    for (int i = 0; i < 22; ++i) p.in[i] = (const float*)d_in[i];
    p.out = (float*)d_out; p.ws = (GAS unsigned char*)d_ws;
    if (hipMemsetAsync((unsigned char*)d_ws + WS_CTL, 0, CTL_BYTES, stream) != hipSuccess) { fprintf(stderr, "kernel_launch: memset failed\n"); return; }
    void* args[] = {&p};
    hipError_t e = hipLaunchCooperativeKernel((const void*)hymba_fwd, dim3(grid_blocks), dim3(512), args, LDS_BYTES, stream);
    if (e != hipSuccess) fprintf(stderr, "cooperative launch failed: %s (grid %d)\n", hipGetErrorString(e), grid_blocks);
}
```

```cpp
#include <hip/hip_runtime.h>
#include <hip/hip_cooperative_groups.h>
#include <cstdio>
#include <cstdint>
namespace cg = cooperative_groups;
namespace pg8 {
#define PG8_LAS __attribute__((address_space(3)))
typedef unsigned short bf16_t;
typedef short bf16x8 __attribute__((ext_vector_type(8)));
typedef float f32x4 __attribute__((ext_vector_type(4)));
typedef unsigned u32x4 __attribute__((ext_vector_type(4)));
constexpr int BM = 256, BK = 64, HALF = 128, HTB = HALF * BK * 2  , STAGE_BYTES = 8 * HTB, NXCD = 8, WGM = 8;

__host__ __device__ __forceinline__ int lds_byte(int r, int c) { const int st = (r >> 4) * 2 + (c >> 5), rr = r & 15, cc = c & 31, ob = rr * 64 + cc * 2; return st * 1024 + (ob ^ (((ob >> 9) & 1) << 5)); }
__host__ __device__ __forceinline__ void stage_rc(int b, int& R, int& C) { const int st = b / 1024, sb = b % 1024, swz = sb ^ (((sb >> 9) & 1) << 5); R = (st >> 1) * 16 + swz / 64; C = (st & 1) * 32 + (swz % 64) / 2; }
__host__ __device__ __forceinline__ int perm32(int rho) { const int n = rho >> 4, i = rho & 15; return 8 * (i >> 2) + 4 * n + (i & 3); }

struct Unit { int pm, pn; };
struct Gemm { const bf16_t* A; const bf16_t* Bt; int M, N, K; };

struct StaticOrder {
    int nM, nN, nwg, G, c;
    __host__ __device__ void init(int M, int N, int G_, int c_) { nM = M / BM; nN = N / BM; nwg = nM * nN; G = G_; c = c_; }
    __host__ __device__ bool next(int i, Unit& u) const {
        const long L = (long)i * G + c; if (L >= nwg) return false;
        int wgid = (int)L; { const int q = nwg / NXCD, r = nwg % NXCD, xcd = wgid % NXCD, off = wgid / NXCD; wgid = (xcd < r ? xcd * (q + 1) : r * (q + 1) + (xcd - r) * q) + off; }
        const int nig = WGM * nN, gid = wgid / nig, fm = gid * WGM, gsz = (nM - fm) < WGM ? (nM - fm) : WGM;
        u.pm = fm + ((wgid % nig) % gsz); u.pn = (wgid % nig) / gsz; return true;
    }
    __device__ __forceinline__ void a_ready(const Unit&) const {}
    __device__ __forceinline__ void done(const Unit&) const {}
};

typedef unsigned u32x2 __attribute__((ext_vector_type(2)));
__device__ __forceinline__ unsigned cvt_pk_bf16(float lo, float hi) { unsigned r; asm("v_cvt_pk_bf16_f32 %0, %1, %2" : "=v"(r) : "v"(lo), "v"(hi)); return r; }
__device__ __forceinline__ float ssp_sum(const float* p, int row) {
    float s = 0.f;
#pragma unroll
    for (int i = 0; i < 8; ++i) { const f32x4 v = *(const f32x4*)(p + ((size_t)i * 8192 + row) * 4); s += (v[0] + v[1]) + (v[2] + v[3]); }
    return s;
}
template <class Sched> __device__ __forceinline__ void rstd_table(PG8_LAS float* rtab, const float* ss, const Sched& S, int tid) {
    float v[4]; bool ok[4];
#pragma unroll
    for (int k = 0; k < 4; ++k) { const int i = 2 * k + (tid >> 8); Unit u; ok[k] = S.next(i, u); v[k] = ok[k] ? ssp_sum(ss, u.pm * BM + (tid & 255)) : 0.f; }
#pragma unroll
    for (int k = 0; k < 4; ++k) if (ok[k]) rtab[(2 * k + (tid >> 8)) * 256 + (tid & 255)] = rsqrtf(v[k] * (1.0f / 2048.0f) + 1e-6f);
    __syncthreads();
}
#define PG8_ROW_RSTD(rs, ss, row0) float rs[2][4]; { const int lane_ = (int)(threadIdx.x & 63u); \
    const float v0_ = rsqrtf(ssp_sum((ss), (row0) + (lane_ >> 4) * 16) * (1.0f / 2048.0f) + 1e-6f), v1_ = rsqrtf(ssp_sum((ss), (row0) + HALF + (lane_ >> 4) * 16) * (1.0f / 2048.0f) + 1e-6f); \
    _Pragma("unroll") for (int m_ = 0; m_ < 4; ++m_) { rs[0][m_] = __shfl(v0_, (lane_ & 15) + 16 * m_); rs[1][m_] = __shfl(v1_, (lane_ & 15) + 16 * m_); } }
struct EpiStoreF32 {
    static constexpr bool PERM = false, AFTER_DRAIN = false;
    float* O; int ldc; const PG8_LAS float* rtab; mutable int ui;
    bf16_t* qkv;
    __device__ __forceinline__ void operator()(const f32x4 (&acc)[2][2][4][2], const Unit& u, int wr, int wc, int fr, int fq) const {
        const int row0 = u.pm * BM + wr * 64 + fr, col0 = u.pn * BM + wc * 32 + 4 * fq;
        const PG8_LAS float* rt = rtab + ui * 256 + wr * 64 + fr; ++ui;
#pragma unroll
        for (int ai = 0; ai < 2; ++ai)
#pragma unroll
            for (int m = 0; m < 4; ++m) { const int row = row0 + ai * HALF + m * 16; float* rowp = O + (size_t)row * ldc + col0;
                const float rs = rt[ai * HALF + m * 16];
                if (u.pn < 6 || (u.pn >> 1) == 4) {
                    const float sc = (u.pn < 2) ? 0.125f * 1.4426950408889634f : 1.0f;
                    bf16_t* bp = qkv + ((size_t)(u.pn < 6 ? (u.pn >> 1) : 3) * 8192 + row) * 512 + (u.pn & 1) * 256 + wc * 32 + 4 * fq;
#pragma unroll
                    for (int bj = 0; bj < 2; ++bj)
#pragma unroll
                        for (int n = 0; n < 2; ++n) { f32x4 v = acc[ai][bj][m][n] * rs; if (u.pn < 2) v = v * sc;
                            u32x2 w; w.x = cvt_pk_bf16(v[0], v[1]); w.y = cvt_pk_bf16(v[2], v[3]); *(u32x2*)(bp + bj * HALF + n * 16) = w; }
                } else {
#pragma unroll
                for (int bj = 0; bj < 2; ++bj)
#pragma unroll
                    for (int n = 0; n < 2; ++n) *(f32x4*)(rowp + bj * HALF + n * 16) = acc[ai][bj][m][n] * rs; } }
    }
};
struct EpiResid {
    static constexpr bool PERM = false, AFTER_DRAIN = false;
    const float* base; float* out; bf16_t* xb; float* ss; const float* gain; int ldc;
    __device__ __forceinline__ void operator()(const f32x4 (&acc)[2][2][4][2], const Unit& u, int wr, int wc, int fr, int fq) const {
        const int row0 = u.pm * BM + wr * 64 + fr, col0 = u.pn * BM + wc * 32 + 4 * fq;
        f32x4 gv[2][2];
#pragma unroll
        for (int bj = 0; bj < 2; ++bj)
#pragma unroll
            for (int n = 0; n < 2; ++n) gv[bj][n] = *(const f32x4*)(gain + col0 + bj * HALF + n * 16);
#pragma unroll
        for (int ai = 0; ai < 2; ++ai) {
            f32x4 pre[4][2][2];
#pragma unroll
            for (int m = 0; m < 4; ++m)
#pragma unroll
                for (int bj = 0; bj < 2; ++bj)
#pragma unroll
                    for (int n = 0; n < 2; ++n) pre[m][bj][n] = *(const f32x4*)(base + (size_t)(row0 + ai * HALF + m * 16) * ldc + col0 + bj * HALF + n * 16);
#pragma unroll
            for (int m = 0; m < 4; ++m) { const int row = row0 + ai * HALF + m * 16; const size_t off = (size_t)row * ldc + col0; float s = 0.f;
#pragma unroll
                for (int bj = 0; bj < 2; ++bj)
#pragma unroll
                    for (int n = 0; n < 2; ++n) { const f32x4 b = pre[m][bj][n]; const f32x4 v = b + acc[ai][bj][m][n];
                        *(f32x4*)(out + off + bj * HALF + n * 16) = v; s += (v[0] * v[0] + v[1] * v[1]) + (v[2] * v[2] + v[3] * v[3]);
                        if (xb) { const f32x4 y = v * gv[bj][n]; u32x2 w; w.x = cvt_pk_bf16(y[0], y[1]); w.y = cvt_pk_bf16(y[2], y[3]); *(u32x2*)(xb + off + bj * HALF + n * 16) = w; } }
                s += __shfl_xor(s, 16); s += __shfl_xor(s, 32);
                if (fq == 0) ss[((size_t)u.pn * 8192 + row) * 4 + wc] = s; }
            asm volatile("" ::: "memory");
        }
    }
};
struct EpiSwiglu {
    static constexpr bool PERM = true, AFTER_DRAIN = false;
    bf16_t* O; int ldc; const PG8_LAS float* rtab; mutable int ui;
    __device__ __forceinline__ void operator()(const f32x4 (&acc)[2][2][4][2], const Unit& u, int wr, int wc, int fr, int fq) const {
        const int row0 = u.pm * BM + wr * 64 + fr, col0 = u.pn * HALF + wc * 32 + 8 * fq;
        const PG8_LAS float* rt = rtab + ui * 256 + wr * 64 + fr; ++ui;
#pragma unroll
        for (int ai = 0; ai < 2; ++ai)
#pragma unroll
            for (int m = 0; m < 4; ++m) {
                const float rs = rt[ai * HALF + m * 16];
                float h[8];
#pragma unroll
                for (int n = 0; n < 2; ++n)
#pragma unroll
                    for (int e = 0; e < 4; ++e) { const float g = acc[ai][0][m][n][e] * rs, up = acc[ai][1][m][n][e] * rs; h[n * 4 + e] = g * __builtin_amdgcn_rcpf(1.0f + __builtin_amdgcn_exp2f(g * -1.4426950408889634f)) * up; }
                u32x4 w; w.x = cvt_pk_bf16(h[0], h[1]); w.y = cvt_pk_bf16(h[2], h[3]); w.z = cvt_pk_bf16(h[4], h[5]); w.w = cvt_pk_bf16(h[6], h[7]);
                *(u32x4*)(O + (size_t)(row0 + ai * HALF + m * 16) * ldc + col0) = w; }
    }
};
template <class Epi, class Sched, bool ALIGN_EPI = false, bool SP2 = false>
__device__ __forceinline__ void gemm_phase(PG8_LAS unsigned char* lds, const Gemm g, const Sched& S, const Epi& E, const int tid) {
    const int wid = __builtin_amdgcn_readfirstlane(tid >> 6), lane = tid & 63, wr = wid >> 2, wc = wid & 3, fr = lane & 15, fq = lane >> 4;
    const int K = g.K, nt = K / BK;
    unsigned voffA[2], voffB[2];
#pragma unroll
    for (int i = 0; i < 2; ++i) { int R, C; stage_rc(tid * 16 + i * 8192, R, C); const int Rb = Epi::PERM ? ((R & ~31) + perm32(R & 31)) : R;
        voffA[i] = (unsigned)(R * K + C) * 2u; voffB[i] = (unsigned)(Rb * K + C) * 2u; }
    const size_t kstep = (size_t)(BK * 2);
    const size_t hstep = (size_t)HALF * K * 2;
    const size_t tstep = 2 * hstep;
    const unsigned ldsw = (unsigned)wid * 1024u;
    const int aoff = lds_byte(wr * 64 + fr, fq * 8), boff = lds_byte(wc * 32 + fr, fq * 8);
#define PG8_SA(b, h) (((b) * 2 + (h)) * HTB)
#define PG8_SB(b, h) ((4 + (b) * 2 + (h)) * HTB)
#define PG8_STAGE(bufoff, gbase, voff) do { _Pragma("unroll") for (int _i = 0; _i < 2; ++_i) \
        __builtin_amdgcn_global_load_lds((const unsigned*)((const char*)(gbase) + (voff)[_i]), (PG8_LAS unsigned*)(lds + (bufoff) + ldsw + _i * 8192), 16, 0, 0); } while (0)
#define PG8_LDA(dst, b, h) do { _Pragma("unroll") for (int m = 0; m < 4; ++m) _Pragma("unroll") for (int k = 0; k < 2; ++k) dst[m][k] = *(const PG8_LAS bf16x8*)(lds + PG8_SA(b, h) + aoff + m * 2048 + k * 1024); } while (0)
#define PG8_LDB(dst, b, h) do { _Pragma("unroll") for (int n = 0; n < 2; ++n) _Pragma("unroll") for (int k = 0; k < 2; ++k) dst[n][k] = *(const PG8_LAS bf16x8*)(lds + PG8_SB(b, h) + boff + n * 2048 + k * 1024); } while (0)
#define PG8_MMA(ai, bj, At, Bt) do { __builtin_amdgcn_s_setprio(1); _Pragma("unroll") for (int m = 0; m < 4; ++m) _Pragma("unroll") for (int n = 0; n < 2; ++n) _Pragma("unroll") for (int k = 0; k < 2; ++k) \
        acc[ai][bj][m][n] = __builtin_amdgcn_mfma_f32_16x16x32_bf16(Bt[n][k], At[m][k], acc[ai][bj][m][n], 0, 0, 0); __builtin_amdgcn_s_setprio(0); } while (0)
#define PG8_WAIT_V(n) asm volatile("s_waitcnt vmcnt(" #n ")" ::: "memory")
#define PG8_WAIT_L(n) asm volatile("s_waitcnt lgkmcnt(" #n ")" ::: "memory")
#define PG8_BAR __builtin_amdgcn_s_barrier()
#define PG8_SCHED __builtin_amdgcn_sched_barrier(0)
    Unit cur, nxt; int ui = 0;
    if (!S.next(0, cur)) return;
    f32x4 acc[2][2][4][2];
#pragma unroll
    for (int a = 0; a < 2; ++a)
#pragma unroll
        for (int b = 0; b < 2; ++b)
#pragma unroll
            for (int m = 0; m < 4; ++m)
#pragma unroll
                for (int n = 0; n < 2; ++n) acc[a][b][m][n] = (f32x4){0.f, 0.f, 0.f, 0.f};
    bf16x8 At[4][2], B0[2][2], B1[2][2];
    const char* cA = (const char*)g.A + (size_t)cur.pm * tstep; const char* cB = (const char*)g.Bt + (size_t)cur.pn * tstep;
    S.a_ready(cur);
    if constexpr (SP2) {
        PG8_STAGE(PG8_SB(0, 0), cB, voffB); PG8_STAGE(PG8_SB(0, 1), cB + hstep, voffB); PG8_STAGE(PG8_SA(0, 0), cA, voffA); PG8_STAGE(PG8_SA(0, 1), cA + hstep, voffA);
        if (wr == 1) PG8_BAR;
        PG8_WAIT_V(2); PG8_BAR;
        PG8_STAGE(PG8_SB(1, 0), cB + kstep, voffB); PG8_STAGE(PG8_SA(1, 0), cA + kstep, voffA); PG8_STAGE(PG8_SB(1, 1), cB + hstep + kstep, voffB);
        PG8_WAIT_V(6); PG8_BAR;
    } else {
        PG8_STAGE(PG8_SB(0, 0), cB, voffB); PG8_STAGE(PG8_SA(0, 0), cA, voffA); PG8_STAGE(PG8_SB(0, 1), cB + hstep, voffB); PG8_STAGE(PG8_SA(0, 1), cA + hstep, voffA);
        if (wr == 1) PG8_BAR;
        PG8_WAIT_V(4); PG8_BAR;
        PG8_STAGE(PG8_SB(1, 0), cB + kstep, voffB); PG8_STAGE(PG8_SA(1, 0), cA + kstep, voffA); PG8_STAGE(PG8_SB(1, 1), cB + hstep + kstep, voffB);
        PG8_WAIT_V(6); PG8_BAR;
    }
    for (;;) {
        const bool has_next = S.next(ui + 1, nxt);
        const char* nA = has_next ? (const char*)g.A + (size_t)nxt.pm * tstep : cA; const char* nB = has_next ? (const char*)g.Bt + (size_t)nxt.pn * tstep : cB;
        for (int t = 0; t < nt; t += 2) {
            const bool last = (t == nt - 2);
            const char* a1 = cA + (size_t)(t + 1) * kstep;
            const char* a2 = last ? nA : cA + (size_t)(t + 2) * kstep; const char* b2 = last ? nB : cB + (size_t)(t + 2) * kstep;
            const char* a3 = a2 + kstep; const char* b3 = b2 + kstep;
            if (last && has_next) S.a_ready(nxt);
            if constexpr (SP2) {
            PG8_LDB(B0, 0, 0); PG8_LDB(B1, 0, 1); PG8_SCHED; PG8_LDA(At, 0, 0); PG8_STAGE(PG8_SA(1, 1), a1 + hstep, voffA);
            PG8_WAIT_V(8); PG8_WAIT_L(0); PG8_BAR; PG8_MMA(0, 0, At, B0); PG8_MMA(0, 1, At, B1); PG8_BAR; PG8_SCHED;
            PG8_LDA(At, 0, 1); PG8_STAGE(PG8_SB(0, 0), b2, voffB); PG8_STAGE(PG8_SB(0, 1), b2 + hstep, voffB); PG8_STAGE(PG8_SA(0, 0), a2, voffA);
            PG8_WAIT_V(8); PG8_WAIT_L(0); PG8_BAR; PG8_MMA(1, 0, At, B0); PG8_MMA(1, 1, At, B1); PG8_BAR; PG8_SCHED;
            PG8_LDB(B0, 1, 0); PG8_LDB(B1, 1, 1); PG8_SCHED; PG8_LDA(At, 1, 0); PG8_STAGE(PG8_SA(0, 1), a2 + hstep, voffA);
            PG8_WAIT_V(8); PG8_WAIT_L(0); PG8_BAR; PG8_MMA(0, 0, At, B0); PG8_MMA(0, 1, At, B1); PG8_BAR; PG8_SCHED;
            PG8_LDA(At, 1, 1); PG8_STAGE(PG8_SB(1, 0), b3, voffB); PG8_STAGE(PG8_SB(1, 1), b3 + hstep, voffB); PG8_STAGE(PG8_SA(1, 0), a3, voffA);
            PG8_WAIT_V(8); PG8_WAIT_L(0); PG8_BAR; PG8_MMA(1, 0, At, B0); PG8_MMA(1, 1, At, B1); PG8_BAR; PG8_SCHED;
            } else {
            PG8_LDB(B0, 0, 0); PG8_SCHED; PG8_LDA(At, 0, 0); PG8_STAGE(PG8_SA(1, 1), a1 + hstep, voffA);
            PG8_WAIT_L(8); PG8_BAR; PG8_WAIT_L(0); PG8_MMA(0, 0, At, B0); PG8_BAR; PG8_SCHED;
            PG8_LDB(B1, 0, 1); PG8_STAGE(PG8_SB(0, 0), b2, voffB);
            PG8_BAR; PG8_WAIT_L(0); PG8_MMA(0, 1, At, B1); PG8_BAR;
            PG8_LDA(At, 0, 1); PG8_STAGE(PG8_SA(0, 0), a2, voffA);
            PG8_BAR; PG8_WAIT_L(0); PG8_MMA(1, 0, At, B0); PG8_BAR; PG8_SCHED;
            PG8_STAGE(PG8_SB(0, 1), b2 + hstep, voffB);
            PG8_WAIT_V(6); PG8_BAR; PG8_MMA(1, 1, At, B1); PG8_BAR;
            PG8_LDB(B0, 1, 0); PG8_SCHED; PG8_LDA(At, 1, 0); PG8_STAGE(PG8_SA(0, 1), a2 + hstep, voffA);
            PG8_WAIT_L(8); PG8_BAR; PG8_WAIT_L(0); PG8_MMA(0, 0, At, B0); PG8_BAR; PG8_SCHED;
            PG8_LDB(B1, 1, 1); PG8_STAGE(PG8_SB(1, 0), b3, voffB);
            PG8_BAR; PG8_WAIT_L(0); PG8_MMA(0, 1, At, B1); PG8_BAR;
            PG8_LDA(At, 1, 1); PG8_STAGE(PG8_SA(1, 0), a3, voffA);
            PG8_BAR; PG8_WAIT_L(0); PG8_MMA(1, 0, At, B0); PG8_BAR; PG8_SCHED;
            PG8_STAGE(PG8_SB(1, 1), b3 + hstep, voffB);
            PG8_WAIT_V(6); PG8_BAR; PG8_MMA(1, 1, At, B1); PG8_BAR;
            }
        }
        if constexpr (ALIGN_EPI) { if (wr == 0) PG8_BAR; }
        if constexpr (!Epi::AFTER_DRAIN) { E(acc, cur, wr, wc, fr, fq); S.done(cur); }
        if (!has_next) break;
#pragma unroll
        for (int a = 0; a < 2; ++a)
#pragma unroll
            for (int b = 0; b < 2; ++b)
#pragma unroll
                for (int m = 0; m < 4; ++m)
#pragma unroll
                    for (int n = 0; n < 2; ++n) acc[a][b][m][n] = (f32x4){0.f, 0.f, 0.f, 0.f};
        cur = nxt; cA = nA; cB = nB; ++ui;
        if constexpr (ALIGN_EPI) { if (wr == 1) PG8_BAR; }
    }
    PG8_WAIT_V(0);
    if constexpr (!ALIGN_EPI) { if (wr == 0) PG8_BAR; }
    PG8_BAR;
    if constexpr (Epi::AFTER_DRAIN) { E.fused(acc, cur, wr, wc, fr, fq, lds, wid, lane); S.done(cur); }
#undef PG8_SA
#undef PG8_SB
#undef PG8_STAGE
#undef PG8_LDA
#undef PG8_LDB
#undef PG8_MMA
#undef PG8_WAIT_V
#undef PG8_WAIT_L
#undef PG8_BAR
#undef PG8_SCHED
}
}

#define LAS __attribute__((address_space(3)))
typedef unsigned short bf16_t;
typedef short bf16x8 __attribute__((ext_vector_type(8)));
typedef short s16x4 __attribute__((ext_vector_type(4)));
typedef float f32x4 __attribute__((ext_vector_type(4)));
typedef float f32x2 __attribute__((ext_vector_type(2)));
typedef unsigned u32x4 __attribute__((ext_vector_type(4)));
typedef unsigned u32x2 __attribute__((ext_vector_type(2)));
typedef LAS unsigned char* lds_t;

constexpr int NT = 8192, DM = 2048, SEQ = 2048, NB = 4, DEPTH = 4;
constexpr int INW = 5144, NPROJ = 5376, FFH = 5632;
constexpr int PC_FQ = 0, PC_FK = 512, PC_FV = 1024, PC_GQ = 1536, PC_GK = 1792, PC_GV = 2048, PC_GG = 2560, PC_LG = 3072, PC_LX = 4096, PC_FF = 5120, PC_GR = 5128;
constexpr float EPS = 1e-6f;
constexpr float LOG2E = 1.4426950408889634f;
constexpr int LDS_BYTES = 147456;

constexpr size_t MiB = 1u << 20;
constexpr size_t WS_WIN = 0, WS_WOUT = 21 * MiB, WS_WGU = 29 * MiB, WS_WDN = 73 * MiB;
constexpr size_t WS_XW = 96 * MiB;
constexpr size_t WS_HB = 160 * MiB;
constexpr size_t WS_PROJ = 192 * MiB;
constexpr size_t WS_MIX = 360 * MiB;
constexpr size_t WS_FOXO = 392 * MiB;
constexpr size_t WS_CBUF = 400 * MiB;
constexpr size_t WS_GQT = 401 * MiB;
constexpr size_t WS_GA = 405 * MiB;
constexpr size_t WS_GVT = 407 * MiB;
constexpr size_t WS_GU = 415 * MiB;
constexpr size_t WS_GS = 447 * MiB;
constexpr size_t WS_GDEC = 463 * MiB;
constexpr size_t WS_LA = 464 * MiB;
constexpr size_t WS_LU = 496 * MiB;
constexpr size_t WS_AGP = 528 * MiB, WS_AGH = 529 * MiB, WS_HIN = 530 * MiB;
constexpr size_t WS_SS1 = 532 * MiB, WS_SS2 = 537 * MiB;
constexpr size_t WS_CTL = 531 * MiB, CTL_BYTES = 16384;
constexpr size_t WS_GWT = 541 * MiB;
constexpr size_t WS_SMALL = 542 * MiB, SMALL_BYTES = 10 * MiB;
constexpr size_t SL_CBUF = 0, SL_GDEC = 256 * 1024, SL_GWT = 512 * 1024, SL_AGP = 1 * MiB, SL_AGH = 2 * MiB, SL_HIN = 3 * MiB, SL_GQT = 4 * MiB, SL_GA = 8 * MiB;
constexpr size_t WS_QKV = 582 * MiB;
constexpr size_t WS_END = 614 * MiB;

#define GAS __attribute__((address_space(1)))
struct Params { const float* in[22]; float* out; GAS unsigned char* ws; GAS unsigned char* wsl; };

__device__ __forceinline__ unsigned pk2(float lo, float hi) { unsigned r; asm("v_cvt_pk_bf16_f32 %0, %1, %2" : "=v"(r) : "v"(lo), "v"(hi)); return r; }
__device__ __forceinline__ bf16_t f2bf(float f) { return (bf16_t)(pk2(f, 0.f) & 0xffffu); }
__device__ __forceinline__ float bf2f(unsigned b) { return __uint_as_float(b << 16); }
__device__ __forceinline__ float logsig(float x) { return fminf(x, 0.f) - __logf(1.0f + __expf(-fabsf(x))); }
__device__ __forceinline__ float sigmoidf(float x) { return __builtin_amdgcn_rcpf(1.0f + __expf(-x)); }
__device__ __forceinline__ float neg_expm1_small(float y) {
    const float pl = y * (1.0f + y * (0.5f + y * (0.16666667f + y * (0.041666668f + y * (0.0083333338f + y * (0.0013888889f + y * 0.00019841270f))))));
    return (y > -0.25f) ? -pl : (1.0f - __expf(y));
}
__device__ __forceinline__ f32x4 mfma16(bf16x8 a, bf16x8 b, f32x4 c) { return __builtin_amdgcn_mfma_f32_16x16x32_bf16(a, b, c, 0, 0, 0); }
__device__ __forceinline__ float wave_sum(float v) {
#pragma unroll
    for (int o = 1; o < 64; o <<= 1) v += __shfl_xor(v, o);
    return v;
}
__device__ __forceinline__ bf16x8 pack8(f32x4 a, f32x4 b) {
    u32x4 w; w.x = pk2(a[0], a[1]); w.y = pk2(a[2], a[3]); w.z = pk2(b[0], b[1]); w.w = pk2(b[2], b[3]);
    return __builtin_bit_cast(bf16x8, w);
}

template <int MODE>
__device__ __forceinline__ void wconv_item(const float* W0, const float* W1, int Nsrc, int K, bf16_t* Bt, int NG, int item, int lane, const float* gain) {
    const int kb = item / NG, nb = item - kb * NG;
    const int kg = lane >> 4, ng = lane & 15;
    const int np = nb * 64 + ng * 4, k = kb * 32 + kg * 8;
    const float* src = W0; int c = np;
    if (MODE == 0) { c = np < 1536 ? np : np < 3072 ? np + 8 : np < 5120 ? np + 24 : np < 5128 ? np - 5120 + 1536 : np < 5144 ? np - 5128 + 3080 : -1; }
    if (MODE == 2) { const int pn = np >> 8, j = np & 255; src = j < 128 ? W0 : W1; c = pn * 128 + (j & 127); }
    f32x4 v[8];
#pragma unroll
    for (int i = 0; i < 8; ++i) v[i] = (c >= 0) ? *(const f32x4*)(src + (size_t)(k + i) * Nsrc + c) : (f32x4){0.f, 0.f, 0.f, 0.f};
    if (gain) { const f32x4 g0 = *(const f32x4*)(gain + k), g1 = *(const f32x4*)(gain + k + 4);
#pragma unroll
        for (int i = 0; i < 4; ++i) { v[i] = v[i] * g0[i]; v[4 + i] = v[4 + i] * g1[i]; } }
#pragma unroll
    for (int j = 0; j < 4; ++j) {
        u32x4 o; o.x = pk2(v[0][j], v[1][j]); o.y = pk2(v[2][j], v[3][j]); o.z = pk2(v[4][j], v[5][j]); o.w = pk2(v[6][j], v[7][j]);
        *(u32x4*)(Bt + (size_t)(np + j) * K + k) = o;
    }
}

__device__ __forceinline__ void prep_row(const float* xrow, bf16_t* orow, float* ss, int row, int lane, const float* g) {
    const f32x4* xr = (const f32x4*)xrow + lane; const f32x4* gr = (const f32x4*)g + lane;
    f32x4 v[8]; float s = 0.f;
#pragma unroll
    for (int j = 0; j < 8; ++j) { v[j] = xr[64 * j]; s += (v[j][0] * v[j][0] + v[j][1] * v[j][1]) + (v[j][2] * v[j][2] + v[j][3] * v[j][3]); }
    s = wave_sum(s);
    if (lane < 32) ss[((size_t)(lane >> 2) * 8192 + row) * 4 + (lane & 3)] = (lane == 0) ? s : 0.f;
#pragma unroll
    for (int j = 0; j < 8; ++j) { const f32x4 y = v[j] * gr[64 * j]; u32x2 w; w.x = pk2(y[0], y[1]); w.y = pk2(y[2], y[3]); ((u32x2*)orow)[lane + 64 * j] = w; }
}
__device__ __forceinline__ void final_row(const float* xrow, const float* g, float* orow, float ss, int lane) {
    const f32x4* xr = (const f32x4*)xrow + lane; const f32x4* gr = (const f32x4*)g + lane;
    const float rstd = rsqrtf(ss * (1.0f / 2048.0f) + EPS);
#pragma unroll
    for (int j = 0; j < 8; ++j) ((f32x4*)orow)[lane + 64 * j] = xr[64 * j] * rstd * gr[64 * j];
}

__device__ __forceinline__ void phase_wconv(const Params& p, int l, int mask, int w, int nw, int lane) {
    GAS unsigned char* ws = p.ws;
    constexpr int I_IN = 64 * 84, I_OUT = 64 * 32, I_GU = 64 * 176, I_DN = 176 * 32;
    const float* w_in = p.in[2] + (size_t)l * DM * INW;
    const float* w_out = p.in[16] + (size_t)l * DM * DM;
    const float* w_gate = p.in[18] + (size_t)l * DM * FFH;
    const float* w_up = p.in[19] + (size_t)l * DM * FFH;
    const float* w_down = p.in[20] + (size_t)l * FFH * DM;
    if (mask & 1) for (int it = w; it < I_IN; it += nw) wconv_item<0>(w_in, w_in, INW, DM, (bf16_t*)(ws + WS_WIN), 84, it, lane, nullptr);
    if (mask & 2) for (int it = w; it < I_OUT; it += nw) wconv_item<1>(w_out, w_out, DM, DM, (bf16_t*)(ws + WS_WOUT), 32, it, lane, nullptr);
    if (mask & 4) for (int it = w; it < I_GU; it += nw) wconv_item<2>(w_gate, w_up, FFH, DM, (bf16_t*)(ws + WS_WGU), 176, it, lane, nullptr);
    if (mask & 8) for (int it = w; it < I_DN; it += nw) wconv_item<1>(w_down, w_down, DM, FFH, (bf16_t*)(ws + WS_WDN), 32, it, lane, nullptr);
}

__device__ __forceinline__ void fox_cumsum(const Params& p, int l, int seq, int lane) {
    const float* proj = (const float*)(p.ws + WS_PROJ);
    float* cbuf = (float*)(p.wsl + SL_CBUF);
    const int b = seq >> 3, h = seq & 7;
    const float bias = p.in[3][l * 8 + h];
    const float* src = proj + (size_t)(b * SEQ + lane * 32) * NPROJ + PC_FF + h;
    float ls[32];
#pragma unroll
    for (int i = 0; i < 32; ++i) ls[i] = src[(size_t)i * NPROJ];
    float s = 0.f;
#pragma unroll
    for (int i = 0; i < 32; ++i) { ls[i] = logsig(ls[i] + bias); s += ls[i]; }
    float incl = s;
#pragma unroll
    for (int o = 1; o < 64; o <<= 1) { const float t = __shfl_up(incl, o); if (lane >= o) incl += t; }
    float run = incl - s;
    float* dst = cbuf + seq * SEQ + lane * 32;
#pragma unroll
    for (int i = 0; i < 32; ++i) { run += ls[i]; dst[i] = run * LOG2E; }
}

__device__ __forceinline__ void gate_wt_prep(const Params& p, int l, int gid) {
    if (gid < 2 * 16 * 64 * 64) {
        const int d = gid & 63, e = (gid >> 6) & 63, n = (gid >> 12) & 15, g = gid >> 16;
        const float* w = (g == 0 ? p.in[10] : p.in[12]) + ((size_t)(l * 16 + n) * 64 + d) * 64 + e;
        ((bf16_t*)(p.wsl + SL_GWT))[gid] = f2bf(*w);
    }
}

__device__ __forceinline__ void gla_prep_witem(const Params& p, int l, int ch, lds_t wl_in, int lane_in) {
    int lane = lane_in; asm volatile("" : "+v"(lane));
    unsigned wlo_ = 0; asm volatile("" : "+s"(wlo_)); lds_t wl = wl_in + wlo_;
    const float* proj = (const float*)(p.ws + WS_PROJ);
    const int bh = ch >> 6, n = ch & 63, b = bh >> 2, h = bh & 3;
    const int t0 = b * SEQ + n * 32;
    LAS bf16_t* Qs = (LAS bf16_t*)(wl);
    LAS bf16_t* Ks = (LAS bf16_t*)(wl + 4608);
    LAS bf16_t* KstT = (LAS bf16_t*)(wl);
    LAS bf16_t* VT = (LAS bf16_t*)(wl + 5120);
    const int r = lane & 15, q = lane >> 4;
    float gqv[32], gkv[32];
#pragma unroll
    for (int t = 0; t < 32; ++t) { const float* prow = proj + (size_t)(t0 + t) * NPROJ; gqv[t] = prow[PC_GQ + h * 64 + lane]; gkv[t] = prow[PC_GK + h * 64 + lane]; }
    unsigned vw[2][16];
#pragma unroll
    for (int vv = 0; vv < 2; ++vv) {
        const bf16_t* vp = (const bf16_t*)(p.ws + WS_QKV) + ((size_t)3 * NT + t0) * 512 + h * 128 + lane + 64 * vv;
#pragma unroll
        for (int t = 0; t < 32; t += 2) vw[vv][t >> 1] = (unsigned)vp[(size_t)t * 512] | ((unsigned)vp[(size_t)(t + 1) * 512] << 16);
    }
    float bcum[32];
    {
        const float* w2 = p.in[5] + (size_t)l * 16 * 256 + h * 64 + lane;
        const float gb = p.in[6][l * 256 + h * 64 + lane];
        float w2r[16];
#pragma unroll
        for (int i = 0; i < 16; ++i) w2r[i] = w2[i * 256];
        LAS float* grs = (LAS float*)(wl);
        { const float* gsrc = proj + (size_t)(t0 + (lane >> 1)) * NPROJ + PC_GR + (lane & 1) * 8;
          const f32x4 g0 = *(const f32x4*)gsrc, g1 = *(const f32x4*)(gsrc + 4);
          *(LAS f32x4*)(grs + lane * 8) = g0; *(LAS f32x4*)(grs + lane * 8 + 4) = g1; }
        float run = 0.f;
#pragma unroll
        for (int t = 0; t < 32; ++t) {
            f32x4 gr4[4];
#pragma unroll
            for (int i = 0; i < 4; ++i) gr4[i] = *(LAS f32x4*)(grs + t * 16 + 4 * i);
            float z = gb;
#pragma unroll
            for (int i = 0; i < 16; ++i) z += gr4[i >> 2][i & 3] * w2r[i];
            run += logsig(z) * (1.0f / 16.0f);
            bcum[t] = run;
        }
        asm volatile("" ::: "memory");
    }
    const float bl = bcum[31];
    unsigned kstp[16];
    {
        bf16_t* qtg = (bf16_t*)(p.wsl + SL_GQT) + (size_t)t0 * 256 + h * 64 + lane;
        float ksprev = 0.f;
#pragma unroll
        for (int t = 0; t < 32; ++t) {
            const float gq = gqv[t], gk = gkv[t];
            const float bv = bcum[t];
            const float qt = gq * 0.125f * __expf(bv), kt = gk * __expf(-bv), ks = gk * __expf(bl - bv);
            const bf16_t qb16 = f2bf(qt);
            Qs[t * 72 + lane] = qb16; Ks[t * 72 + lane] = f2bf(kt);
            qtg[(size_t)t * 256] = qb16;
            if (t & 1) kstp[t >> 1] = pk2(ksprev, ks); else ksprev = ks;
        }
        ((float*)(p.wsl + SL_GDEC))[ch * 64 + lane] = __expf(bl);
    }
    {
        bf16_t* ab = (bf16_t*)(p.wsl + SL_GA) + (size_t)ch * 1024;
#pragma unroll
        for (int tt = 0; tt < 2; ++tt)
#pragma unroll
            for (int st = 0; st < 2; ++st) {
                f32x4 acc = {0.f, 0.f, 0.f, 0.f};
#pragma unroll
                for (int ks = 0; ks < 2; ++ks) {
                    const bf16x8 a = *(LAS bf16x8*)(Qs + (16 * tt + r) * 72 + 32 * ks + 8 * q);
                    const bf16x8 bb = *(LAS bf16x8*)(Ks + (16 * st + r) * 72 + 32 * ks + 8 * q);
                    acc = mfma16(a, bb, acc);
                }
#pragma unroll
                for (int j = 0; j < 4; ++j) { const int t = 16 * tt + 4 * q + j, s = 16 * st + r; ab[t * 32 + s] = f2bf(s <= t ? acc[j] : 0.f); }
            }
    }
#pragma unroll
    for (int i = 0; i < 4; ++i) { u32x4 w; w.x = kstp[4 * i]; w.y = kstp[4 * i + 1]; w.z = kstp[4 * i + 2]; w.w = kstp[4 * i + 3]; *(LAS u32x4*)(KstT + lane * 40 + 8 * i) = w; }
#pragma unroll
    for (int vv = 0; vv < 2; ++vv) {
        const int v = lane + 64 * vv;
        bf16_t* vg = (bf16_t*)(p.ws + WS_GVT) + (size_t)ch * 4096 + v * 32;
#pragma unroll
        for (int i = 0; i < 4; ++i) { u32x4 w; w.x = vw[vv][4 * i]; w.y = vw[vv][4 * i + 1]; w.z = vw[vv][4 * i + 2]; w.w = vw[vv][4 * i + 3]; *(LAS u32x4*)(VT + v * 40 + 8 * i) = w; *(u32x4*)(vg + 8 * i) = w; }
    }
    {
        float* ub = (float*)(p.ws + WS_GU) + (size_t)ch * 8192;
        bf16x8 kb[4];
#pragma unroll
        for (int dt = 0; dt < 4; ++dt) kb[dt] = *(LAS bf16x8*)(KstT + (16 * dt + r) * 40 + 8 * q);
#pragma unroll
        for (int w = 0; w < 8; ++w) {
            const bf16x8 a = *(LAS bf16x8*)(VT + (16 * w + r) * 40 + 8 * q);
#pragma unroll
            for (int dt = 0; dt < 4; ++dt) {
                const f32x4 acc = mfma16(a, kb[dt], (f32x4){0.f, 0.f, 0.f, 0.f});
#pragma unroll
                for (int j = 0; j < 4; ++j) ub[(16 * w + 4 * q + j) * 64 + 16 * dt + r] = acc[j];
            }
        }
    }
}

__device__ __forceinline__ void lru_prep_witem(const Params& p, int l, int item, lds_t wl_in, int lane_in) {
    int lane = lane_in; asm volatile("" : "+v"(lane));
    unsigned wlo_ = 0; asm volatile("" : "+s"(wlo_)); lds_t wl = wl_in + wlo_;
    const float* proj = (const float*)(p.ws + WS_PROJ);
    const int gt = item >> 4, n = item & 15, tok0 = gt * 32, b = tok0 >> 11, p0 = tok0 & 2047, c0 = n * 64;
    LAS bf16_t* Xs = (LAS bf16_t*)(wl);
    LAS float* Xf = (LAS float*)(wl + 4608);
    const int r = lane & 15, q = lane >> 4;
    const bf16_t* gwt = (const bf16_t*)(p.wsl + SL_GWT);
    bf16x8 bav[4][2], biv[4][2]; float bbav[4], bbiv[4], lamv[4];
#pragma unroll
    for (int et = 0; et < 4; ++et) {
#pragma unroll
        for (int ks = 0; ks < 2; ++ks) { bav[et][ks] = *(const bf16x8*)(gwt + ((size_t)(0 * 16 + n) * 64 + 16 * et + r) * 64 + 32 * ks + 8 * q); biv[et][ks] = *(const bf16x8*)(gwt + ((size_t)(1 * 16 + n) * 64 + 16 * et + r) * 64 + 32 * ks + 8 * q); }
        const int c = c0 + 16 * et + r;
        bbav[et] = p.in[11][l * 1024 + c]; bbiv[et] = p.in[13][l * 1024 + c]; lamv[et] = p.in[14][l * 1024 + c];
    }
    {
        const int c = c0 + lane;
        const float* cw = p.in[8] + (size_t)l * 4 * 1024 + c;
        const float w0 = cw[0], w1 = cw[1024], w2 = cw[2048], w3 = cw[3072], cb = p.in[9][l * 1024 + c];
        const float* lxp = proj + (size_t)(b * SEQ) * NPROJ + PC_LX + c;
        float x0 = p0 >= 3 ? lxp[(size_t)(p0 - 3) * NPROJ] : 0.f, x1 = p0 >= 2 ? lxp[(size_t)(p0 - 2) * NPROJ] : 0.f, x2 = p0 >= 1 ? lxp[(size_t)(p0 - 1) * NPROJ] : 0.f;
        float xv[32];
#pragma unroll
        for (int i = 0; i < 32; ++i) xv[i] = lxp[(size_t)(p0 + i) * NPROJ];
#pragma unroll
        for (int i = 0; i < 32; ++i) {
            const float x3 = xv[i];
            const float y = cb + w0 * x0 + w1 * x1 + w2 * x2 + w3 * x3;
            Xf[i * 68 + lane] = y; Xs[i * 72 + lane] = f2bf(y);
            x0 = x1; x1 = x2; x2 = x3;
        }
    }
    bf16x8 af[2][2];
#pragma unroll
    for (int tt = 0; tt < 2; ++tt)
#pragma unroll
        for (int ks = 0; ks < 2; ++ks) af[tt][ks] = *(LAS bf16x8*)(Xs + (16 * tt + r) * 72 + 32 * ks + 8 * q);
    float* la = (float*)(p.ws + WS_LA); float* lu = (float*)(p.ws + WS_LU);
#pragma unroll
    for (int et = 0; et < 4; ++et) {
        bf16x8 ba[2], bi[2];
#pragma unroll
        for (int ks = 0; ks < 2; ++ks) { ba[ks] = bav[et][ks]; bi[ks] = biv[et][ks]; }
        const int e = 16 * et + r, c = c0 + e;
        const float bba = bbav[et], bbi = bbiv[et], lls = logsig(lamv[et]);
        float av[2][4], uv[2][4];
#pragma unroll
        for (int tt = 0; tt < 2; ++tt) {
            f32x4 pa = {0.f, 0.f, 0.f, 0.f}, pi = {0.f, 0.f, 0.f, 0.f};
#pragma unroll
            for (int ks = 0; ks < 2; ++ks) { pa = mfma16(af[tt][ks], ba[ks], pa); pi = mfma16(af[tt][ks], bi[ks], pi); }
#pragma unroll
            for (int j = 0; j < 4; ++j) {
                const int t = 16 * tt + 4 * q + j;
                const float rg = sigmoidf(pa[j] + bba), ig = sigmoidf(pi[j] + bbi);
                const float loga = 8.0f * rg * lls;
                const float a = __expf(loga);
                const float u = __builtin_amdgcn_sqrtf(fmaxf(neg_expm1_small(2.0f * loga), 0.f)) * (ig * Xf[t * 68 + e]);
                la[(size_t)(tok0 + t) * 1024 + c] = a; lu[(size_t)(tok0 + t) * 1024 + c] = u;
                av[tt][j] = a; uv[tt][j] = u;
            }
            asm volatile("" ::: "memory");
        }
        float P = 1.f, H = 0.f;
#pragma unroll
        for (int tt = 0; tt < 2; ++tt)
#pragma unroll
            for (int qq = 0; qq < 4; ++qq) {
                if (q == qq) {
#pragma unroll
                    for (int j = 0; j < 4; ++j) { H = av[tt][j] * H + uv[tt][j]; P *= av[tt][j]; }
                }
                P = __shfl(P, r + 16 * qq); H = __shfl(H, r + 16 * qq);
            }
        if (q == 0) { ((float*)(p.wsl + SL_AGP))[gt * 1024 + c] = P; ((float*)(p.wsl + SL_AGH))[gt * 1024 + c] = H; }
    }
}

__device__ __forceinline__ void fox_attn_unit(const Params& p, int bh, int qb, lds_t lds, int tid, int wave, int lane) {
    const float* proj = (const float*)(p.ws + WS_PROJ);
    const float* cb = (const float*)(p.wsl + SL_CBUF) + bh * SEQ;
    const int b = bh >> 3, h = bh & 7;
    LAS bf16_t* Ks = (LAS bf16_t*)(lds);
    LAS bf16_t* Vt = (LAS bf16_t*)(lds + 9216);
    LAS float* cks = (LAS float*)(lds + 18432);
    const int r = lane & 15, q = lane >> 4;
    const int q0 = qb * 128, qw0 = q0 + 16 * wave, nkv = 2 * (qb + 1);
    const float C2 = 0.125f * LOG2E;
    bf16x8 qf[2];
    {
        const bf16_t* qp = (const bf16_t*)(p.ws + WS_QKV) + (size_t)(b * SEQ + qw0 + r) * 512 + h * 64 + 8 * q;
#pragma unroll
        for (int ks = 0; ks < 2; ++ks) qf[ks] = *(const bf16x8*)(qp + 32 * ks);
    }
    const float cq = cb[qw0 + r];
    float m = -1e30f, lsum = 0.f;
    f32x4 o[4];
#pragma unroll
    for (int i = 0; i < 4; ++i) o[i] = (f32x4){0.f, 0.f, 0.f, 0.f};
    const int lrow = tid >> 3, lch = (tid & 7) * 8;
    const bf16_t* kbase = (const bf16_t*)(p.ws + WS_QKV) + ((size_t)NT + b * SEQ + lrow) * 512 + h * 64 + lch;
    const int vrow = tid & 63, vch = (tid >> 6) * 8;
    const bf16_t* vbase = (const bf16_t*)(p.ws + WS_QKV) + ((size_t)2 * NT + b * SEQ + vrow) * 512 + h * 64 + vch;
    bf16x8 kA = *(const bf16x8*)kbase, vA = *(const bf16x8*)vbase;
    float ckA = tid < 64 ? cb[tid] : 0.f;
    bf16x8 kB = *(const bf16x8*)(kbase + (size_t)64 * 512), vB = *(const bf16x8*)(vbase + (size_t)64 * 512);
    float ckB = tid < 64 ? cb[64 + tid] : 0.f;
    constexpr int FOXBUF = 18432 + 256;
#define FOX_WRITE(KK, VV, CK, bufi, jn) { \
        LAS bf16_t* KsW = (LAS bf16_t*)(lds + (bufi) * FOXBUF); LAS bf16_t* VtW = (LAS bf16_t*)(lds + (bufi) * FOXBUF + 9216); LAS float* cksW = (LAS float*)(lds + (bufi) * FOXBUF + 18432); \
        *(LAS bf16x8*)(KsW + lrow * 72 + lch) = KK; \
        _Pragma("unroll") for (int i = 0; i < 8; ++i) VtW[(vch + i) * 72 + vrow] = (bf16_t)VV[i]; \
        if (tid < 64) cksW[tid] = CK; \
        if ((jn) < nkv) { const size_t off = (size_t)(jn) * 64 * 512; \
            KK = *(const bf16x8*)(kbase + off); VV = *(const bf16x8*)(vbase + off); \
            if (tid < 64) CK = cb[(jn) * 64 + tid]; } }
    __syncthreads();
    FOX_WRITE(kA, vA, ckA, 0, 2)
    asm volatile("s_waitcnt lgkmcnt(0)\n\ts_barrier" ::: "memory");
    for (int j0 = 0; j0 < nkv; j0 += 2) {
        { const int j = j0;
          FOX_WRITE(kB, vB, ckB, 1, j + 3)
          LAS bf16_t* KsX = (LAS bf16_t*)(lds); LAS bf16_t* VtX = (LAS bf16_t*)(lds + 9216); LAS float* cksX = (LAS float*)(lds + 18432);
        if (64 * j <= qw0 + 15) {
            f32x4 s[4]; float mx = -INFINITY;
            bf16x8 kfr[4][2]; f32x4 ckr[4]; s16x4 vlo[4][2], vhi[4][2];
#pragma unroll
            for (int st = 0; st < 4; ++st) {
#pragma unroll
                for (int ks = 0; ks < 2; ++ks) kfr[st][ks] = *(LAS bf16x8*)(KsX + (16 * st + r) * 72 + 32 * ks + 8 * q);
                ckr[st] = *(LAS f32x4*)(cksX + 16 * st + 4 * q);
            }
#pragma unroll
            for (int ds = 0; ds < 4; ++ds)
#pragma unroll
                for (int ks = 0; ks < 2; ++ks) { vlo[ds][ks] = *(LAS s16x4*)(VtX + (16 * ds + r) * 72 + 32 * ks + 4 * q); vhi[ds][ks] = *(LAS s16x4*)(VtX + (16 * ds + r) * 72 + 32 * ks + 16 + 4 * q); }
#pragma unroll
            for (int st = 0; st < 4; ++st) {
                f32x4 acc = {0.f, 0.f, 0.f, 0.f};
#pragma unroll
                for (int ks = 0; ks < 2; ++ks) acc = mfma16(kfr[st][ks], qf[ks], acc);
                const f32x4 ck = ckr[st];
#pragma unroll
                for (int jj = 0; jj < 4; ++jj) {
                    const int kv = 64 * j + 16 * st + 4 * q + jj;
                    float sv = acc[jj] + (cq - ck[jj]);
                    if (64 * j + 63 > qw0) sv = (kv <= qw0 + r) ? sv : -INFINITY;
                    s[st][jj] = sv; mx = fmaxf(mx, sv);
                }
            }
            mx = fmaxf(mx, __shfl_xor(mx, 16)); mx = fmaxf(mx, __shfl_xor(mx, 32));
            const float mnew = fmaxf(m, mx);
            const float alpha = __builtin_amdgcn_exp2f(m - mnew);
            m = mnew;
            float ps = 0.f;
#pragma unroll
            for (int st = 0; st < 4; ++st)
#pragma unroll
                for (int jj = 0; jj < 4; ++jj) { const float e = __builtin_amdgcn_exp2f(s[st][jj] - mnew); s[st][jj] = e; ps += e; }
            lsum = lsum * alpha + ps;
#pragma unroll
            for (int i = 0; i < 4; ++i) o[i] = o[i] * alpha;
            bf16x8 pf[2];
            pf[0] = pack8(s[0], s[1]); pf[1] = pack8(s[2], s[3]);
#pragma unroll
            for (int ds = 0; ds < 4; ++ds)
#pragma unroll
                for (int ks = 0; ks < 2; ++ks) {
                    const s16x4 lo = vlo[ds][ks], hi = vhi[ds][ks];
                    const bf16x8 a = {lo[0], lo[1], lo[2], lo[3], hi[0], hi[1], hi[2], hi[3]};
                    o[ds] = mfma16(a, pf[ks], o[ds]);
                }
        }
          asm volatile("s_waitcnt lgkmcnt(0)\n\ts_barrier" ::: "memory");
        }
        { const int j = j0 + 1;
          if (j + 1 < nkv) FOX_WRITE(kA, vA, ckA, 0, j + 3)
          LAS bf16_t* KsX = (LAS bf16_t*)(lds + FOXBUF); LAS bf16_t* VtX = (LAS bf16_t*)(lds + FOXBUF + 9216); LAS float* cksX = (LAS float*)(lds + FOXBUF + 18432);
        if (64 * j <= qw0 + 15) {
            f32x4 s[4]; float mx = -INFINITY;
            bf16x8 kfr[4][2]; f32x4 ckr[4]; s16x4 vlo[4][2], vhi[4][2];
#pragma unroll
            for (int st = 0; st < 4; ++st) {
#pragma unroll
                for (int ks = 0; ks < 2; ++ks) kfr[st][ks] = *(LAS bf16x8*)(KsX + (16 * st + r) * 72 + 32 * ks + 8 * q);
                ckr[st] = *(LAS f32x4*)(cksX + 16 * st + 4 * q);
            }
#pragma unroll
            for (int ds = 0; ds < 4; ++ds)
#pragma unroll
                for (int ks = 0; ks < 2; ++ks) { vlo[ds][ks] = *(LAS s16x4*)(VtX + (16 * ds + r) * 72 + 32 * ks + 4 * q); vhi[ds][ks] = *(LAS s16x4*)(VtX + (16 * ds + r) * 72 + 32 * ks + 16 + 4 * q); }
#pragma unroll
            for (int st = 0; st < 4; ++st) {
                f32x4 acc = {0.f, 0.f, 0.f, 0.f};
#pragma unroll
                for (int ks = 0; ks < 2; ++ks) acc = mfma16(kfr[st][ks], qf[ks], acc);
                const f32x4 ck = ckr[st];
#pragma unroll
                for (int jj = 0; jj < 4; ++jj) {
                    const int kv = 64 * j + 16 * st + 4 * q + jj;
                    float sv = acc[jj] + (cq - ck[jj]);
                    if (64 * j + 63 > qw0) sv = (kv <= qw0 + r) ? sv : -INFINITY;
                    s[st][jj] = sv; mx = fmaxf(mx, sv);
                }
            }
            mx = fmaxf(mx, __shfl_xor(mx, 16)); mx = fmaxf(mx, __shfl_xor(mx, 32));
            const float mnew = fmaxf(m, mx);
            const float alpha = __builtin_amdgcn_exp2f(m - mnew);
            m = mnew;
            float ps = 0.f;
#pragma unroll
            for (int st = 0; st < 4; ++st)
#pragma unroll
                for (int jj = 0; jj < 4; ++jj) { const float e = __builtin_amdgcn_exp2f(s[st][jj] - mnew); s[st][jj] = e; ps += e; }
            lsum = lsum * alpha + ps;
#pragma unroll
            for (int i = 0; i < 4; ++i) o[i] = o[i] * alpha;
            bf16x8 pf[2];
            pf[0] = pack8(s[0], s[1]); pf[1] = pack8(s[2], s[3]);
#pragma unroll
            for (int ds = 0; ds < 4; ++ds)
#pragma unroll
                for (int ks = 0; ks < 2; ++ks) {
                    const s16x4 lo = vlo[ds][ks], hi = vhi[ds][ks];
                    const bf16x8 a = {lo[0], lo[1], lo[2], lo[3], hi[0], hi[1], hi[2], hi[3]};
                    o[ds] = mfma16(a, pf[ks], o[ds]);
                }
        }
          asm volatile("s_waitcnt lgkmcnt(0)\n\ts_barrier" ::: "memory");
        }
    }
#undef FOX_WRITE
    lsum += __shfl_xor(lsum, 16); lsum += __shfl_xor(lsum, 32);
    const float inv = 1.0f / lsum;
    bf16_t* op = (bf16_t*)(p.ws + WS_FOXO) + (size_t)(b * SEQ + qw0 + r) * 512 + h * 64 + 4 * q;
#pragma unroll
    for (int ds = 0; ds < 4; ++ds) { u32x2 w; w.x = pk2(o[ds][0] * inv, o[ds][1] * inv); w.y = pk2(o[ds][2] * inv, o[ds][3] * inv); *(u32x2*)(op + 16 * ds) = w; }
}

__device__ __forceinline__ void gla_scan_item(const Params& p, int item, int tid) {
    const int bh = item >> 4, e = (item & 15) * 512 + tid, d = e & 63;
    const float* ub = (const float*)(p.ws + WS_GU) + (size_t)bh * 64 * 8192 + e;
    const float* dec = (const float*)(p.wsl + SL_GDEC) + (size_t)bh * 64 * 64 + d;
    bf16_t* sp = (bf16_t*)(p.ws + WS_GS) + (size_t)bh * 64 * 8192 + e;
    float st = 0.f;
#pragma unroll
    for (int n0 = 0; n0 < 64; n0 += 64) {
        float u[64], dc[64];
#pragma unroll
        for (int n = 0; n < 64; ++n) { u[n] = ub[(size_t)(n0 + n) * 8192]; dc[n] = dec[(n0 + n) * 64]; }
#pragma unroll
        for (int n = 0; n < 64; ++n) { sp[(size_t)(n0 + n) * 8192] = f2bf(st); st = dc[n] * st + u[n]; }
    }
}

__device__ __forceinline__ void lru_tilescan_item(const Params& p, int item, int tid) {
    const int gid = item * 512 + tid, b = gid >> 10, c = gid & 1023;
    const float* P = (const float*)(p.wsl + SL_AGP) + (size_t)b * 64 * 1024 + c;
    const float* H = (const float*)(p.wsl + SL_AGH) + (size_t)b * 64 * 1024 + c;
    float* hi = (float*)(p.wsl + SL_HIN) + (size_t)b * 64 * 1024 + c;
    float h = 0.f;
#pragma unroll
    for (int t0 = 0; t0 < 64; t0 += 64) {
        float a[64], u[64];
#pragma unroll
        for (int t = 0; t < 64; ++t) { a[t] = P[(t0 + t) * 1024]; u[t] = H[(t0 + t) * 1024]; }
#pragma unroll
        for (int t = 0; t < 64; ++t) { hi[(t0 + t) * 1024] = h; h = a[t] * h + u[t]; }
    }
}

__device__ __forceinline__ void fox_norm_rows4(const Params& p, int l, int tok0, int stride, int lane) {
    u32x4 w[4];
#pragma unroll
    for (int k = 0; k < 4; ++k) w[k] = *(const u32x4*)((const bf16_t*)(p.ws + WS_FOXO) + (size_t)(tok0 + k * stride) * 512 + lane * 8);
    const float* g = p.in[4] + l * 512 + lane * 8;
    const f32x4 g0 = *(const f32x4*)g, g1 = *(const f32x4*)(g + 4);
#pragma unroll
    for (int k = 0; k < 4; ++k) {
        float v[8];
#pragma unroll
        for (int i = 0; i < 4; ++i) { v[2 * i] = bf2f(w[k][i] & 0xffffu); v[2 * i + 1] = bf2f(w[k][i] >> 16); }
        float s = 0.f;
#pragma unroll
        for (int i = 0; i < 8; ++i) s += v[i] * v[i];
        const float rstd = rsqrtf(wave_sum(s) * (1.0f / 512.0f) + EPS);
        u32x4 ow; ow.x = pk2(v[0] * rstd * g0[0], v[1] * rstd * g0[1]); ow.y = pk2(v[2] * rstd * g0[2], v[3] * rstd * g0[3]);
        ow.z = pk2(v[4] * rstd * g1[0], v[5] * rstd * g1[1]); ow.w = pk2(v[6] * rstd * g1[2], v[7] * rstd * g1[3]);
        *(u32x4*)((bf16_t*)(p.ws + WS_MIX) + (size_t)(tok0 + k * stride) * 2048 + lane * 8) = ow;
    }
}

__device__ __forceinline__ void gla_out_witem(const Params& p, int l, int item, int lane) {
    const float* proj = (const float*)(p.ws + WS_PROJ);
    const int ch = item >> 1, tt = item & 1;
    const int bh = ch >> 6, n = ch & 63, b = bh >> 2, h = bh & 3;
    const int t0 = b * SEQ + n * 32;
    const int r = lane & 15, q = lane >> 4;
    const bf16_t* ab = (const bf16_t*)(p.wsl + SL_GA) + (size_t)ch * 1024;
    const bf16_t* vt = (const bf16_t*)(p.ws + WS_GVT) + (size_t)ch * 4096;
    const bf16_t* qt = (const bf16_t*)(p.wsl + SL_GQT) + (size_t)t0 * 256 + h * 64;
    const bf16_t* sp = (const bf16_t*)(p.ws + WS_GS) + (size_t)ch * 8192;
    const bf16x8 aa = *(const bf16x8*)(ab + (16 * tt + r) * 32 + 8 * q);
    const bf16x8 aq0 = *(const bf16x8*)(qt + (size_t)(16 * tt + r) * 256 + 8 * q), aq1 = *(const bf16x8*)(qt + (size_t)(16 * tt + r) * 256 + 32 + 8 * q);
    float ggv[4][8], gnv[8];
#pragma unroll
    for (int w = 0; w < 8; ++w) gnv[w] = p.in[7][l * 128 + 16 * w + r];
#pragma unroll
    for (int j = 0; j < 4; ++j)
#pragma unroll
        for (int w = 0; w < 8; ++w) ggv[j][w] = proj[(size_t)(t0 + 16 * tt + 4 * q + j) * NPROJ + PC_GG + h * 128 + r + 16 * w];
    f32x4 acc[8];
#pragma unroll
    for (int w = 0; w < 8; ++w) {
        const int v = 16 * w + r;
        const bf16x8 bv = *(const bf16x8*)(vt + v * 32 + 8 * q);
        const bf16x8 bs0 = *(const bf16x8*)(sp + v * 64 + 8 * q), bs1 = *(const bf16x8*)(sp + v * 64 + 32 + 8 * q);
        f32x4 c = mfma16(aa, bv, (f32x4){0.f, 0.f, 0.f, 0.f});
        c = mfma16(aq0, bs0, c); c = mfma16(aq1, bs1, c);
        acc[w] = c;
    }
    float tot[4] = {0.f, 0.f, 0.f, 0.f};
#pragma unroll
    for (int w = 0; w < 8; ++w)
#pragma unroll
        for (int j = 0; j < 4; ++j) {
            float s = acc[w][j] * acc[w][j];
            s += __shfl_xor(s, 1); s += __shfl_xor(s, 2); s += __shfl_xor(s, 4); s += __shfl_xor(s, 8);
            tot[j] += s;
        }
#pragma unroll
    for (int j = 0; j < 4; ++j) {
        const int t = 16 * tt + 4 * q + j;
        const float rstd = rsqrtf(tot[j] * (1.0f / 128.0f) + EPS);
        bf16_t* mp = (bf16_t*)(p.ws + WS_MIX) + (size_t)(t0 + t) * 2048 + 512 + h * 128 + r;
#pragma unroll
        for (int w = 0; w < 8; ++w) {
            const float gn = gnv[w];
            const float gg = ggv[j][w];
            const float y = acc[w][j] * rstd * gn * (gg * sigmoidf(gg));
            mp[16 * w] = f2bf(y);
        }
    }
}

__device__ __forceinline__ float gelu_tanh(float x) {
    const float u = 0.7978845608028654f * (x + 0.044715f * x * x * x);
    const float t = 1.0f - 2.0f * __builtin_amdgcn_rcpf(1.0f + __expf(2.0f * u));
    return 0.5f * x * (1.0f + t);
}

__device__ __forceinline__ void lru_out_item(const Params& p, int l, int gt, lds_t lds, int tid, int wave, int lane) {
    const float* proj = (const float*)(p.ws + WS_PROJ);
    const int tok0 = gt * 32, c = 2 * tid;
    LAS float* part = (LAS float*)(lds);
    LAS float* rs = (LAS float*)(lds + 65536);
    const f32x2* la = (const f32x2*)((const float*)(p.ws + WS_LA) + (size_t)tok0 * 1024 + c);
    const f32x2* lu = (const f32x2*)((const float*)(p.ws + WS_LU) + (size_t)tok0 * 1024 + c);
    const float* lgp = proj + (size_t)tok0 * NPROJ + PC_LG + c;
    f32x2 h = *(const f32x2*)((const float*)(p.wsl + SL_HIN) + (size_t)gt * 1024 + c);
    f32x2 y[32];
    {
        f32x2 av[32], uv[32];
#pragma unroll
        for (int t = 0; t < 32; ++t) y[t] = *(const f32x2*)(lgp + (size_t)t * NPROJ);
#pragma unroll
        for (int t = 0; t < 32; ++t) { av[t] = la[t * 512]; uv[t] = lu[t * 512]; }
#pragma unroll
        for (int t = 0; t < 32; ++t) { y[t][0] = gelu_tanh(y[t][0]); y[t][1] = gelu_tanh(y[t][1]); }
#pragma unroll
        for (int t = 0; t < 32; ++t) {
            h = av[t] * h + uv[t];
            y[t][0] = h[0] * y[t][0]; y[t][1] = h[1] * y[t][1];
            part[t * 512 + tid] = y[t][0] * y[t][0] + y[t][1] * y[t][1];
        }
    }
    __syncthreads();
    {
        const int t = tid >> 4, k0 = tid & 15;
        float s = 0.f;
#pragma unroll 8
        for (int k = 0; k < 32; ++k) s += part[t * 512 + k0 + 16 * k];
        s += __shfl_xor(s, 1); s += __shfl_xor(s, 2); s += __shfl_xor(s, 4); s += __shfl_xor(s, 8);
        if (k0 == 0) rs[t] = rsqrtf(s * (1.0f / 1024.0f) + EPS);
    }
    __syncthreads();
    const f32x2 g = *(const f32x2*)(p.in[15] + l * 1024 + c);
    bf16_t* mix = (bf16_t*)(p.ws + WS_MIX) + (size_t)tok0 * 2048 + 1024 + c;
#pragma unroll
    for (int t = 0; t < 32; ++t) { const float rr = rs[t]; *(unsigned*)(mix + (size_t)t * 2048) = pk2(y[t][0] * rr * g[0], y[t][1] * rr * g[1]); }
    __syncthreads();
}

#define XB_TMO      128
#define XB_XCNT(j)  (256  + 64 * (j))
#define XB_XSUB(j)  (1280 + 64 * (j))
#define XB_XGEN(j)  (2304 + 64 * (j))
#define XB_TOP      3328
#define XB_TOPGEN   3392
#define XCD_BAR_WORDS 3456
#define XB_SPIN_CAP (1u << 18)

__device__ __forceinline__ unsigned xb_ld(unsigned* p)              { return __hip_atomic_load(p, __ATOMIC_RELAXED, __HIP_MEMORY_SCOPE_AGENT); }
__device__ __forceinline__ unsigned xb_add(unsigned* p, unsigned v) { return __hip_atomic_fetch_add(p, v, __ATOMIC_RELAXED, __HIP_MEMORY_SCOPE_AGENT); }
__device__ __forceinline__ unsigned xb_xcc_id() { return (unsigned)__builtin_amdgcn_s_getreg((3 << 11) | 20) & 0xFu; }
#define XB_SPIN(cond, bar) do { unsigned _sp = 0; while (cond) { __builtin_amdgcn_s_sleep(1); \
    if ((++_sp & 255u) == 0u) { if (xb_ld(&(bar)[XB_TMO])) break; if (_sp > XB_SPIN_CAP) { atomicAdd(&(bar)[XB_TMO], 1u); break; } } } } while (0)

struct XcdBarrier {
    unsigned* bar; unsigned x;
    volatile LAS unsigned* st;
};

__device__ __forceinline__ XcdBarrier xcd_barrier_post(unsigned* bar, volatile LAS unsigned* st) {
    XcdBarrier b; b.bar = bar; b.x = xb_xcc_id(); b.st = st;
    if (threadIdx.x == 0) (void)xb_add(&bar[XB_XCNT(b.x)], 1u);
    return b;
}
__device__ __forceinline__ void xcd_barrier_complete(unsigned* bar, unsigned x, unsigned& nloc, unsigned& nx) {
    const unsigned G = gridDim.x * gridDim.y * gridDim.z;
    unsigned sum, cnt, mine, sp = 0u;
    for (;;) {
        sum = 0u; cnt = 0u; mine = 0u;
#pragma unroll
        for (unsigned j = 0; j < 16; ++j) { const unsigned c = xb_ld(&bar[XB_XCNT(j)]); sum += c; cnt += (c > 0u) ? 1u : 0u; mine = (j == x) ? c : mine; }
        if (sum == G) break;
        __builtin_amdgcn_s_sleep(1);
        if ((++sp & 255u) == 0u) { if (xb_ld(&bar[XB_TMO])) break; if (sp > XB_SPIN_CAP) { atomicAdd(&bar[XB_TMO], 1u); break; } }
    }
    nloc = mine > 0u ? mine : 1u; nx = cnt > 0u ? cnt : 1u;
}

__device__ __forceinline__ void xcd_barrier(const XcdBarrier& b) {
    asm volatile("s_waitcnt vmcnt(0)" ::: "memory");
    __syncthreads();
    if (threadIdx.x == 0) {
        unsigned* bar = b.bar;
        __builtin_amdgcn_s_waitcnt(0);
        unsigned nloc = b.st[0], nx = b.st[1];
        if (nloc == 0u) { xcd_barrier_complete(bar, b.x, nloc, nx); b.st[0] = nloc; b.st[1] = nx; }
        const unsigned old = xb_add(&bar[XB_XSUB(b.x)], 1u);
        const unsigned gen = old / nloc;
        if (old + 1u == (gen + 1u) * nloc) {
            __builtin_amdgcn_fence(__ATOMIC_RELEASE, "agent");
            asm volatile("s_waitcnt vmcnt(0)" ::: "memory");
            const unsigned og = xb_add(&bar[XB_TOP], 1u);
            const unsigned tg = og / nx;
            if (og + 1u == (tg + 1u) * nx) xb_add(&bar[XB_TOPGEN], 1u);
            else XB_SPIN(xb_ld(&bar[XB_TOPGEN]) == tg, bar);
            __builtin_amdgcn_fence(__ATOMIC_ACQUIRE, "agent");
            xb_add(&bar[XB_XGEN(b.x)], 1u);
            asm volatile("s_waitcnt vmcnt(0)" ::: "memory");
        } else {
            XB_SPIN(xb_ld(&bar[XB_XGEN(b.x)]) == gen, bar);
            __builtin_amdgcn_fence(__ATOMIC_ACQUIRE, "agent");
            asm volatile("s_waitcnt vmcnt(0)" ::: "memory");
        }
    }
    __syncthreads();
}

__global__ void __launch_bounds__(512, 2) hymba_fwd(Params p0) {
    extern __shared__ __attribute__((aligned(16))) unsigned char lds_raw[];
    cg::grid_group grid = cg::this_grid();
    const int G = gridDim.x, bid = blockIdx.x, ngw = G * 8;
    volatile LAS unsigned* bst = (volatile LAS unsigned*)((lds_t)lds_raw + (LDS_BYTES - 64));
    if (threadIdx.x < 16) bst[threadIdx.x] = 0u;
    __syncthreads();
    const XcdBarrier bar = xcd_barrier_post((unsigned*)(p0.ws + WS_CTL), bst);
#define PHASE_BEGIN \
    int tid = threadIdx.x; asm volatile("" : "+v"(tid)); \
    const int lane = tid & 63, wave = __builtin_amdgcn_readfirstlane(tid >> 6); \
    unsigned lo_ = 0; asm volatile("" : "+s"(lo_)); lds_t lds = (lds_t)lds_raw + lo_; \
    Params p = p0; asm volatile("" : "+s"(p.ws)); p.wsl = p.ws + WS_SMALL + (size_t)lcur * SMALL_BYTES; \
    GAS unsigned char* ws = p.ws; const int gw = bid * 8 + wave; (void)gw; (void)lane; (void)lds; (void)ws;

#pragma clang loop unroll(disable)
    for (int l = 0; l < DEPTH; ++l) {
        const int lcur = l;
        if (l == 0) {
            {
                PHASE_BEGIN
                phase_wconv(p, 0, 1, gw, ngw, lane);
                for (int m = gw; m < NT; m += ngw) prep_row(p.in[0] + (size_t)m * DM, (bf16_t*)(ws + WS_HB) + (size_t)m * DM, (float*)(ws + WS_SS1), m, lane, p.in[1]);
            }
            if (p0.ws == nullptr) grid.sync();
            xcd_barrier(bar);
        }
        {
            PHASE_BEGIN
            pg8::Gemm g{(const bf16_t*)(ws + WS_HB), (const bf16_t*)(ws + WS_WIN), NT, NPROJ, DM}; pg8::StaticOrder S; S.init(NT, NPROJ, G, bid);
            gate_wt_prep(p, l, bid * 512 + tid);
            pg8::rstd_table((LAS float*)(lds + 131072), (const float*)(ws + WS_SS1 + (size_t)l * MiB), S, tid);
            pg8::EpiStoreF32 E{(float*)(ws + WS_PROJ), NPROJ, (const LAS float*)(lds + 131072), 0, (bf16_t*)(ws + WS_QKV)};
            pg8::gemm_phase<pg8::EpiStoreF32, pg8::StaticOrder, true, true>(lds, g, S, E, tid);
            { const int nfull = (NT / 256) * (NPROJ / 256) % G; if (nfull > 0 && bid >= nfull) phase_wconv(p, l, 2 | 4, (bid - nfull) * 8 + wave, (G - nfull) * 8, lane); else if (nfull == 0) phase_wconv(p, l, 2 | 4, gw, ngw, lane); }
        }
        xcd_barrier(bar);
        {
            PHASE_BEGIN
            if (gw < 32) fox_cumsum(p, l, gw, lane);
            {
                lds_t wl = lds + wave * 18432;
                if (G == 256) {
                    if (wave < 4) { gla_prep_witem(p, l, bid * 4 + wave, wl, lane); lru_prep_witem(p, l, bid * 16 + wave, wl, lane); }
                    else for (int k = 0; k < 3; ++k) lru_prep_witem(p, l, bid * 16 + 4 + (wave - 4) * 3 + k, wl, lane);
                } else
                for (int it = gw; it < 1024 + 4096; it += ngw) {
                    if (it < 1024) gla_prep_witem(p, l, it, wl, lane);
                    else lru_prep_witem(p, l, it - 1024, wl, lane);
                }
            }
        }
        xcd_barrier(bar);
        {
            PHASE_BEGIN
            for (int it = bid; it < 256; it += G) {
                const int bh = it >> 3, s = it & 7;
                fox_attn_unit(p, bh, 15 - s, lds, tid, wave, lane);
                fox_attn_unit(p, bh, s, lds, tid, wave, lane);
            }
            for (int it = bid; it < 256; it += G) gla_scan_item(p, it, tid);
            for (int it = G - 1 - bid; it < 8; it += G) lru_tilescan_item(p, it, tid);
        }
        xcd_barrier(bar);
        {
            PHASE_BEGIN
            for (int it = bid; it < 256; it += G) lru_out_item(p, l, it, lds, tid, wave, lane);
            for (int it = gw; it < 2048; it += ngw) gla_out_witem(p, l, it, lane);
            if (NT % (4 * ngw) == 0) { for (int tok = gw; tok < NT; tok += 4 * ngw) fox_norm_rows4(p, l, tok, ngw, lane); }
            else for (int tok = gw; tok < NT; tok += ngw) fox_norm_rows4(p, l, tok, 0, lane);
        }
        xcd_barrier(bar);
        {
            PHASE_BEGIN
            const float* xin = (l == 0) ? p.in[0] : (const float*)(ws + WS_XW);
            pg8::Gemm g{(const bf16_t*)(ws + WS_MIX), (const bf16_t*)(ws + WS_WOUT), NT, DM, DM}; pg8::StaticOrder S; S.init(NT, DM, G, bid);
            pg8::EpiResid E{xin, (float*)(ws + WS_XW), (bf16_t*)(ws + WS_HB), (float*)(ws + WS_SS2 + (size_t)l * MiB), p.in[17] + l * DM, DM};
            pg8::gemm_phase<pg8::EpiResid, pg8::StaticOrder, true, true>(lds, g, S, E, tid);
        }
        xcd_barrier(bar);
        {
            PHASE_BEGIN
            pg8::Gemm g{(const bf16_t*)(ws + WS_HB), (const bf16_t*)(ws + WS_WGU), NT, 2 * FFH, DM}; pg8::StaticOrder S; S.init(NT, 2 * FFH, G, bid);
            pg8::rstd_table((LAS float*)(lds + 131072), (const float*)(ws + WS_SS2 + (size_t)l * MiB), S, tid);
            pg8::EpiSwiglu E{(bf16_t*)(ws + WS_PROJ), FFH, (const LAS float*)(lds + 131072), 0};
            pg8::gemm_phase<pg8::EpiSwiglu, pg8::StaticOrder, true, true>(lds, g, S, E, tid);
            { const int nfull = (NT / 256) * (2 * FFH / 256) % G; const int msk = 8 | (l + 1 < DEPTH ? 1 : 0); const int ln = (l + 1 < DEPTH) ? l + 1 : l;
              if (nfull > 0 && bid >= nfull) { phase_wconv(p, l, 8, (bid - nfull) * 8 + wave, (G - nfull) * 8, lane); if (msk & 1) phase_wconv(p, ln, 1, (bid - nfull) * 8 + wave, (G - nfull) * 8, lane); }
              else if (nfull == 0) { phase_wconv(p, l, 8, gw, ngw, lane); if (msk & 1) phase_wconv(p, ln, 1, gw, ngw, lane); } }
        }
        xcd_barrier(bar);
        {
            PHASE_BEGIN
            pg8::Gemm g{(const bf16_t*)(ws + WS_PROJ), (const bf16_t*)(ws + WS_WDN), NT, DM, FFH}; pg8::StaticOrder S; S.init(NT, DM, G, bid);
            pg8::EpiResid E{(const float*)(ws + WS_XW), (float*)(ws + WS_XW), (l < DEPTH - 1) ? (bf16_t*)(ws + WS_HB) : (bf16_t*)nullptr, (float*)(ws + WS_SS1 + (size_t)(l + 1) * MiB), p.in[1] + (l < DEPTH - 1 ? l + 1 : 0) * DM, DM};
            pg8::gemm_phase<pg8::EpiResid, pg8::StaticOrder, true, true>(lds, g, S, E, tid);
        }
        xcd_barrier(bar);
    }
    {
        const int lcur = 0;
        PHASE_BEGIN
        if (NT % (4 * ngw) == 0) {
            const f32x4* gr = (const f32x4*)p.in[21] + lane;
            const float* ssb = (const float*)(ws + WS_SS1 + (size_t)DEPTH * MiB);
            for (int m0 = gw; m0 < NT; m0 += 4 * ngw) {
                f32x4 xv[4][8]; float pv[4];
#pragma unroll
                for (int k = 0; k < 4; ++k) {
                    const int m = m0 + k * ngw;
                    pv[k] = lane < 32 ? ssb[((size_t)(lane >> 2) * 8192 + m) * 4 + (lane & 3)] : 0.f;
                    const f32x4* xr = (const f32x4*)((const float*)(ws + WS_XW) + (size_t)m * DM) + lane;
#pragma unroll
                    for (int j = 0; j < 8; ++j) xv[k][j] = xr[64 * j];
                }
                f32x4 gv[8];
#pragma unroll
                for (int j = 0; j < 8; ++j) gv[j] = gr[64 * j];
#pragma unroll
                for (int k = 0; k < 4; ++k) {
                    const int m = m0 + k * ngw;
                    const float rstd = rsqrtf(wave_sum(pv[k]) * (1.0f / 2048.0f) + EPS);
                    f32x4* orow = (f32x4*)(p.out + (size_t)m * DM) + lane;
#pragma unroll
                    for (int j = 0; j < 8; ++j) orow[64 * j] = xv[k][j] * rstd * gv[j];
                }
            }
        } else
        for (int m = gw; m < NT; m += ngw) { const float sv = wave_sum(lane < 32 ? ((const float*)(ws + WS_SS1 + (size_t)DEPTH * MiB))[((size_t)(lane >> 2) * 8192 + m) * 4 + (lane & 3)] : 0.f);
            final_row((const float*)(ws + WS_XW) + (size_t)m * DM, p.in[21], p.out + (size_t)m * DM, sv, lane); }
    }
}

extern "C" void kernel_launch(void* const* d_in, const int* in_sizes, int n_in, void* d_out, int out_size, void* d_ws, size_t ws_size, hipStream_t stream) {
    static int grid_blocks = 0;
    if (grid_blocks == 0) {
        if (n_in != 22 || ws_size < WS_END) { fprintf(stderr, "kernel_launch: unexpected n_in %d / ws_size %zu\n", n_in, ws_size); grid_blocks = -1; return; }
        int dev = 0, cus = 0, per_cu = 0;
        hipGetDevice(&dev);
        hipDeviceGetAttribute(&cus, hipDeviceAttributeMultiprocessorCount, dev);
        hipFuncSetAttribute((const void*)hymba_fwd, hipFuncAttributeMaxDynamicSharedMemorySize, LDS_BYTES);
        hipOccupancyMaxActiveBlocksPerMultiprocessor(&per_cu, (const void*)hymba_fwd, 512, LDS_BYTES);
        if (per_cu < 1) { fprintf(stderr, "kernel_launch: occupancy query says %d blocks per CU\n", per_cu); per_cu = 1; }
        (void)hipGetLastError();
        grid_blocks = cus * 1;
    }
    if (grid_blocks < 0) return;
    Params p{};
    for (int i = 0; i < 22; ++i) p.in[i] = (const float*)d_in[i];
    p.out = (float*)d_out; p.ws = (GAS unsigned char*)d_ws;
    if (hipMemsetAsync((unsigned char*)d_ws + WS_CTL, 0, CTL_BYTES, stream) != hipSuccess) { fprintf(stderr, "kernel_launch: memset failed\n"); return; }
    void* args[] = {&p};
    hipError_t e = hipLaunchCooperativeKernel((const void*)hymba_fwd, dim3(grid_blocks), dim3(512), args, LDS_BYTES, stream);
    if (e != hipSuccess) fprintf(stderr, "cooperative launch failed: %s (grid %d)\n", hipGetErrorString(e), grid_blocks);
}
```

```cpp
#include <hip/hip_runtime.h>
#include <hip/hip_cooperative_groups.h>
#include <cstdio>
#include <cstdint>
namespace cg = cooperative_groups;
namespace pg8 {
#define PG8_LAS __attribute__((address_space(3)))
typedef unsigned short bf16_t;
typedef short bf16x8 __attribute__((ext_vector_type(8)));
typedef float f32x4 __attribute__((ext_vector_type(4)));
typedef unsigned u32x4 __attribute__((ext_vector_type(4)));
constexpr int BM = 256, BK = 64, HALF = 128, HTB = HALF * BK * 2  , STAGE_BYTES = 8 * HTB, NXCD = 8, WGM = 8;

__host__ __device__ __forceinline__ int lds_byte(int r, int c) { const int st = (r >> 4) * 2 + (c >> 5), rr = r & 15, cc = c & 31, ob = rr * 64 + cc * 2; return st * 1024 + (ob ^ (((ob >> 9) & 1) << 5)); }
__host__ __device__ __forceinline__ void stage_rc(int b, int& R, int& C) { const int st = b / 1024, sb = b % 1024, swz = sb ^ (((sb >> 9) & 1) << 5); R = (st >> 1) * 16 + swz / 64; C = (st & 1) * 32 + (swz % 64) / 2; }
__host__ __device__ __forceinline__ int perm32(int rho) { const int n = rho >> 4, i = rho & 15; return 8 * (i >> 2) + 4 * n + (i & 3); }

struct Unit { int pm, pn; };
struct Gemm { const bf16_t* A; const bf16_t* Bt; int M, N, K; };

struct StaticOrder {
    int nM, nN, nwg, G, c;
    __host__ __device__ void init(int M, int N, int G_, int c_) { nM = M / BM; nN = N / BM; nwg = nM * nN; G = G_; c = c_; }
    __host__ __device__ bool next(int i, Unit& u) const {
        const long L = (long)i * G + c; if (L >= nwg) return false;
        int wgid = (int)L; { const int q = nwg / NXCD, r = nwg % NXCD, xcd = wgid % NXCD, off = wgid / NXCD; wgid = (xcd < r ? xcd * (q + 1) : r * (q + 1) + (xcd - r) * q) + off; }
        const int nig = WGM * nN, gid = wgid / nig, fm = gid * WGM, gsz = (nM - fm) < WGM ? (nM - fm) : WGM;
        u.pm = fm + ((wgid % nig) % gsz); u.pn = (wgid % nig) / gsz; return true;
    }
    __device__ __forceinline__ void a_ready(const Unit&) const {}
    __device__ __forceinline__ void done(const Unit&) const {}
};

typedef unsigned u32x2 __attribute__((ext_vector_type(2)));
__device__ __forceinline__ unsigned cvt_pk_bf16(float lo, float hi) { unsigned r; asm("v_cvt_pk_bf16_f32 %0, %1, %2" : "=v"(r) : "v"(lo), "v"(hi)); return r; }
__device__ __forceinline__ float ssp_sum(const float* p, int row) {
    float s = 0.f;
#pragma unroll
    for (int i = 0; i < 8; ++i) { const f32x4 v = *(const f32x4*)(p + ((size_t)i * 8192 + row) * 4); s += (v[0] + v[1]) + (v[2] + v[3]); }
    return s;
}
template <class Sched> __device__ __forceinline__ void rstd_table(PG8_LAS float* rtab, const float* ss, const Sched& S, int tid) {
    float v[4]; bool ok[4];
#pragma unroll
    for (int k = 0; k < 4; ++k) { const int i = 2 * k + (tid >> 8); Unit u; ok[k] = S.next(i, u); v[k] = ok[k] ? ssp_sum(ss, u.pm * BM + (tid & 255)) : 0.f; }
#pragma unroll
    for (int k = 0; k < 4; ++k) if (ok[k]) rtab[(2 * k + (tid >> 8)) * 256 + (tid & 255)] = rsqrtf(v[k] * (1.0f / 2048.0f) + 1e-6f);
    __syncthreads();
}
#define PG8_ROW_RSTD(rs, ss, row0) float rs[2][4]; { const int lane_ = (int)(threadIdx.x & 63u); \
    const float v0_ = rsqrtf(ssp_sum((ss), (row0) + (lane_ >> 4) * 16) * (1.0f / 2048.0f) + 1e-6f), v1_ = rsqrtf(ssp_sum((ss), (row0) + HALF + (lane_ >> 4) * 16) * (1.0f / 2048.0f) + 1e-6f); \
    _Pragma("unroll") for (int m_ = 0; m_ < 4; ++m_) { rs[0][m_] = __shfl(v0_, (lane_ & 15) + 16 * m_); rs[1][m_] = __shfl(v1_, (lane_ & 15) + 16 * m_); } }
struct EpiStoreF32 {
    static constexpr bool PERM = false, AFTER_DRAIN = false;
    float* O; int ldc; const PG8_LAS float* rtab; mutable int ui;
    bf16_t* qkv;
    __device__ __forceinline__ void operator()(const f32x4 (&acc)[2][2][4][2], const Unit& u, int wr, int wc, int fr, int fq) const {
        const int row0 = u.pm * BM + wr * 64 + fr, col0 = u.pn * BM + wc * 32 + 4 * fq;
        const PG8_LAS float* rt = rtab + ui * 256 + wr * 64 + fr; ++ui;
#pragma unroll
        for (int ai = 0; ai < 2; ++ai)
#pragma unroll
            for (int m = 0; m < 4; ++m) { const int row = row0 + ai * HALF + m * 16; float* rowp = O + (size_t)row * ldc + col0;
                const float rs = rt[ai * HALF + m * 16];
                if (u.pn < 6 || (u.pn >> 1) == 4) {
                    const float sc = (u.pn < 2) ? 0.125f * 1.4426950408889634f : 1.0f;
                    bf16_t* bp = qkv + ((size_t)(u.pn < 6 ? (u.pn >> 1) : 3) * 8192 + row) * 512 + (u.pn & 1) * 256 + wc * 32 + 4 * fq;
#pragma unroll
                    for (int bj = 0; bj < 2; ++bj)
#pragma unroll
                        for (int n = 0; n < 2; ++n) { f32x4 v = acc[ai][bj][m][n] * rs; if (u.pn < 2) v = v * sc;
                            u32x2 w; w.x = cvt_pk_bf16(v[0], v[1]); w.y = cvt_pk_bf16(v[2], v[3]); *(u32x2*)(bp + bj * HALF + n * 16) = w; }
                } else {
#pragma unroll
                for (int bj = 0; bj < 2; ++bj)
#pragma unroll
                    for (int n = 0; n < 2; ++n) *(f32x4*)(rowp + bj * HALF + n * 16) = acc[ai][bj][m][n] * rs; } }
    }
};
struct EpiResid {
    static constexpr bool PERM = false, AFTER_DRAIN = false;
    const float* base; float* out; bf16_t* xb; float* ss; const float* gain; int ldc;
    __device__ __forceinline__ void operator()(const f32x4 (&acc)[2][2][4][2], const Unit& u, int wr, int wc, int fr, int fq) const {
        const int row0 = u.pm * BM + wr * 64 + fr, col0 = u.pn * BM + wc * 32 + 4 * fq;
        f32x4 gv[2][2];
#pragma unroll
        for (int bj = 0; bj < 2; ++bj)
#pragma unroll
            for (int n = 0; n < 2; ++n) gv[bj][n] = *(const f32x4*)(gain + col0 + bj * HALF + n * 16);
#pragma unroll
        for (int ai = 0; ai < 2; ++ai) {
            f32x4 pre[4][2][2];
#pragma unroll
            for (int m = 0; m < 4; ++m)
#pragma unroll
                for (int bj = 0; bj < 2; ++bj)
#pragma unroll
                    for (int n = 0; n < 2; ++n) pre[m][bj][n] = *(const f32x4*)(base + (size_t)(row0 + ai * HALF + m * 16) * ldc + col0 + bj * HALF + n * 16);
#pragma unroll
            for (int m = 0; m < 4; ++m) { const int row = row0 + ai * HALF + m * 16; const size_t off = (size_t)row * ldc + col0; float s = 0.f;
#pragma unroll
                for (int bj = 0; bj < 2; ++bj)
#pragma unroll
                    for (int n = 0; n < 2; ++n) { const f32x4 b = pre[m][bj][n]; const f32x4 v = b + acc[ai][bj][m][n];
                        *(f32x4*)(out + off + bj * HALF + n * 16) = v; s += (v[0] * v[0] + v[1] * v[1]) + (v[2] * v[2] + v[3] * v[3]);
                        if (xb) { const f32x4 y = v * gv[bj][n]; u32x2 w; w.x = cvt_pk_bf16(y[0], y[1]); w.y = cvt_pk_bf16(y[2], y[3]); *(u32x2*)(xb + off + bj * HALF + n * 16) = w; } }
                s += __shfl_xor(s, 16); s += __shfl_xor(s, 32);
                if (fq == 0) ss[((size_t)u.pn * 8192 + row) * 4 + wc] = s; }
            asm volatile("" ::: "memory");
        }
    }
};
struct EpiSwiglu {
    static constexpr bool PERM = true, AFTER_DRAIN = false;
    bf16_t* O; int ldc; const PG8_LAS float* rtab; mutable int ui;
    __device__ __forceinline__ void operator()(const f32x4 (&acc)[2][2][4][2], const Unit& u, int wr, int wc, int fr, int fq) const {
        const int row0 = u.pm * BM + wr * 64 + fr, col0 = u.pn * HALF + wc * 32 + 8 * fq;
        const PG8_LAS float* rt = rtab + ui * 256 + wr * 64 + fr; ++ui;
#pragma unroll
        for (int ai = 0; ai < 2; ++ai)
#pragma unroll
            for (int m = 0; m < 4; ++m) {
                const float rs = rt[ai * HALF + m * 16];
                float h[8];
#pragma unroll
                for (int n = 0; n < 2; ++n)
#pragma unroll
                    for (int e = 0; e < 4; ++e) { const float g = acc[ai][0][m][n][e] * rs, up = acc[ai][1][m][n][e] * rs; h[n * 4 + e] = g * __builtin_amdgcn_rcpf(1.0f + __builtin_amdgcn_exp2f(g * -1.4426950408889634f)) * up; }
                u32x4 w; w.x = cvt_pk_bf16(h[0], h[1]); w.y = cvt_pk_bf16(h[2], h[3]); w.z = cvt_pk_bf16(h[4], h[5]); w.w = cvt_pk_bf16(h[6], h[7]);
                *(u32x4*)(O + (size_t)(row0 + ai * HALF + m * 16) * ldc + col0) = w; }
    }
};
template <class Epi, class Sched, bool ALIGN_EPI = false, bool SP2 = false>
__device__ __forceinline__ void gemm_phase(PG8_LAS unsigned char* lds, const Gemm g, const Sched& S, const Epi& E, const int tid) {
    const int wid = __builtin_amdgcn_readfirstlane(tid >> 6), lane = tid & 63, wr = wid >> 2, wc = wid & 3, fr = lane & 15, fq = lane >> 4;
    const int K = g.K, nt = K / BK;
    unsigned voffA[2], voffB[2];
#pragma unroll
    for (int i = 0; i < 2; ++i) { int R, C; stage_rc(tid * 16 + i * 8192, R, C); const int Rb = Epi::PERM ? ((R & ~31) + perm32(R & 31)) : R;
        voffA[i] = (unsigned)(R * K + C) * 2u; voffB[i] = (unsigned)(Rb * K + C) * 2u; }
    const size_t kstep = (size_t)(BK * 2);
    const size_t hstep = (size_t)HALF * K * 2;
    const size_t tstep = 2 * hstep;
    const unsigned ldsw = (unsigned)wid * 1024u;
    const int aoff = lds_byte(wr * 64 + fr, fq * 8), boff = lds_byte(wc * 32 + fr, fq * 8);
#define PG8_SA(b, h) (((b) * 2 + (h)) * HTB)
#define PG8_SB(b, h) ((4 + (b) * 2 + (h)) * HTB)
#define PG8_STAGE(bufoff, gbase, voff) do { _Pragma("unroll") for (int _i = 0; _i < 2; ++_i) \
        __builtin_amdgcn_global_load_lds((const unsigned*)((const char*)(gbase) + (voff)[_i]), (PG8_LAS unsigned*)(lds + (bufoff) + ldsw + _i * 8192), 16, 0, 0); } while (0)
#define PG8_LDA(dst, b, h) do { _Pragma("unroll") for (int m = 0; m < 4; ++m) _Pragma("unroll") for (int k = 0; k < 2; ++k) dst[m][k] = *(const PG8_LAS bf16x8*)(lds + PG8_SA(b, h) + aoff + m * 2048 + k * 1024); } while (0)
#define PG8_LDB(dst, b, h) do { _Pragma("unroll") for (int n = 0; n < 2; ++n) _Pragma("unroll") for (int k = 0; k < 2; ++k) dst[n][k] = *(const PG8_LAS bf16x8*)(lds + PG8_SB(b, h) + boff + n * 2048 + k * 1024); } while (0)
#define PG8_MMA(ai, bj, At, Bt) do { __builtin_amdgcn_s_setprio(1); _Pragma("unroll") for (int m = 0; m < 4; ++m) _Pragma("unroll") for (int n = 0; n < 2; ++n) _Pragma("unroll") for (int k = 0; k < 2; ++k) \
        acc[ai][bj][m][n] = __builtin_amdgcn_mfma_f32_16x16x32_bf16(Bt[n][k], At[m][k], acc[ai][bj][m][n], 0, 0, 0); __builtin_amdgcn_s_setprio(0); } while (0)
#define PG8_WAIT_V(n) asm volatile("s_waitcnt vmcnt(" #n ")" ::: "memory")
#define PG8_WAIT_L(n) asm volatile("s_waitcnt lgkmcnt(" #n ")" ::: "memory")
#define PG8_BAR __builtin_amdgcn_s_barrier()
#define PG8_SCHED __builtin_amdgcn_sched_barrier(0)
    Unit cur, nxt; int ui = 0;
    if (!S.next(0, cur)) return;
    f32x4 acc[2][2][4][2];
#pragma unroll
    for (int a = 0; a < 2; ++a)
#pragma unroll
        for (int b = 0; b < 2; ++b)
#pragma unroll
            for (int m = 0; m < 4; ++m)
#pragma unroll
                for (int n = 0; n < 2; ++n) acc[a][b][m][n] = (f32x4){0.f, 0.f, 0.f, 0.f};
    bf16x8 At[4][2], B0[2][2], B1[2][2];
    const char* cA = (const char*)g.A + (size_t)cur.pm * tstep; const char* cB = (const char*)g.Bt + (size_t)cur.pn * tstep;
    S.a_ready(cur);
    if constexpr (SP2) {
        PG8_STAGE(PG8_SB(0, 0), cB, voffB); PG8_STAGE(PG8_SB(0, 1), cB + hstep, voffB); PG8_STAGE(PG8_SA(0, 0), cA, voffA); PG8_STAGE(PG8_SA(0, 1), cA + hstep, voffA);
        if (wr == 1) PG8_BAR;
        PG8_WAIT_V(2); PG8_BAR;
        PG8_STAGE(PG8_SB(1, 0), cB + kstep, voffB); PG8_STAGE(PG8_SA(1, 0), cA + kstep, voffA); PG8_STAGE(PG8_SB(1, 1), cB + hstep + kstep, voffB);
        PG8_WAIT_V(6); PG8_BAR;
    } else {
        PG8_STAGE(PG8_SB(0, 0), cB, voffB); PG8_STAGE(PG8_SA(0, 0), cA, voffA); PG8_STAGE(PG8_SB(0, 1), cB + hstep, voffB); PG8_STAGE(PG8_SA(0, 1), cA + hstep, voffA);
        if (wr == 1) PG8_BAR;
        PG8_WAIT_V(4); PG8_BAR;
        PG8_STAGE(PG8_SB(1, 0), cB + kstep, voffB); PG8_STAGE(PG8_SA(1, 0), cA + kstep, voffA); PG8_STAGE(PG8_SB(1, 1), cB + hstep + kstep, voffB);
        PG8_WAIT_V(6); PG8_BAR;
    }
    for (;;) {
        const bool has_next = S.next(ui + 1, nxt);
        const char* nA = has_next ? (const char*)g.A + (size_t)nxt.pm * tstep : cA; const char* nB = has_next ? (const char*)g.Bt + (size_t)nxt.pn * tstep : cB;
        for (int t = 0; t < nt; t += 2) {
            const bool last = (t == nt - 2);
            const char* a1 = cA + (size_t)(t + 1) * kstep;
            const char* a2 = last ? nA : cA + (size_t)(t + 2) * kstep; const char* b2 = last ? nB : cB + (size_t)(t + 2) * kstep;
            const char* a3 = a2 + kstep; const char* b3 = b2 + kstep;
            if (last && has_next) S.a_ready(nxt);
            if constexpr (SP2) {
            PG8_LDB(B0, 0, 0); PG8_LDB(B1, 0, 1); PG8_SCHED; PG8_LDA(At, 0, 0); PG8_STAGE(PG8_SA(1, 1), a1 + hstep, voffA);
            PG8_WAIT_V(8); PG8_WAIT_L(0); PG8_BAR; PG8_MMA(0, 0, At, B0); PG8_MMA(0, 1, At, B1); PG8_BAR; PG8_SCHED;
            PG8_LDA(At, 0, 1); PG8_STAGE(PG8_SB(0, 0), b2, voffB); PG8_STAGE(PG8_SB(0, 1), b2 + hstep, voffB); PG8_STAGE(PG8_SA(0, 0), a2, voffA);
            PG8_WAIT_V(8); PG8_WAIT_L(0); PG8_BAR; PG8_MMA(1, 0, At, B0); PG8_MMA(1, 1, At, B1); PG8_BAR; PG8_SCHED;
            PG8_LDB(B0, 1, 0); PG8_LDB(B1, 1, 1); PG8_SCHED; PG8_LDA(At, 1, 0); PG8_STAGE(PG8_SA(0, 1), a2 + hstep, voffA);
            PG8_WAIT_V(8); PG8_WAIT_L(0); PG8_BAR; PG8_MMA(0, 0, At, B0); PG8_MMA(0, 1, At, B1); PG8_BAR; PG8_SCHED;
            PG8_LDA(At, 1, 1); PG8_STAGE(PG8_SB(1, 0), b3, voffB); PG8_STAGE(PG8_SB(1, 1), b3 + hstep, voffB); PG8_STAGE(PG8_SA(1, 0), a3, voffA);
            PG8_WAIT_V(8); PG8_WAIT_L(0); PG8_BAR; PG8_MMA(1, 0, At, B0); PG8_MMA(1, 1, At, B1); PG8_BAR; PG8_SCHED;
            } else {
            PG8_LDB(B0, 0, 0); PG8_SCHED; PG8_LDA(At, 0, 0); PG8_STAGE(PG8_SA(1, 1), a1 + hstep, voffA);
            PG8_WAIT_L(8); PG8_BAR; PG8_WAIT_L(0); PG8_MMA(0, 0, At, B0); PG8_BAR; PG8_SCHED;
            PG8_LDB(B1, 0, 1); PG8_STAGE(PG8_SB(0, 0), b2, voffB);
            PG8_BAR; PG8_WAIT_L(0); PG8_MMA(0, 1, At, B1); PG8_BAR;
            PG8_LDA(At, 0, 1); PG8_STAGE(PG8_SA(0, 0), a2, voffA);
            PG8_BAR; PG8_WAIT_L(0); PG8_MMA(1, 0, At, B0); PG8_BAR; PG8_SCHED;
            PG8_STAGE(PG8_SB(0, 1), b2 + hstep, voffB);
            PG8_WAIT_V(6); PG8_BAR; PG8_MMA(1, 1, At, B1); PG8_BAR;
            PG8_LDB(B0, 1, 0); PG8_SCHED; PG8_LDA(At, 1, 0); PG8_STAGE(PG8_SA(0, 1), a2 + hstep, voffA);
            PG8_WAIT_L(8); PG8_BAR; PG8_WAIT_L(0); PG8_MMA(0, 0, At, B0); PG8_BAR; PG8_SCHED;
            PG8_LDB(B1, 1, 1); PG8_STAGE(PG8_SB(1, 0), b3, voffB);
            PG8_BAR; PG8_WAIT_L(0); PG8_MMA(0, 1, At, B1); PG8_BAR;
            PG8_LDA(At, 1, 1); PG8_STAGE(PG8_SA(1, 0), a3, voffA);
            PG8_BAR; PG8_WAIT_L(0); PG8_MMA(1, 0, At, B0); PG8_BAR; PG8_SCHED;
            PG8_STAGE(PG8_SB(1, 1), b3 + hstep, voffB);
            PG8_WAIT_V(6); PG8_BAR; PG8_MMA(1, 1, At, B1); PG8_BAR;
            }
        }
        if constexpr (ALIGN_EPI) { if (wr == 0) PG8_BAR; }
        if constexpr (!Epi::AFTER_DRAIN) { E(acc, cur, wr, wc, fr, fq); S.done(cur); }
        if (!has_next) break;
#pragma unroll
        for (int a = 0; a < 2; ++a)
#pragma unroll
            for (int b = 0; b < 2; ++b)
#pragma unroll
                for (int m = 0; m < 4; ++m)
#pragma unroll
                    for (int n = 0; n < 2; ++n) acc[a][b][m][n] = (f32x4){0.f, 0.f, 0.f, 0.f};
        cur = nxt; cA = nA; cB = nB; ++ui;
        if constexpr (ALIGN_EPI) { if (wr == 1) PG8_BAR; }
    }
    PG8_WAIT_V(0);
    if constexpr (!ALIGN_EPI) { if (wr == 0) PG8_BAR; }
    PG8_BAR;
    if constexpr (Epi::AFTER_DRAIN) { E.fused(acc, cur, wr, wc, fr, fq, lds, wid, lane); S.done(cur); }
#undef PG8_SA
#undef PG8_SB
#undef PG8_STAGE
#undef PG8_LDA
#undef PG8_LDB
#undef PG8_MMA
#undef PG8_WAIT_V
#undef PG8_WAIT_L
#undef PG8_BAR
#undef PG8_SCHED
}
}

#define LAS __attribute__((address_space(3)))
typedef unsigned short bf16_t;
typedef short bf16x8 __attribute__((ext_vector_type(8)));
typedef short s16x4 __attribute__((ext_vector_type(4)));
typedef float f32x4 __attribute__((ext_vector_type(4)));
typedef float f32x2 __attribute__((ext_vector_type(2)));
typedef unsigned u32x4 __attribute__((ext_vector_type(4)));
typedef unsigned u32x2 __attribute__((ext_vector_type(2)));
typedef LAS unsigned char* lds_t;

constexpr int NT = 8192, DM = 2048, SEQ = 2048, NB = 4, DEPTH = 4;
constexpr int INW = 5144, NPROJ = 5376, FFH = 5632;
constexpr int PC_FQ = 0, PC_FK = 512, PC_FV = 1024, PC_GQ = 1536, PC_GK = 1792, PC_GV = 2048, PC_GG = 2560, PC_LG = 3072, PC_LX = 4096, PC_FF = 5120, PC_GR = 5128;
constexpr float EPS = 1e-6f;
constexpr float LOG2E = 1.4426950408889634f;
constexpr int LDS_BYTES = 147456;

constexpr size_t MiB = 1u << 20;
constexpr size_t WS_WIN = 0, WS_WOUT = 21 * MiB, WS_WGU = 29 * MiB, WS_WDN = 73 * MiB;
constexpr size_t WS_XW = 96 * MiB;
constexpr size_t WS_HB = 160 * MiB;
constexpr size_t WS_PROJ = 192 * MiB;
constexpr size_t WS_MIX = 360 * MiB;
constexpr size_t WS_FOXO = 392 * MiB;
constexpr size_t WS_CBUF = 400 * MiB;
constexpr size_t WS_GQT = 401 * MiB;
constexpr size_t WS_GA = 405 * MiB;
constexpr size_t WS_GVT = 407 * MiB;
constexpr size_t WS_GU = 415 * MiB;
constexpr size_t WS_GS = 447 * MiB;
constexpr size_t WS_GDEC = 463 * MiB;
constexpr size_t WS_LA = 464 * MiB;
constexpr size_t WS_LU = 496 * MiB;
constexpr size_t WS_AGP = 528 * MiB, WS_AGH = 529 * MiB, WS_HIN = 530 * MiB;
constexpr size_t WS_SS1 = 532 * MiB, WS_SS2 = 537 * MiB;
constexpr size_t WS_CTL = 531 * MiB, CTL_BYTES = 16384;
constexpr size_t WS_GWT = 541 * MiB;
constexpr size_t WS_SMALL = 542 * MiB, SMALL_BYTES = 10 * MiB;
constexpr size_t SL_CBUF = 0, SL_GDEC = 256 * 1024, SL_GWT = 512 * 1024, SL_AGP = 1 * MiB, SL_AGH = 2 * MiB, SL_HIN = 3 * MiB, SL_GQT = 4 * MiB, SL_GA = 8 * MiB;
constexpr size_t WS_QKV = 582 * MiB;
constexpr size_t WS_END = 614 * MiB;

#define GAS __attribute__((address_space(1)))
struct Params { const float* in[22]; float* out; GAS unsigned char* ws; GAS unsigned char* wsl; };

__device__ __forceinline__ unsigned pk2(float lo, float hi) { unsigned r; asm("v_cvt_pk_bf16_f32 %0, %1, %2" : "=v"(r) : "v"(lo), "v"(hi)); return r; }
__device__ __forceinline__ bf16_t f2bf(float f) { return (bf16_t)(pk2(f, 0.f) & 0xffffu); }
__device__ __forceinline__ float bf2f(unsigned b) { return __uint_as_float(b << 16); }
__device__ __forceinline__ float logsig(float x) { return fminf(x, 0.f) - __logf(1.0f + __expf(-fabsf(x))); }
__device__ __forceinline__ float sigmoidf(float x) { return __builtin_amdgcn_rcpf(1.0f + __expf(-x)); }
__device__ __forceinline__ float neg_expm1_small(float y) {
    const float pl = y * (1.0f + y * (0.5f + y * (0.16666667f + y * (0.041666668f + y * (0.0083333338f + y * (0.0013888889f + y * 0.00019841270f))))));
    return (y > -0.25f) ? -pl : (1.0f - __expf(y));
}
__device__ __forceinline__ f32x4 mfma16(bf16x8 a, bf16x8 b, f32x4 c) { return __builtin_amdgcn_mfma_f32_16x16x32_bf16(a, b, c, 0, 0, 0); }
__device__ __forceinline__ float wave_sum(float v) {
#pragma unroll
    for (int o = 1; o < 64; o <<= 1) v += __shfl_xor(v, o);
    return v;
}
__device__ __forceinline__ bf16x8 pack8(f32x4 a, f32x4 b) {
    u32x4 w; w.x = pk2(a[0], a[1]); w.y = pk2(a[2], a[3]); w.z = pk2(b[0], b[1]); w.w = pk2(b[2], b[3]);
    return __builtin_bit_cast(bf16x8, w);
}

template <int MODE>
__device__ __forceinline__ void wconv_item(const float* W0, const float* W1, int Nsrc, int K, bf16_t* Bt, int NG, int item, int lane, const float* gain) {
    const int kb = item / NG, nb = item - kb * NG;
    const int kg = lane >> 4, ng = lane & 15;
    const int np = nb * 64 + ng * 4, k = kb * 32 + kg * 8;
    const float* src = W0; int c = np;
    if (MODE == 0) { c = np < 1536 ? np : np < 3072 ? np + 8 : np < 5120 ? np + 24 : np < 5128 ? np - 5120 + 1536 : np < 5144 ? np - 5128 + 3080 : -1; }
    if (MODE == 2) { const int pn = np >> 8, j = np & 255; src = j < 128 ? W0 : W1; c = pn * 128 + (j & 127); }
    f32x4 v[8];
#pragma unroll
    for (int i = 0; i < 8; ++i) v[i] = (c >= 0) ? *(const f32x4*)(src + (size_t)(k + i) * Nsrc + c) : (f32x4){0.f, 0.f, 0.f, 0.f};
    if (gain) { const f32x4 g0 = *(const f32x4*)(gain + k), g1 = *(const f32x4*)(gain + k + 4);
#pragma unroll
        for (int i = 0; i < 4; ++i) { v[i] = v[i] * g0[i]; v[4 + i] = v[4 + i] * g1[i]; } }
#pragma unroll
    for (int j = 0; j < 4; ++j) {
        u32x4 o; o.x = pk2(v[0][j], v[1][j]); o.y = pk2(v[2][j], v[3][j]); o.z = pk2(v[4][j], v[5][j]); o.w = pk2(v[6][j], v[7][j]);
        *(u32x4*)(Bt + (size_t)(np + j) * K + k) = o;
    }
}

__device__ __forceinline__ void prep_row(const float* xrow, bf16_t* orow, float* ss, int row, int lane, const float* g) {
    const f32x4* xr = (const f32x4*)xrow + lane; const f32x4* gr = (const f32x4*)g + lane;
    f32x4 v[8]; float s = 0.f;
#pragma unroll
    for (int j = 0; j < 8; ++j) { v[j] = xr[64 * j]; s += (v[j][0] * v[j][0] + v[j][1] * v[j][1]) + (v[j][2] * v[j][2] + v[j][3] * v[j][3]); }
    s = wave_sum(s);
    if (lane < 32) ss[((size_t)(lane >> 2) * 8192 + row) * 4 + (lane & 3)] = (lane == 0) ? s : 0.f;
#pragma unroll
    for (int j = 0; j < 8; ++j) { const f32x4 y = v[j] * gr[64 * j]; u32x2 w; w.x = pk2(y[0], y[1]); w.y = pk2(y[2], y[3]); ((u32x2*)orow)[lane + 64 * j] = w; }
}
__device__ __forceinline__ void final_row(const float* xrow, const float* g, float* orow, float ss, int lane) {
    const f32x4* xr = (const f32x4*)xrow + lane; const f32x4* gr = (const f32x4*)g + lane;
    const float rstd = rsqrtf(ss * (1.0f / 2048.0f) + EPS);
#pragma unroll
    for (int j = 0; j < 8; ++j) ((f32x4*)orow)[lane + 64 * j] = xr[64 * j] * rstd * gr[64 * j];
}

__device__ __forceinline__ void phase_wconv(const Params& p, int l, int mask, int w, int nw, int lane) {
    GAS unsigned char* ws = p.ws;
    constexpr int I_IN = 64 * 84, I_OUT = 64 * 32, I_GU = 64 * 176, I_DN = 176 * 32;
    const float* w_in = p.in[2] + (size_t)l * DM * INW;
    const float* w_out = p.in[16] + (size_t)l * DM * DM;
    const float* w_gate = p.in[18] + (size_t)l * DM * FFH;
    const float* w_up = p.in[19] + (size_t)l * DM * FFH;
    const float* w_down = p.in[20] + (size_t)l * FFH * DM;
    if (mask & 1) for (int it = w; it < I_IN; it += nw) wconv_item<0>(w_in, w_in, INW, DM, (bf16_t*)(ws + WS_WIN), 84, it, lane, nullptr);
    if (mask & 2) for (int it = w; it < I_OUT; it += nw) wconv_item<1>(w_out, w_out, DM, DM, (bf16_t*)(ws + WS_WOUT), 32, it, lane, nullptr);
    if (mask & 4) for (int it = w; it < I_GU; it += nw) wconv_item<2>(w_gate, w_up, FFH, DM, (bf16_t*)(ws + WS_WGU), 176, it, lane, nullptr);
    if (mask & 8) for (int it = w; it < I_DN; it += nw) wconv_item<1>(w_down, w_down, DM, FFH, (bf16_t*)(ws + WS_WDN), 32, it, lane, nullptr);
}

__device__ __forceinline__ void fox_cumsum(const Params& p, int l, int seq, int lane) {
    const float* proj = (const float*)(p.ws + WS_PROJ);
    float* cbuf = (float*)(p.wsl + SL_CBUF);
    const int b = seq >> 3, h = seq & 7;
    const float bias = p.in[3][l * 8 + h];
    const float* src = proj + (size_t)(b * SEQ + lane * 32) * NPROJ + PC_FF + h;
    float ls[32];
#pragma unroll
    for (int i = 0; i < 32; ++i) ls[i] = src[(size_t)i * NPROJ];
    float s = 0.f;
#pragma unroll
    for (int i = 0; i < 32; ++i) { ls[i] = logsig(ls[i] + bias); s += ls[i]; }
    float incl = s;
#pragma unroll
    for (int o = 1; o < 64; o <<= 1) { const float t = __shfl_up(incl, o); if (lane >= o) incl += t; }
    float run = incl - s;
    float* dst = cbuf + seq * SEQ + lane * 32;
#pragma unroll
    for (int i = 0; i < 32; ++i) { run += ls[i]; dst[i] = run * LOG2E; }
}

__device__ __forceinline__ void gate_wt_prep(const Params& p, int l, int gid) {
    if (gid < 2 * 16 * 64 * 64) {
        const int d = gid & 63, e = (gid >> 6) & 63, n = (gid >> 12) & 15, g = gid >> 16;
        const float* w = (g == 0 ? p.in[10] : p.in[12]) + ((size_t)(l * 16 + n) * 64 + d) * 64 + e;
        ((bf16_t*)(p.wsl + SL_GWT))[gid] = f2bf(*w);
    }
}

__device__ __forceinline__ void gla_prep_witem(const Params& p, int l, int ch, lds_t wl_in, int lane_in) {
    int lane = lane_in; asm volatile("" : "+v"(lane));
    unsigned wlo_ = 0; asm volatile("" : "+s"(wlo_)); lds_t wl = wl_in + wlo_;
    const float* proj = (const float*)(p.ws + WS_PROJ);
    const int bh = ch >> 6, n = ch & 63, b = bh >> 2, h = bh & 3;
    const int t0 = b * SEQ + n * 32;
    LAS bf16_t* Qs = (LAS bf16_t*)(wl);
    LAS bf16_t* Ks = (LAS bf16_t*)(wl + 4608);
    LAS bf16_t* KstT = (LAS bf16_t*)(wl);
    LAS bf16_t* VT = (LAS bf16_t*)(wl + 5120);
    const int r = lane & 15, q = lane >> 4;
    float gqv[32], gkv[32];
#pragma unroll
    for (int t = 0; t < 32; ++t) { const float* prow = proj + (size_t)(t0 + t) * NPROJ; gqv[t] = prow[PC_GQ + h * 64 + lane]; gkv[t] = prow[PC_GK + h * 64 + lane]; }
    unsigned vw[2][16];
#pragma unroll
    for (int vv = 0; vv < 2; ++vv) {
        const bf16_t* vp = (const bf16_t*)(p.ws + WS_QKV) + ((size_t)3 * NT + t0) * 512 + h * 128 + lane + 64 * vv;
#pragma unroll
        for (int t = 0; t < 32; t += 2) vw[vv][t >> 1] = (unsigned)vp[(size_t)t * 512] | ((unsigned)vp[(size_t)(t + 1) * 512] << 16);
    }
    float bcum[32];
    {
        const float* w2 = p.in[5] + (size_t)l * 16 * 256 + h * 64 + lane;
        const float gb = p.in[6][l * 256 + h * 64 + lane];
        float w2r[16];
#pragma unroll
        for (int i = 0; i < 16; ++i) w2r[i] = w2[i * 256];
        LAS float* grs = (LAS float*)(wl);
        { const float* gsrc = proj + (size_t)(t0 + (lane >> 1)) * NPROJ + PC_GR + (lane & 1) * 8;
          const f32x4 g0 = *(const f32x4*)gsrc, g1 = *(const f32x4*)(gsrc + 4);
          *(LAS f32x4*)(grs + lane * 8) = g0; *(LAS f32x4*)(grs + lane * 8 + 4) = g1; }
        float run = 0.f;
#pragma unroll
        for (int t = 0; t < 32; ++t) {
            f32x4 gr4[4];
#pragma unroll
            for (int i = 0; i < 4; ++i) gr4[i] = *(LAS f32x4*)(grs + t * 16 + 4 * i);
            float z = gb;
#pragma unroll
            for (int i = 0; i < 16; ++i) z += gr4[i >> 2][i & 3] * w2r[i];
            run += logsig(z) * (1.0f / 16.0f);
            bcum[t] = run;
        }
        asm volatile("" ::: "memory");
    }
    const float bl = bcum[31];
    unsigned kstp[16];
    {
        bf16_t* qtg = (bf16_t*)(p.wsl + SL_GQT) + (size_t)t0 * 256 + h * 64 + lane;
        float ksprev = 0.f;
#pragma unroll
        for (int t = 0; t < 32; ++t) {
            const float gq = gqv[t], gk = gkv[t];
            const float bv = bcum[t];
            const float qt = gq * 0.125f * __expf(bv), kt = gk * __expf(-bv), ks = gk * __expf(bl - bv);
            const bf16_t qb16 = f2bf(qt);
            Qs[t * 72 + lane] = qb16; Ks[t * 72 + lane] = f2bf(kt);
            qtg[(size_t)t * 256] = qb16;
            if (t & 1) kstp[t >> 1] = pk2(ksprev, ks); else ksprev = ks;
        }
        ((float*)(p.wsl + SL_GDEC))[ch * 64 + lane] = __expf(bl);
    }
    {
        bf16_t* ab = (bf16_t*)(p.wsl + SL_GA) + (size_t)ch * 1024;
#pragma unroll
        for (int tt = 0; tt < 2; ++tt)
#pragma unroll
            for (int st = 0; st < 2; ++st) {
                f32x4 acc = {0.f, 0.f, 0.f, 0.f};
#pragma unroll
                for (int ks = 0; ks < 2; ++ks) {
                    const bf16x8 a = *(LAS bf16x8*)(Qs + (16 * tt + r) * 72 + 32 * ks + 8 * q);
                    const bf16x8 bb = *(LAS bf16x8*)(Ks + (16 * st + r) * 72 + 32 * ks + 8 * q);
                    acc = mfma16(a, bb, acc);
                }
#pragma unroll
                for (int j = 0; j < 4; ++j) { const int t = 16 * tt + 4 * q + j, s = 16 * st + r; ab[t * 32 + s] = f2bf(s <= t ? acc[j] : 0.f); }
            }
    }
#pragma unroll
    for (int i = 0; i < 4; ++i) { u32x4 w; w.x = kstp[4 * i]; w.y = kstp[4 * i + 1]; w.z = kstp[4 * i + 2]; w.w = kstp[4 * i + 3]; *(LAS u32x4*)(KstT + lane * 40 + 8 * i) = w; }
#pragma unroll
    for (int vv = 0; vv < 2; ++vv) {
        const int v = lane + 64 * vv;
        bf16_t* vg = (bf16_t*)(p.ws + WS_GVT) + (size_t)ch * 4096 + v * 32;
#pragma unroll
        for (int i = 0; i < 4; ++i) { u32x4 w; w.x = vw[vv][4 * i]; w.y = vw[vv][4 * i + 1]; w.z = vw[vv][4 * i + 2]; w.w = vw[vv][4 * i + 3]; *(LAS u32x4*)(VT + v * 40 + 8 * i) = w; *(u32x4*)(vg + 8 * i) = w; }
    }
    {
        float* ub = (float*)(p.ws + WS_GU) + (size_t)ch * 8192;
        bf16x8 kb[4];
#pragma unroll
        for (int dt = 0; dt < 4; ++dt) kb[dt] = *(LAS bf16x8*)(KstT + (16 * dt + r) * 40 + 8 * q);
#pragma unroll
        for (int w = 0; w < 8; ++w) {
            const bf16x8 a = *(LAS bf16x8*)(VT + (16 * w + r) * 40 + 8 * q);
#pragma unroll
            for (int dt = 0; dt < 4; ++dt) {
                const f32x4 acc = mfma16(a, kb[dt], (f32x4){0.f, 0.f, 0.f, 0.f});
#pragma unroll
                for (int j = 0; j < 4; ++j) ub[(16 * w + 4 * q + j) * 64 + 16 * dt + r] = acc[j];
            }
        }
    }
}

__device__ __forceinline__ void lru_prep_witem(const Params& p, int l, int item, lds_t wl_in, int lane_in) {
    int lane = lane_in; asm volatile("" : "+v"(lane));
    unsigned wlo_ = 0; asm volatile("" : "+s"(wlo_)); lds_t wl = wl_in + wlo_;
    const float* proj = (const float*)(p.ws + WS_PROJ);
    const int gt = item >> 4, n = item & 15, tok0 = gt * 32, b = tok0 >> 11, p0 = tok0 & 2047, c0 = n * 64;
    LAS bf16_t* Xs = (LAS bf16_t*)(wl);
    LAS float* Xf = (LAS float*)(wl + 4608);
    const int r = lane & 15, q = lane >> 4;
    const bf16_t* gwt = (const bf16_t*)(p.wsl + SL_GWT);
    bf16x8 bav[4][2], biv[4][2]; float bbav[4], bbiv[4], lamv[4];
#pragma unroll
    for (int et = 0; et < 4; ++et) {
#pragma unroll
        for (int ks = 0; ks < 2; ++ks) { bav[et][ks] = *(const bf16x8*)(gwt + ((size_t)(0 * 16 + n) * 64 + 16 * et + r) * 64 + 32 * ks + 8 * q); biv[et][ks] = *(const bf16x8*)(gwt + ((size_t)(1 * 16 + n) * 64 + 16 * et + r) * 64 + 32 * ks + 8 * q); }
        const int c = c0 + 16 * et + r;
        bbav[et] = p.in[11][l * 1024 + c]; bbiv[et] = p.in[13][l * 1024 + c]; lamv[et] = p.in[14][l * 1024 + c];
    }
    {
        const int c = c0 + lane;
        const float* cw = p.in[8] + (size_t)l * 4 * 1024 + c;
        const float w0 = cw[0], w1 = cw[1024], w2 = cw[2048], w3 = cw[3072], cb = p.in[9][l * 1024 + c];
        const float* lxp = proj + (size_t)(b * SEQ) * NPROJ + PC_LX + c;
        float x0 = p0 >= 3 ? lxp[(size_t)(p0 - 3) * NPROJ] : 0.f, x1 = p0 >= 2 ? lxp[(size_t)(p0 - 2) * NPROJ] : 0.f, x2 = p0 >= 1 ? lxp[(size_t)(p0 - 1) * NPROJ] : 0.f;
        float xv[32];
#pragma unroll
        for (int i = 0; i < 32; ++i) xv[i] = lxp[(size_t)(p0 + i) * NPROJ];
#pragma unroll
        for (int i = 0; i < 32; ++i) {
            const float x3 = xv[i];
            const float y = cb + w0 * x0 + w1 * x1 + w2 * x2 + w3 * x3;
            Xf[i * 68 + lane] = y; Xs[i * 72 + lane] = f2bf(y);
            x0 = x1; x1 = x2; x2 = x3;
        }
    }
    bf16x8 af[2][2];
#pragma unroll
    for (int tt = 0; tt < 2; ++tt)
#pragma unroll
        for (int ks = 0; ks < 2; ++ks) af[tt][ks] = *(LAS bf16x8*)(Xs + (16 * tt + r) * 72 + 32 * ks + 8 * q);
    float* la = (float*)(p.ws + WS_LA); float* lu = (float*)(p.ws + WS_LU);
#pragma unroll
    for (int et = 0; et < 4; ++et) {
        bf16x8 ba[2], bi[2];
#pragma unroll
        for (int ks = 0; ks < 2; ++ks) { ba[ks] = bav[et][ks]; bi[ks] = biv[et][ks]; }
        const int e = 16 * et + r, c = c0 + e;
        const float bba = bbav[et], bbi = bbiv[et], lls = logsig(lamv[et]);
        float av[2][4], uv[2][4];
#pragma unroll
        for (int tt = 0; tt < 2; ++tt) {
            f32x4 pa = {0.f, 0.f, 0.f, 0.f}, pi = {0.f, 0.f, 0.f, 0.f};
#pragma unroll
            for (int ks = 0; ks < 2; ++ks) { pa = mfma16(af[tt][ks], ba[ks], pa); pi = mfma16(af[tt][ks], bi[ks], pi); }
#pragma unroll
            for (int j = 0; j < 4; ++j) {
                const int t = 16 * tt + 4 * q + j;
                const float rg = sigmoidf(pa[j] + bba), ig = sigmoidf(pi[j] + bbi);
                const float loga = 8.0f * rg * lls;
                const float a = __expf(loga);
                const float u = __builtin_amdgcn_sqrtf(fmaxf(neg_expm1_small(2.0f * loga), 0.f)) * (ig * Xf[t * 68 + e]);
                la[(size_t)(tok0 + t) * 1024 + c] = a; lu[(size_t)(tok0 + t) * 1024 + c] = u;
                av[tt][j] = a; uv[tt][j] = u;
            }
            asm volatile("" ::: "memory");
        }
        float P = 1.f, H = 0.f;
#pragma unroll
        for (int tt = 0; tt < 2; ++tt)
#pragma unroll
            for (int qq = 0; qq < 4; ++qq) {
                if (q == qq) {
#pragma unroll
                    for (int j = 0; j < 4; ++j) { H = av[tt][j] * H + uv[tt][j]; P *= av[tt][j]; }
                }
                P = __shfl(P, r + 16 * qq); H = __shfl(H, r + 16 * qq);
            }
        if (q == 0) { ((float*)(p.wsl + SL_AGP))[gt * 1024 + c] = P; ((float*)(p.wsl + SL_AGH))[gt * 1024 + c] = H; }
    }
}

__device__ __forceinline__ void fox_attn_unit(const Params& p, int bh, int qb, lds_t lds, int tid, int wave, int lane) {
    const float* proj = (const float*)(p.ws + WS_PROJ);
    const float* cb = (const float*)(p.wsl + SL_CBUF) + bh * SEQ;
    const int b = bh >> 3, h = bh & 7;
    LAS bf16_t* Ks = (LAS bf16_t*)(lds);
    LAS bf16_t* Vt = (LAS bf16_t*)(lds + 9216);
    LAS float* cks = (LAS float*)(lds + 18432);
    const int r = lane & 15, q = lane >> 4;
    const int q0 = qb * 128, qw0 = q0 + 16 * wave, nkv = 2 * (qb + 1);
    const float C2 = 0.125f * LOG2E;
    bf16x8 qf[2];
    {
        const bf16_t* qp = (const bf16_t*)(p.ws + WS_QKV) + (size_t)(b * SEQ + qw0 + r) * 512 + h * 64 + 8 * q;
#pragma unroll
        for (int ks = 0; ks < 2; ++ks) qf[ks] = *(const bf16x8*)(qp + 32 * ks);
    }
    const float cq = cb[qw0 + r];
    float m = -1e30f, lsum = 0.f;
    f32x4 o[4];
#pragma unroll
    for (int i = 0; i < 4; ++i) o[i] = (f32x4){0.f, 0.f, 0.f, 0.f};
    const int lrow = tid >> 3, lch = (tid & 7) * 8;
    const bf16_t* kbase = (const bf16_t*)(p.ws + WS_QKV) + ((size_t)NT + b * SEQ + lrow) * 512 + h * 64 + lch;
    const int vrow = tid & 63, vch = (tid >> 6) * 8;
    const bf16_t* vbase = (const bf16_t*)(p.ws + WS_QKV) + ((size_t)2 * NT + b * SEQ + vrow) * 512 + h * 64 + vch;
    bf16x8 kA = *(const bf16x8*)kbase, vA = *(const bf16x8*)vbase;
    float ckA = tid < 64 ? cb[tid] : 0.f;
    bf16x8 kB = *(const bf16x8*)(kbase + (size_t)64 * 512), vB = *(const bf16x8*)(vbase + (size_t)64 * 512);
    float ckB = tid < 64 ? cb[64 + tid] : 0.f;
    constexpr int FOXBUF = 18432 + 256;
#define FOX_WRITE(KK, VV, CK, bufi, jn) { \
        LAS bf16_t* KsW = (LAS bf16_t*)(lds + (bufi) * FOXBUF); LAS bf16_t* VtW = (LAS bf16_t*)(lds + (bufi) * FOXBUF + 9216); LAS float* cksW = (LAS float*)(lds + (bufi) * FOXBUF + 18432); \
        *(LAS bf16x8*)(KsW + lrow * 72 + lch) = KK; \
        _Pragma("unroll") for (int i = 0; i < 8; ++i) VtW[(vch + i) * 72 + vrow] = (bf16_t)VV[i]; \
        if (tid < 64) cksW[tid] = CK; \
        if ((jn) < nkv) { const size_t off = (size_t)(jn) * 64 * 512; \
            KK = *(const bf16x8*)(kbase + off); VV = *(const bf16x8*)(vbase + off); \
            if (tid < 64) CK = cb[(jn) * 64 + tid]; } }
    __syncthreads();
    FOX_WRITE(kA, vA, ckA, 0, 2)
    asm volatile("s_waitcnt lgkmcnt(0)\n\ts_barrier" ::: "memory");
    for (int j0 = 0; j0 < nkv; j0 += 2) {
        { const int j = j0;
          FOX_WRITE(kB, vB, ckB, 1, j + 3)
          LAS bf16_t* KsX = (LAS bf16_t*)(lds); LAS bf16_t* VtX = (LAS bf16_t*)(lds + 9216); LAS float* cksX = (LAS float*)(lds + 18432);
        if (64 * j <= qw0 + 15) {
            f32x4 s[4]; float mx = -INFINITY;
            bf16x8 kfr[4][2]; f32x4 ckr[4]; s16x4 vlo[4][2], vhi[4][2];
#pragma unroll
            for (int st = 0; st < 4; ++st) {
#pragma unroll
                for (int ks = 0; ks < 2; ++ks) kfr[st][ks] = *(LAS bf16x8*)(KsX + (16 * st + r) * 72 + 32 * ks + 8 * q);
                ckr[st] = *(LAS f32x4*)(cksX + 16 * st + 4 * q);
            }
#pragma unroll
            for (int ds = 0; ds < 4; ++ds)
#pragma unroll
                for (int ks = 0; ks < 2; ++ks) { vlo[ds][ks] = *(LAS s16x4*)(VtX + (16 * ds + r) * 72 + 32 * ks + 4 * q); vhi[ds][ks] = *(LAS s16x4*)(VtX + (16 * ds + r) * 72 + 32 * ks + 16 + 4 * q); }
#pragma unroll
            for (int st = 0; st < 4; ++st) {
                f32x4 acc = {0.f, 0.f, 0.f, 0.f};
#pragma unroll
                for (int ks = 0; ks < 2; ++ks) acc = mfma16(kfr[st][ks], qf[ks], acc);
                const f32x4 ck = ckr[st];
#pragma unroll
                for (int jj = 0; jj < 4; ++jj) {
                    const int kv = 64 * j + 16 * st + 4 * q + jj;
                    float sv = acc[jj] + (cq - ck[jj]);
                    if (64 * j + 63 > qw0) sv = (kv <= qw0 + r) ? sv : -INFINITY;
                    s[st][jj] = sv; mx = fmaxf(mx, sv);
                }
            }
            mx = fmaxf(mx, __shfl_xor(mx, 16)); mx = fmaxf(mx, __shfl_xor(mx, 32));
            const float mnew = fmaxf(m, mx);
            const float alpha = __builtin_amdgcn_exp2f(m - mnew);
            m = mnew;
            float ps = 0.f;
#pragma unroll
            for (int st = 0; st < 4; ++st)
#pragma unroll
                for (int jj = 0; jj < 4; ++jj) { const float e = __builtin_amdgcn_exp2f(s[st][jj] - mnew); s[st][jj] = e; ps += e; }
            lsum = lsum * alpha + ps;
#pragma unroll
            for (int i = 0; i < 4; ++i) o[i] = o[i] * alpha;
            bf16x8 pf[2];
            pf[0] = pack8(s[0], s[1]); pf[1] = pack8(s[2], s[3]);
#pragma unroll
            for (int ds = 0; ds < 4; ++ds)
#pragma unroll
                for (int ks = 0; ks < 2; ++ks) {
                    const s16x4 lo = vlo[ds][ks], hi = vhi[ds][ks];
                    const bf16x8 a = {lo[0], lo[1], lo[2], lo[3], hi[0], hi[1], hi[2], hi[3]};
                    o[ds] = mfma16(a, pf[ks], o[ds]);
                }
        }
          asm volatile("s_waitcnt lgkmcnt(0)\n\ts_barrier" ::: "memory");
        }
        { const int j = j0 + 1;
          if (j + 1 < nkv) FOX_WRITE(kA, vA, ckA, 0, j + 3)
          LAS bf16_t* KsX = (LAS bf16_t*)(lds + FOXBUF); LAS bf16_t* VtX = (LAS bf16_t*)(lds + FOXBUF + 9216); LAS float* cksX = (LAS float*)(lds + FOXBUF + 18432);
        if (64 * j <= qw0 + 15) {
            f32x4 s[4]; float mx = -INFINITY;
            bf16x8 kfr[4][2]; f32x4 ckr[4]; s16x4 vlo[4][2], vhi[4][2];
#pragma unroll
            for (int st = 0; st < 4; ++st) {
#pragma unroll
                for (int ks = 0; ks < 2; ++ks) kfr[st][ks] = *(LAS bf16x8*)(KsX + (16 * st + r) * 72 + 32 * ks + 8 * q);
                ckr[st] = *(LAS f32x4*)(cksX + 16 * st + 4 * q);
            }
#pragma unroll
            for (int ds = 0; ds < 4; ++ds)
#pragma unroll
                for (int ks = 0; ks < 2; ++ks) { vlo[ds][ks] = *(LAS s16x4*)(VtX + (16 * ds + r) * 72 + 32 * ks + 4 * q); vhi[ds][ks] = *(LAS s16x4*)(VtX + (16 * ds + r) * 72 + 32 * ks + 16 + 4 * q); }
#pragma unroll
            for (int st = 0; st < 4; ++st) {
                f32x4 acc = {0.f, 0.f, 0.f, 0.f};
#pragma unroll
                for (int ks = 0; ks < 2; ++ks) acc = mfma16(kfr[st][ks], qf[ks], acc);
                const f32x4 ck = ckr[st];
#pragma unroll
                for (int jj = 0; jj < 4; ++jj) {
                    const int kv = 64 * j + 16 * st + 4 * q + jj;
                    float sv = acc[jj] + (cq - ck[jj]);
                    if (64 * j + 63 > qw0) sv = (kv <= qw0 + r) ? sv : -INFINITY;
                    s[st][jj] = sv; mx = fmaxf(mx, sv);
                }
            }
            mx = fmaxf(mx, __shfl_xor(mx, 16)); mx = fmaxf(mx, __shfl_xor(mx, 32));
            const float mnew = fmaxf(m, mx);
            const float alpha = __builtin_amdgcn_exp2f(m - mnew);
            m = mnew;
            float ps = 0.f;
#pragma unroll
            for (int st = 0; st < 4; ++st)
#pragma unroll
                for (int jj = 0; jj < 4; ++jj) { const float e = __builtin_amdgcn_exp2f(s[st][jj] - mnew); s[st][jj] = e; ps += e; }
            lsum = lsum * alpha + ps;
#pragma unroll
            for (int i = 0; i < 4; ++i) o[i] = o[i] * alpha;
            bf16x8 pf[2];
            pf[0] = pack8(s[0], s[1]); pf[1] = pack8(s[2], s[3]);
#pragma unroll
            for (int ds = 0; ds < 4; ++ds)
#pragma unroll
                for (int ks = 0; ks < 2; ++ks) {
                    const s16x4 lo = vlo[ds][ks], hi = vhi[ds][ks];
                    const bf16x8 a = {lo[0], lo[1], lo[2], lo[3], hi[0], hi[1], hi[2], hi[3]};
                    o[ds] = mfma16(a, pf[ks], o[ds]);
                }
        }
          asm volatile("s_waitcnt lgkmcnt(0)\n\ts_barrier" ::: "memory");
        }
    }
#undef FOX_WRITE
    lsum += __shfl_xor(lsum, 16); lsum += __shfl_xor(lsum, 32);
    const float inv = 1.0f / lsum;
    bf16_t* op = (bf16_t*)(p.ws + WS_FOXO) + (size_t)(b * SEQ + qw0 + r) * 512 + h * 64 + 4 * q;
#pragma unroll
    for (int ds = 0; ds < 4; ++ds) { u32x2 w; w.x = pk2(o[ds][0] * inv, o[ds][1] * inv); w.y = pk2(o[ds][2] * inv, o[ds][3] * inv); *(u32x2*)(op + 16 * ds) = w; }
}

__device__ __forceinline__ void gla_scan_item(const Params& p, int item, int tid) {
    const int bh = item >> 4, e = (item & 15) * 512 + tid, d = e & 63;
    const float* ub = (const float*)(p.ws + WS_GU) + (size_t)bh * 64 * 8192 + e;
    const float* dec = (const float*)(p.wsl + SL_GDEC) + (size_t)bh * 64 * 64 + d;
    bf16_t* sp = (bf16_t*)(p.ws + WS_GS) + (size_t)bh * 64 * 8192 + e;
    float st = 0.f;
#pragma unroll
    for (int n0 = 0; n0 < 64; n0 += 64) {
        float u[64], dc[64];
#pragma unroll
        for (int n = 0; n < 64; ++n) { u[n] = ub[(size_t)(n0 + n) * 8192]; dc[n] = dec[(n0 + n) * 64]; }
#pragma unroll
        for (int n = 0; n < 64; ++n) { sp[(size_t)(n0 + n) * 8192] = f2bf(st); st = dc[n] * st + u[n]; }
    }
}

__device__ __forceinline__ void lru_tilescan_item(const Params& p, int item, int tid) {
    const int gid = item * 512 + tid, b = gid >> 10, c = gid & 1023;
    const float* P = (const float*)(p.wsl + SL_AGP) + (size_t)b * 64 * 1024 + c;
    const float* H = (const float*)(p.wsl + SL_AGH) + (size_t)b * 64 * 1024 + c;
    float* hi = (float*)(p.wsl + SL_HIN) + (size_t)b * 64 * 1024 + c;
    float h = 0.f;
#pragma unroll
    for (int t0 = 0; t0 < 64; t0 += 64) {
        float a[64], u[64];
#pragma unroll
        for (int t = 0; t < 64; ++t) { a[t] = P[(t0 + t) * 1024]; u[t] = H[(t0 + t) * 1024]; }
#pragma unroll
        for (int t = 0; t < 64; ++t) { hi[(t0 + t) * 1024] = h; h = a[t] * h + u[t]; }
    }
}

__device__ __forceinline__ void fox_norm_rows4(const Params& p, int l, int tok0, int stride, int lane) {
    u32x4 w[4];
#pragma unroll
    for (int k = 0; k < 4; ++k) w[k] = *(const u32x4*)((const bf16_t*)(p.ws + WS_FOXO) + (size_t)(tok0 + k * stride) * 512 + lane * 8);
    const float* g = p.in[4] + l * 512 + lane * 8;
    const f32x4 g0 = *(const f32x4*)g, g1 = *(const f32x4*)(g + 4);
#pragma unroll
    for (int k = 0; k < 4; ++k) {
        float v[8];
#pragma unroll
        for (int i = 0; i < 4; ++i) { v[2 * i] = bf2f(w[k][i] & 0xffffu); v[2 * i + 1] = bf2f(w[k][i] >> 16); }
        float s = 0.f;
#pragma unroll
        for (int i = 0; i < 8; ++i) s += v[i] * v[i];
        const float rstd = rsqrtf(wave_sum(s) * (1.0f / 512.0f) + EPS);
        u32x4 ow; ow.x = pk2(v[0] * rstd * g0[0], v[1] * rstd * g0[1]); ow.y = pk2(v[2] * rstd * g0[2], v[3] * rstd * g0[3]);
        ow.z = pk2(v[4] * rstd * g1[0], v[5] * rstd * g1[1]); ow.w = pk2(v[6] * rstd * g1[2], v[7] * rstd * g1[3]);
        *(u32x4*)((bf16_t*)(p.ws + WS_MIX) + (size_t)(tok0 + k * stride) * 2048 + lane * 8) = ow;
    }
}

__device__ __forceinline__ void gla_out_witem(const Params& p, int l, int item, int lane) {
    const float* proj = (const float*)(p.ws + WS_PROJ);
    const int ch = item >> 1, tt = item & 1;
    const int bh = ch >> 6, n = ch & 63, b = bh >> 2, h = bh & 3;
    const int t0 = b * SEQ + n * 32;
    const int r = lane & 15, q = lane >> 4;
    const bf16_t* ab = (const bf16_t*)(p.wsl + SL_GA) + (size_t)ch * 1024;
    const bf16_t* vt = (const bf16_t*)(p.ws + WS_GVT) + (size_t)ch * 4096;
    const bf16_t* qt = (const bf16_t*)(p.wsl + SL_GQT) + (size_t)t0 * 256 + h * 64;
    const bf16_t* sp = (const bf16_t*)(p.ws + WS_GS) + (size_t)ch * 8192;
    const bf16x8 aa = *(const bf16x8*)(ab + (16 * tt + r) * 32 + 8 * q);
    const bf16x8 aq0 = *(const bf16x8*)(qt + (size_t)(16 * tt + r) * 256 + 8 * q), aq1 = *(const bf16x8*)(qt + (size_t)(16 * tt + r) * 256 + 32 + 8 * q);
    float ggv[4][8], gnv[8];
#pragma unroll
    for (int w = 0; w < 8; ++w) gnv[w] = p.in[7][l * 128 + 16 * w + r];
#pragma unroll
    for (int j = 0; j < 4; ++j)
#pragma unroll
        for (int w = 0; w < 8; ++w) ggv[j][w] = proj[(size_t)(t0 + 16 * tt + 4 * q + j) * NPROJ + PC_GG + h * 128 + r + 16 * w];
    f32x4 acc[8];
#pragma unroll
    for (int w = 0; w < 8; ++w) {
        const int v = 16 * w + r;
        const bf16x8 bv = *(const bf16x8*)(vt + v * 32 + 8 * q);
        const bf16x8 bs0 = *(const bf16x8*)(sp + v * 64 + 8 * q), bs1 = *(const bf16x8*)(sp + v * 64 + 32 + 8 * q);
        f32x4 c = mfma16(aa, bv, (f32x4){0.f, 0.f, 0.f, 0.f});
        c = mfma16(aq0, bs0, c); c = mfma16(aq1, bs1, c);
        acc[w] = c;
    }
    float tot[4] = {0.f, 0.f, 0.f, 0.f};
#pragma unroll
    for (int w = 0; w < 8; ++w)
#pragma unroll
        for (int j = 0; j < 4; ++j) {
            float s = acc[w][j] * acc[w][j];
            s += __shfl_xor(s, 1); s += __shfl_xor(s, 2); s += __shfl_xor(s, 4); s += __shfl_xor(s, 8);
            tot[j] += s;
        }
#pragma unroll
    for (int j = 0; j < 4; ++j) {
        const int t = 16 * tt + 4 * q + j;
        const float rstd = rsqrtf(tot[j] * (1.0f / 128.0f) + EPS);
        bf16_t* mp = (bf16_t*)(p.ws + WS_MIX) + (size_t)(t0 + t) * 2048 + 512 + h * 128 + r;
#pragma unroll
        for (int w = 0; w < 8; ++w) {
            const float gn = gnv[w];
            const float gg = ggv[j][w];
            const float y = acc[w][j] * rstd * gn * (gg * sigmoidf(gg));
            mp[16 * w] = f2bf(y);
        }
    }
}

__device__ __forceinline__ float gelu_tanh(float x) {
    const float u = 0.7978845608028654f * (x + 0.044715f * x * x * x);
    const float t = 1.0f - 2.0f * __builtin_amdgcn_rcpf(1.0f + __expf(2.0f * u));
    return 0.5f * x * (1.0f + t);
}

__device__ __forceinline__ void lru_out_item(const Params& p, int l, int gt, lds_t lds, int tid, int wave, int lane) {
    const float* proj = (const float*)(p.ws + WS_PROJ);
    const int tok0 = gt * 32, c = 2 * tid;
    LAS float* part = (LAS float*)(lds);
    LAS float* rs = (LAS float*)(lds + 65536);
    const f32x2* la = (const f32x2*)((const float*)(p.ws + WS_LA) + (size_t)tok0 * 1024 + c);
    const f32x2* lu = (const f32x2*)((const float*)(p.ws + WS_LU) + (size_t)tok0 * 1024 + c);
    const float* lgp = proj + (size_t)tok0 * NPROJ + PC_LG + c;
    f32x2 h = *(const f32x2*)((const float*)(p.wsl + SL_HIN) + (size_t)gt * 1024 + c);
    f32x2 y[32];
    {
        f32x2 av[32], uv[32];
#pragma unroll
        for (int t = 0; t < 32; ++t) y[t] = *(const f32x2*)(lgp + (size_t)t * NPROJ);
#pragma unroll
        for (int t = 0; t < 32; ++t) { av[t] = la[t * 512]; uv[t] = lu[t * 512]; }
#pragma unroll
        for (int t = 0; t < 32; ++t) { y[t][0] = gelu_tanh(y[t][0]); y[t][1] = gelu_tanh(y[t][1]); }
#pragma unroll
        for (int t = 0; t < 32; ++t) {
            h = av[t] * h + uv[t];
            y[t][0] = h[0] * y[t][0]; y[t][1] = h[1] * y[t][1];
            part[t * 512 + tid] = y[t][0] * y[t][0] + y[t][1] * y[t][1];
        }
    }
    __syncthreads();
    {
        const int t = tid >> 4, k0 = tid & 15;
        float s = 0.f;
#pragma unroll 8
        for (int k = 0; k < 32; ++k) s += part[t * 512 + k0 + 16 * k];
        s += __shfl_xor(s, 1); s += __shfl_xor(s, 2); s += __shfl_xor(s, 4); s += __shfl_xor(s, 8);
        if (k0 == 0) rs[t] = rsqrtf(s * (1.0f / 1024.0f) + EPS);
    }
    __syncthreads();
    const f32x2 g = *(const f32x2*)(p.in[15] + l * 1024 + c);
    bf16_t* mix = (bf16_t*)(p.ws + WS_MIX) + (size_t)tok0 * 2048 + 1024 + c;
#pragma unroll
    for (int t = 0; t < 32; ++t) { const float rr = rs[t]; *(unsigned*)(mix + (size_t)t * 2048) = pk2(y[t][0] * rr * g[0], y[t][1] * rr * g[1]); }
    __syncthreads();
}

#define XB_TMO      128
#define XB_XCNT(j)  (256  + 64 * (j))
#define XB_XSUB(j)  (1280 + 64 * (j))
#define XB_XGEN(j)  (2304 + 64 * (j))
#define XB_TOP      3328
#define XB_TOPGEN   3392
#define XCD_BAR_WORDS 3456
#define XB_SPIN_CAP (1u << 18)

__device__ __forceinline__ unsigned xb_ld(unsigned* p)              { return __hip_atomic_load(p, __ATOMIC_RELAXED, __HIP_MEMORY_SCOPE_AGENT); }
__device__ __forceinline__ unsigned xb_add(unsigned* p, unsigned v) { return __hip_atomic_fetch_add(p, v, __ATOMIC_RELAXED, __HIP_MEMORY_SCOPE_AGENT); }
__device__ __forceinline__ unsigned xb_xcc_id() { return (unsigned)__builtin_amdgcn_s_getreg((3 << 11) | 20) & 0xFu; }
#define XB_SPIN(cond, bar) do { unsigned _sp = 0; while (cond) { __builtin_amdgcn_s_sleep(1); \
    if ((++_sp & 255u) == 0u) { if (xb_ld(&(bar)[XB_TMO])) break; if (_sp > XB_SPIN_CAP) { atomicAdd(&(bar)[XB_TMO], 1u); break; } } } } while (0)

struct XcdBarrier {
    unsigned* bar; unsigned x;
    volatile LAS unsigned* st;
};

__device__ __forceinline__ XcdBarrier xcd_barrier_post(unsigned* bar, volatile LAS unsigned* st) {
    XcdBarrier b; b.bar = bar; b.x = xb_xcc_id(); b.st = st;
    if (threadIdx.x == 0) (void)xb_add(&bar[XB_XCNT(b.x)], 1u);
    return b;
}
__device__ __forceinline__ void xcd_barrier_complete(unsigned* bar, unsigned x, unsigned& nloc, unsigned& nx) {
    const unsigned G = gridDim.x * gridDim.y * gridDim.z;
    unsigned sum, cnt, mine, sp = 0u;
    for (;;) {
        sum = 0u; cnt = 0u; mine = 0u;
#pragma unroll
        for (unsigned j = 0; j < 16; ++j) { const unsigned c = xb_ld(&bar[XB_XCNT(j)]); sum += c; cnt += (c > 0u) ? 1u : 0u; mine = (j == x) ? c : mine; }
        if (sum == G) break;
        __builtin_amdgcn_s_sleep(1);
        if ((++sp & 255u) == 0u) { if (xb_ld(&bar[XB_TMO])) break; if (sp > XB_SPIN_CAP) { atomicAdd(&bar[XB_TMO], 1u); break; } }
    }
    nloc = mine > 0u ? mine : 1u; nx = cnt > 0u ? cnt : 1u;
}

__device__ __forceinline__ void xcd_barrier(const XcdBarrier& b) {
    asm volatile("s_waitcnt vmcnt(0)" ::: "memory");
    __syncthreads();
    if (threadIdx.x == 0) {
        unsigned* bar = b.bar;
        __builtin_amdgcn_s_waitcnt(0);
        unsigned nloc = b.st[0], nx = b.st[1];
        if (nloc == 0u) { xcd_barrier_complete(bar, b.x, nloc, nx); b.st[0] = nloc; b.st[1] = nx; }
        const unsigned old = xb_add(&bar[XB_XSUB(b.x)], 1u);
        const unsigned gen = old / nloc;
        if (old + 1u == (gen + 1u) * nloc) {
            __builtin_amdgcn_fence(__ATOMIC_RELEASE, "agent");
            asm volatile("s_waitcnt vmcnt(0)" ::: "memory");
            const unsigned og = xb_add(&bar[XB_TOP], 1u);
            const unsigned tg = og / nx;
            if (og + 1u == (tg + 1u) * nx) xb_add(&bar[XB_TOPGEN], 1u);
            else XB_SPIN(xb_ld(&bar[XB_TOPGEN]) == tg, bar);
            __builtin_amdgcn_fence(__ATOMIC_ACQUIRE, "agent");
            xb_add(&bar[XB_XGEN(b.x)], 1u);
            asm volatile("s_waitcnt vmcnt(0)" ::: "memory");
        } else {
            XB_SPIN(xb_ld(&bar[XB_XGEN(b.x)]) == gen, bar);
            __builtin_amdgcn_fence(__ATOMIC_ACQUIRE, "agent");
            asm volatile("s_waitcnt vmcnt(0)" ::: "memory");
        }
    }
    __syncthreads();
}

__global__ void __launch_bounds__(512, 2) hymba_fwd(Params p0) {
    extern __shared__ __attribute__((aligned(16))) unsigned char lds_raw[];
    cg::grid_group grid = cg::this_grid();
    const int G = gridDim.x, bid = blockIdx.x, ngw = G * 8;
    volatile LAS unsigned* bst = (volatile LAS unsigned*)((lds_t)lds_raw + (LDS_BYTES - 64));
    if (threadIdx.x < 16) bst[threadIdx.x] = 0u;
    __syncthreads();
    const XcdBarrier bar = xcd_barrier_post((unsigned*)(p0.ws + WS_CTL), bst);
#define PHASE_BEGIN \
    int tid = threadIdx.x; asm volatile("" : "+v"(tid)); \
    const int lane = tid & 63, wave = __builtin_amdgcn_readfirstlane(tid >> 6); \
    unsigned lo_ = 0; asm volatile("" : "+s"(lo_)); lds_t lds = (lds_t)lds_raw + lo_; \
    Params p = p0; asm volatile("" : "+s"(p.ws)); p.wsl = p.ws + WS_SMALL + (size_t)lcur * SMALL_BYTES; \
    GAS unsigned char* ws = p.ws; const int gw = bid * 8 + wave; (void)gw; (void)lane; (void)lds; (void)ws;

#pragma clang loop unroll(disable)
    for (int l = 0; l < DEPTH; ++l) {
        const int lcur = l;
        if (l == 0) {
            {
                PHASE_BEGIN
                phase_wconv(p, 0, 1, gw, ngw, lane);
                for (int m = gw; m < NT; m += ngw) prep_row(p.in[0] + (size_t)m * DM, (bf16_t*)(ws + WS_HB) + (size_t)m * DM, (float*)(ws + WS_SS1), m, lane, p.in[1]);
            }
            if (p0.ws == nullptr) grid.sync();
            xcd_barrier(bar);
        }
        {
            PHASE_BEGIN
            pg8::Gemm g{(const bf16_t*)(ws + WS_HB), (const bf16_t*)(ws + WS_WIN), NT, NPROJ, DM}; pg8::StaticOrder S; S.init(NT, NPROJ, G, bid);
            gate_wt_prep(p, l, bid * 512 + tid);
            pg8::rstd_table((LAS float*)(lds + 131072), (const float*)(ws + WS_SS1 + (size_t)l * MiB), S, tid);
            pg8::EpiStoreF32 E{(float*)(ws + WS_PROJ), NPROJ, (const LAS float*)(lds + 131072), 0, (bf16_t*)(ws + WS_QKV)};
            pg8::gemm_phase<pg8::EpiStoreF32, pg8::StaticOrder, true, true>(lds, g, S, E, tid);
            { const int nfull = (NT / 256) * (NPROJ / 256) % G; if (nfull > 0 && bid >= nfull) phase_wconv(p, l, 2 | 4, (bid - nfull) * 8 + wave, (G - nfull) * 8, lane); else if (nfull == 0) phase_wconv(p, l, 2 | 4, gw, ngw, lane); }
        }
        xcd_barrier(bar);
        {
            PHASE_BEGIN
            if (G >= 32 ? (wave == 7 && bid < 32) : (gw < 32)) fox_cumsum(p, l, G >= 32 ? bid : gw, lane);
            {
                lds_t wl = lds + wave * 18432;
                if (G == 256) {
                    if (wave < 4) { gla_prep_witem(p, l, bid * 4 + wave, wl, lane); lru_prep_witem(p, l, bid * 16 + wave, wl, lane); }
                    else for (int k = 0; k < 3; ++k) lru_prep_witem(p, l, bid * 16 + 4 + (wave - 4) * 3 + k, wl, lane);
                } else
                for (int it = gw; it < 1024 + 4096; it += ngw) {
                    if (it < 1024) gla_prep_witem(p, l, it, wl, lane);
                    else lru_prep_witem(p, l, it - 1024, wl, lane);
                }
            }
        }
        xcd_barrier(bar);
        {
            PHASE_BEGIN
            for (int it = bid; it < 256; it += G) {
                const int bh = it >> 3, s = it & 7;
                fox_attn_unit(p, bh, 15 - s, lds, tid, wave, lane);
                fox_attn_unit(p, bh, s, lds, tid, wave, lane);
            }
            for (int it = bid; it < 256; it += G) gla_scan_item(p, it, tid);
            for (int it = G - 1 - bid; it < 8; it += G) lru_tilescan_item(p, it, tid);
        }
        xcd_barrier(bar);
        {
            PHASE_BEGIN
            for (int it = bid; it < 256; it += G) lru_out_item(p, l, it, lds, tid, wave, lane);
            for (int it = gw; it < 2048; it += ngw) gla_out_witem(p, l, it, lane);
            if (NT % (4 * ngw) == 0) { for (int tok = gw; tok < NT; tok += 4 * ngw) fox_norm_rows4(p, l, tok, ngw, lane); }
            else for (int tok = gw; tok < NT; tok += ngw) fox_norm_rows4(p, l, tok, 0, lane);
        }
        xcd_barrier(bar);
        {
            PHASE_BEGIN
            const float* xin = (l == 0) ? p.in[0] : (const float*)(ws + WS_XW);
            pg8::Gemm g{(const bf16_t*)(ws + WS_MIX), (const bf16_t*)(ws + WS_WOUT), NT, DM, DM}; pg8::StaticOrder S; S.init(NT, DM, G, bid);
            pg8::EpiResid E{xin, (float*)(ws + WS_XW), (bf16_t*)(ws + WS_HB), (float*)(ws + WS_SS2 + (size_t)l * MiB), p.in[17] + l * DM, DM};
            pg8::gemm_phase<pg8::EpiResid, pg8::StaticOrder, true, true>(lds, g, S, E, tid);
        }
        xcd_barrier(bar);
        {
            PHASE_BEGIN
            pg8::Gemm g{(const bf16_t*)(ws + WS_HB), (const bf16_t*)(ws + WS_WGU), NT, 2 * FFH, DM}; pg8::StaticOrder S; S.init(NT, 2 * FFH, G, bid);
            pg8::rstd_table((LAS float*)(lds + 131072), (const float*)(ws + WS_SS2 + (size_t)l * MiB), S, tid);
            pg8::EpiSwiglu E{(bf16_t*)(ws + WS_PROJ), FFH, (const LAS float*)(lds + 131072), 0};
            pg8::gemm_phase<pg8::EpiSwiglu, pg8::StaticOrder, true, true>(lds, g, S, E, tid);
            { const int nfull = (NT / 256) * (2 * FFH / 256) % G; const int msk = 8 | (l + 1 < DEPTH ? 1 : 0); const int ln = (l + 1 < DEPTH) ? l + 1 : l;
              if (nfull > 0 && bid >= nfull) { phase_wconv(p, l, 8, (bid - nfull) * 8 + wave, (G - nfull) * 8, lane); if (msk & 1) phase_wconv(p, ln, 1, (bid - nfull) * 8 + wave, (G - nfull) * 8, lane); }
              else if (nfull == 0) { phase_wconv(p, l, 8, gw, ngw, lane); if (msk & 1) phase_wconv(p, ln, 1, gw, ngw, lane); } }
        }
        xcd_barrier(bar);
        {
            PHASE_BEGIN
            pg8::Gemm g{(const bf16_t*)(ws + WS_PROJ), (const bf16_t*)(ws + WS_WDN), NT, DM, FFH}; pg8::StaticOrder S; S.init(NT, DM, G, bid);
            pg8::EpiResid E{(const float*)(ws + WS_XW), (float*)(ws + WS_XW), (l < DEPTH - 1) ? (bf16_t*)(ws + WS_HB) : (bf16_t*)nullptr, (float*)(ws + WS_SS1 + (size_t)(l + 1) * MiB), p.in[1] + (l < DEPTH - 1 ? l + 1 : 0) * DM, DM};
            pg8::gemm_phase<pg8::EpiResid, pg8::StaticOrder, true, true>(lds, g, S, E, tid);
        }
        xcd_barrier(bar);
    }
    {
        const int lcur = 0;
        PHASE_BEGIN
        if (NT % (4 * ngw) == 0) {
            const f32x4* gr = (const f32x4*)p.in[21] + lane;
            const float* ssb = (const float*)(ws + WS_SS1 + (size_t)DEPTH * MiB);
            for (int m0 = gw; m0 < NT; m0 += 4 * ngw) {
                f32x4 xv[4][8]; float pv[4];
#pragma unroll
                for (int k = 0; k < 4; ++k) {
                    const int m = m0 + k * ngw;
                    pv[k] = lane < 32 ? ssb[((size_t)(lane >> 2) * 8192 + m) * 4 + (lane & 3)] : 0.f;
                    const f32x4* xr = (const f32x4*)((const float*)(ws + WS_XW) + (size_t)m * DM) + lane;
#pragma unroll
                    for (int j = 0; j < 8; ++j) xv[k][j] = xr[64 * j];
                }
                f32x4 gv[8];
#pragma unroll
                for (int j = 0; j < 8; ++j) gv[j] = gr[64 * j];
#pragma unroll
                for (int k = 0; k < 4; ++k) {
                    const int m = m0 + k * ngw;
                    const float rstd = rsqrtf(wave_sum(pv[k]) * (1.0f / 2048.0f) + EPS);
                    f32x4* orow = (f32x4*)(p.out + (size_t)m * DM) + lane;
#pragma unroll
                    for (int j = 0; j < 8; ++j) orow[64 * j] = xv[k][j] * rstd * gv[j];
                }
            }
        } else
        for (int m = gw; m < NT; m += ngw) { const float sv = wave_sum(lane < 32 ? ((const float*)(ws + WS_SS1 + (size_t)DEPTH * MiB))[((size_t)(lane >> 2) * 8192 + m) * 4 + (lane & 3)] : 0.f);
            final_row((const float*)(ws + WS_XW) + (size_t)m * DM, p.in[21], p.out + (size_t)m * DM, sv, lane); }
    }
}

extern "C" void kernel_launch(void* const* d_in, const int* in_sizes, int n_in, void* d_out, int out_size, void* d_ws, size_t ws_size, hipStream_t stream) {
    static int grid_blocks = 0;
    if (grid_blocks == 0) {
        if (n_in != 22 || ws_size < WS_END) { fprintf(stderr, "kernel_launch: unexpected n_in %d / ws_size %zu\n", n_in, ws_size); grid_blocks = -1; return; }
        int dev = 0, cus = 0, per_cu = 0;
        hipGetDevice(&dev);
        hipDeviceGetAttribute(&cus, hipDeviceAttributeMultiprocessorCount, dev);
        hipFuncSetAttribute((const void*)hymba_fwd, hipFuncAttributeMaxDynamicSharedMemorySize, LDS_BYTES);
        hipOccupancyMaxActiveBlocksPerMultiprocessor(&per_cu, (const void*)hymba_fwd, 512, LDS_BYTES);
        if (per_cu < 1) { fprintf(stderr, "kernel_launch: occupancy query says %d blocks per CU\n", per_cu); per_cu = 1; }
        (void)hipGetLastError();
        grid_blocks = cus * 1;
    }
    if (grid_blocks < 0) return;
    Params p{};
    for (int i = 0; i < 22; ++i) p.in[i] = (const float*)d_in[i];
    p.out = (float*)d_out; p.ws = (GAS unsigned char*)d_ws;
    if (hipMemsetAsync((unsigned char*)d_ws + WS_CTL, 0, CTL_BYTES, stream) != hipSuccess) { fprintf(stderr, "kernel_launch: memset failed\n"); return; }
    void* args[] = {&p};
    hipError_t e = hipLaunchCooperativeKernel((const void*)hymba_fwd, dim3(grid_blocks), dim3(512), args, LDS_BYTES, stream);
    if (e != hipSuccess) fprintf(stderr, "cooperative launch failed: %s (grid %d)\n", hipGetErrorString(e), grid_blocks);
}
```
